# Optimizing an MI355X kernel written in HIP

```python
import math
import jax
import jax.numpy as jnp
from jax import lax
import numpy as np

D_MODEL = 1024
BATCH = 8
SEQ = 2048
DEPTH = 4

MEM_LEN = 256
HEAD_DIM = 64
ROPE_THETA = 500000.0
ROPE_DIM = HEAD_DIM // 4
NORM_EPS = 1e-5

POOL_WINDOWS = (2, 4, 8, 16)
POOL_GROUPS = 4
POOL_GROUP_DIM = D_MODEL // 16
POOL_DIM = POOL_GROUPS * POOL_GROUP_DIM
MOBA_HEADS = (D_MODEL - POOL_DIM) // HEAD_DIM
MOBA_DIM = MOBA_HEADS * HEAD_DIM
MOBA_BLOCK = 256
MOBA_TOPK = 3
MOBA_QC = 16
AB_IN = POOL_DIM + 3 * MOBA_DIM
NSA_HEADS = D_MODEL // HEAD_DIM
NSA_GROUPS = 4
NSA_HPG = NSA_HEADS // NSA_GROUPS
NSA_KV_DIM = NSA_GROUPS * HEAD_DIM
CMP_LEN = 32
CMP_STRIDE = 16
CMP_HIDDEN = 4 * HEAD_DIM
SLC_BLOCK = 64
SLC_TOPN = 16
WINDOW = 512
NSA_QC = 32
FORCE_SCORE = 1e4
C_IN = NSA_HEADS * HEAD_DIM + 6 * NSA_KV_DIM + 3 * NSA_HEADS
XA_HEADS = 4
XA_DIM = XA_HEADS * HEAD_DIM
D_FF = 2816
N_EXPERTS = 8
TOP_K = 2
D_FF_EXPERT = 3584
N_EVEN = (DEPTH + 1) // 2
N_ODD = DEPTH // 2

kernel_name = 'hybrid_pool_moba_nsa_moe_decoder'


def rmsnorm(x, g):
    xf = x.astype(jnp.float32)
    y = xf * lax.rsqrt(jnp.mean(xf * xf, axis=-1, keepdims=True) + NORM_EPS)
    return y.astype(x.dtype) * g


def rope_tables(positions):
    inv = ROPE_THETA ** (-jnp.arange(0, ROPE_DIM, 2, dtype=jnp.float32) / ROPE_DIM)
    ang = positions.astype(jnp.float32)[:, None] * inv[None, :]
    return jnp.cos(ang), jnp.sin(ang)


def apply_rope(x, cos, sin):
    xr, xp = x[..., :ROPE_DIM], x[..., ROPE_DIM:]
    x1, x2 = xr[..., :ROPE_DIM // 2], xr[..., ROPE_DIM // 2:]
    c = cos[None, :, None, :].astype(x.dtype)
    s = sin[None, :, None, :].astype(x.dtype)
    return jnp.concatenate([x1 * c - x2 * s, x1 * s + x2 * c, xp], axis=-1)


def masked_softmax(s, mask):
    s = jnp.where(mask, s.astype(jnp.float32), -jnp.inf)
    m = jnp.max(s, axis=-1, keepdims=True)
    m = jnp.where(jnp.isfinite(m), m, 0.0)
    e = jnp.where(mask, jnp.exp(s - m), 0.0)
    return e / jnp.maximum(jnp.sum(e, axis=-1, keepdims=True), 1e-30)


def gather_blocks(blocks, idx):
    return jax.vmap(jax.vmap(lambda bl, ix: bl[ix]))(blocks, idx)


def swiglu(h, wg, wu, wd):
    return (jax.nn.silu(h @ wg) * (h @ wu)) @ wd


def pool_mixer(u, pool_w, pool_scale):
    B_, S_, _ = u.shape
    uf = u.astype(jnp.float32)
    cs = jnp.concatenate([jnp.zeros((B_, 1, POOL_DIM), jnp.float32), jnp.cumsum(uf, axis=1)], axis=1)
    t = jnp.arange(S_)
    outs = []
    for g, w in enumerate(POOL_WINDOWS):
        sl = slice(g * POOL_GROUP_DIM, (g + 1) * POOL_GROUP_DIM)
        start = jnp.maximum(t + 1 - w, 0)
        cnt = jnp.minimum(t + 1, w).astype(jnp.float32)
        outs.append((cs[:, t + 1, sl] - cs[:, start, sl]) / cnt[None, :, None])
    pooled = (jnp.concatenate(outs, axis=-1) - uf).astype(u.dtype)
    pg = pooled.reshape(B_, S_, POOL_GROUPS, POOL_GROUP_DIM)
    y = jnp.einsum('bsgc,gcd->bsgd', pg, pool_w).reshape(B_, S_, POOL_DIM)
    return y * pool_scale


def moba_attention(q, k, v):
    B_, S_, H, dh = q.shape
    nb = -(-S_ // MOBA_BLOCK)
    s_pad = nb * MOBA_BLOCK
    pad = ((0, 0), (0, s_pad - S_), (0, 0), (0, 0))
    kb = jnp.pad(k, pad).transpose(0, 2, 1, 3).reshape(B_, H, nb, MOBA_BLOCK, dh)
    vb = jnp.pad(v, pad).transpose(0, 2, 1, 3).reshape(B_, H, nb, MOBA_BLOCK, dh)
    kmean = jnp.mean(kb.astype(jnp.float32), axis=3)
    qh = q.transpose(0, 2, 1, 3)
    scale = dh ** -0.5
    topk = min(MOBA_TOPK, nb - 1)

    def chunk(c):
        s0 = c * MOBA_QC
        tq = s0 + jnp.arange(MOBA_QC)
        qc = lax.dynamic_slice_in_dim(qh, s0, MOBA_QC, axis=2)
        blk = s0 // MOBA_BLOCK
        k_own = lax.dynamic_slice_in_dim(kb, blk, 1, axis=2)[:, :, 0]
        v_own = lax.dynamic_slice_in_dim(vb, blk, 1, axis=2)[:, :, 0]
        pos_own = blk * MOBA_BLOCK + jnp.arange(MOBA_BLOCK)
        m_own = (pos_own[None, :] <= tq[:, None])[None, None]
        s_own = jnp.einsum('bhqd,bhkd->bhqk', qc, k_own) * scale
        if topk == 0:
            p = masked_softmax(s_own, m_own).astype(v.dtype)
            return jnp.einsum('bhqk,bhkd->bhqd', p, v_own)
        gate = jnp.einsum('bhqd,bhnd->bhqn', qc.astype(jnp.float32), kmean)
        gate = jnp.where(jnp.arange(nb) < blk, gate, -jnp.inf)
        _, idx = lax.top_k(gate, topk)
        sel_ok = idx < blk
        k_sel = gather_blocks(kb, idx)
        v_sel = gather_blocks(vb, idx)
        s_sel = jnp.einsum('bhqd,bhqnkd->bhqnk', qc, k_sel).reshape(B_, H, MOBA_QC, topk * MOBA_BLOCK) * scale
        m_sel = jnp.repeat(sel_ok, MOBA_BLOCK, axis=-1)
        m_all = jnp.concatenate([m_sel, jnp.broadcast_to(m_own, (B_, H, MOBA_QC, MOBA_BLOCK))], axis=-1)
        p = masked_softmax(jnp.concatenate([s_sel, s_own], axis=-1), m_all).astype(v.dtype)
        p_sel = p[..., :topk * MOBA_BLOCK].reshape(B_, H, MOBA_QC, topk, MOBA_BLOCK)
        p_own = p[..., topk * MOBA_BLOCK:]
        return (jnp.einsum('bhqnk,bhqnkd->bhqd', p_sel, v_sel)
                + jnp.einsum('bhqk,bhkd->bhqd', p_own, v_own))

    out = lax.map(chunk, jnp.arange(S_ // MOBA_QC))
    return out.transpose(1, 0, 3, 2, 4).reshape(B_, S_, H * dh)


def pool_moba_mixer(h, w_in, pool_w, pool_scale, w_out, cos, sin):
    B_, S_, _ = h.shape
    u = h @ w_in
    u_pool, q, k, v = jnp.split(u, [POOL_DIM, POOL_DIM + MOBA_DIM, POOL_DIM + 2 * MOBA_DIM], axis=-1)
    shp = (B_, S_, MOBA_HEADS, HEAD_DIM)
    q = apply_rope(q.reshape(shp), cos, sin)
    k = apply_rope(k.reshape(shp), cos, sin)
    y_a = pool_mixer(u_pool, pool_w, pool_scale)
    y_b = moba_attention(q, k, v.reshape(shp))
    return jnp.concatenate([y_a, y_b], axis=-1) @ w_out


def compress_blocks(t, pe, w1, w2):
    B_, S_, G, dh = t.shape
    n_cmp = (S_ - CMP_LEN) // CMP_STRIDE + 1
    idx = np.arange(n_cmp)[:, None] * CMP_STRIDE + np.arange(CMP_LEN)[None, :]
    blk = t[:, idx] + pe[None, None, :, None, :]
    flat = blk.transpose(0, 1, 3, 2, 4).reshape(B_, n_cmp, G, CMP_LEN * dh)
    return jax.nn.gelu(flat @ w1) @ w2


def nsa_mixer(h, w_in, pe_k, pe_v, k_w1, k_w2, v_w1, v_w2, w_out, cos, sin):
    B_, S_, _ = h.shape
    G, HPG, dh = NSA_GROUPS, NSA_HPG, HEAD_DIM
    u = h @ w_in
    qd = NSA_HEADS * dh
    offs = [qd + i * NSA_KV_DIM for i in range(1, 7)]
    q, kc, vc, ks, vs, kw, vw, gl = jnp.split(u, [qd] + offs, axis=-1)
    q = q.reshape(B_, S_, NSA_HEADS, dh)
    kvs = (B_, S_, G, dh)
    kc, vc, ks, vs, kw, vw = [a.reshape(kvs) for a in (kc, vc, ks, vs, kw, vw)]
    gates = jax.nn.sigmoid(gl.reshape(B_, S_, NSA_HEADS, 3).astype(jnp.float32)).astype(h.dtype)
    q_rot = apply_rope(q, cos, sin).reshape(B_, S_, G, HPG, dh)
    ks = apply_rope(ks, cos, sin)
    kw = apply_rope(kw, cos, sin)
    q_cmp = q.reshape(B_, S_, G, HPG, dh)
    scale = dh ** -0.5
    t = jnp.arange(S_)

    k_cmp = compress_blocks(kc, pe_k, k_w1, k_w2)
    v_cmp = compress_blocks(vc, pe_v, v_w1, v_w2)
    n_cmp = k_cmp.shape[1]
    cmp_end = jnp.arange(n_cmp) * CMP_STRIDE + CMP_LEN - 1
    m_cmp = cmp_end[None, :] <= t[:, None]
    s_cmp = jnp.einsum('bsghd,bngd->bghsn', q_cmp, k_cmp) * scale
    p_cmp = masked_softmax(s_cmp, m_cmp)
    o_cmp = jnp.einsum('bghsn,bngd->bsghd', p_cmp.astype(v_cmp.dtype), v_cmp).reshape(B_, S_, NSA_HEADS, dh)

    n_slc = -(-S_ // SLC_BLOCK)
    c_s = np.arange(n_cmp) * CMP_STRIDE
    s_s = np.arange(n_slc) * SLC_BLOCK
    ov = np.clip(np.minimum(c_s[:, None] + CMP_LEN, s_s[None, :] + SLC_BLOCK) - np.maximum(c_s[:, None], s_s[None, :]), 0, None) / CMP_LEN
    p_slc = jnp.einsum('bgsn,nj->bgsj', jnp.sum(p_cmp, axis=2), jnp.asarray(ov, jnp.float32))
    t_blk = t // SLC_BLOCK
    j = jnp.arange(n_slc)
    forced = (j[None, :] == 0) | (j[None, :] == t_blk[:, None]) | (j[None, :] == t_blk[:, None] - 1)
    valid = j[None, :] <= t_blk[:, None]
    score = jnp.where(valid, jnp.where(forced, FORCE_SCORE, p_slc), -1.0)
    top_n = min(SLC_TOPN, n_slc)
    _, sel_idx = lax.top_k(score, top_n)

    kbs = ks.transpose(0, 2, 1, 3).reshape(B_, G, n_slc, SLC_BLOCK, dh)
    vbs = vs.transpose(0, 2, 1, 3).reshape(B_, G, n_slc, SLC_BLOCK, dh)
    wpad = ((0, 0), (WINDOW, 0), (0, 0), (0, 0))
    kwp = jnp.pad(kw, wpad)
    vwp = jnp.pad(vw, wpad)

    def chunk(c):
        s0 = c * NSA_QC
        tq = s0 + jnp.arange(NSA_QC)
        qc = lax.dynamic_slice_in_dim(q_rot, s0, NSA_QC, axis=1)
        ic = lax.dynamic_slice_in_dim(sel_idx, s0, NSA_QC, axis=2)
        k_sel = gather_blocks(kbs, ic)
        v_sel = gather_blocks(vbs, ic)
        s_sel = jnp.einsum('bqghd,bgqnkd->bghqnk', qc, k_sel).reshape(B_, G, HPG, NSA_QC, top_n * SLC_BLOCK) * scale
        kpos = ic[..., None] * SLC_BLOCK + jnp.arange(SLC_BLOCK)
        m_sel = (kpos <= tq[None, None, :, None, None]) & (ic <= (tq // SLC_BLOCK)[None, None, :, None])[..., None]
        m_sel = m_sel.reshape(B_, G, NSA_QC, top_n * SLC_BLOCK)[:, :, None]
        p_sel = masked_softmax(s_sel, m_sel).astype(v_sel.dtype).reshape(B_, G, HPG, NSA_QC, top_n, SLC_BLOCK)
        o_sel = jnp.einsum('bghqnk,bgqnkd->bqghd', p_sel, v_sel)
        kwc = lax.dynamic_slice_in_dim(kwp, s0, NSA_QC + WINDOW, axis=1)
        vwc = lax.dynamic_slice_in_dim(vwp, s0, NSA_QC + WINDOW, axis=1)
        kp = s0 - WINDOW + jnp.arange(NSA_QC + WINDOW)
        m_win = (kp[None, :] >= 0) & (kp[None, :] <= tq[:, None]) & (tq[:, None] - kp[None, :] < WINDOW)
        s_win = jnp.einsum('bqghd,bkgd->bghqk', qc, kwc) * scale
        p_win = masked_softmax(s_win, m_win).astype(vwc.dtype)
        o_win = jnp.einsum('bghqk,bkgd->bqghd', p_win, vwc)
        return o_sel, o_win

    o_sel, o_win = lax.map(chunk, jnp.arange(S_ // NSA_QC))
    o_sel = o_sel.transpose(1, 0, 2, 3, 4, 5).reshape(B_, S_, NSA_HEADS, dh)
    o_win = o_win.transpose(1, 0, 2, 3, 4, 5).reshape(B_, S_, NSA_HEADS, dh)
    y = gates[..., 0:1] * o_cmp + gates[..., 1:2] * o_sel + gates[..., 2:3] * o_win
    return y.reshape(B_, S_, NSA_HEADS * dh) @ w_out


def memory_cross_attention(h, mem_n, wq, wkv, wo):
    B_, S_, _ = h.shape
    q = (h @ wq).reshape(B_, S_, XA_HEADS, HEAD_DIM)
    k, v = jnp.split(mem_n @ wkv, 2, axis=-1)
    k = k.reshape(B_, MEM_LEN, XA_HEADS, HEAD_DIM)
    v = v.reshape(B_, MEM_LEN, XA_HEADS, HEAD_DIM)
    s = jnp.einsum('bshd,bmhd->bhsm', q, k) * (HEAD_DIM ** -0.5)
    p = jax.nn.softmax(s.astype(jnp.float32), axis=-1).astype(v.dtype)
    o = jnp.einsum('bhsm,bmhd->bshd', p, v).reshape(B_, S_, XA_DIM)
    return o @ wo


def moe_swiglu(h, router_w, wg, wu, wd):
    logits = (h @ router_w).astype(jnp.float32)
    top_val, top_idx = lax.top_k(logits, TOP_K)
    w = jax.nn.softmax(top_val, axis=-1)
    gate = jnp.sum(jax.nn.one_hot(top_idx, N_EXPERTS, dtype=jnp.float32) * w[..., None], axis=-2).astype(h.dtype)
    out = jnp.zeros_like(h)
    for e in range(N_EXPERTS):
        out = out + gate[..., e:e + 1] * swiglu(h, wg[e], wu[e], wd[e])
    return out


def setup_inputs(seed: int = 0) -> dict:
    key = jax.random.key(seed)
    ks = jax.random.split(key, 28)
    D = D_MODEL
    f32 = jnp.float32

    def nrm(k, shape, fan_in):
        return jax.random.normal(k, shape, f32) * (fan_in ** -0.5)

    return {
        'x': jax.random.normal(ks[0], (BATCH, SEQ, D), f32),
        'mem': jax.random.normal(ks[1], (BATCH, MEM_LEN, D), f32),
        'positions': jnp.arange(SEQ, dtype=jnp.int32),
        'norm_g': 1.0 + 0.02 * jax.random.normal(ks[2], (DEPTH, 3, D), f32),
        'mem_g': 1.0 + 0.02 * jax.random.normal(ks[3], (D,), f32),
        'final_g': 1.0 + 0.02 * jax.random.normal(ks[4], (D,), f32),
        'w_in_ab': nrm(ks[5], (N_EVEN, D, AB_IN), D),
        'pool_w': nrm(ks[6], (N_EVEN, POOL_GROUPS, POOL_GROUP_DIM, POOL_GROUP_DIM), POOL_GROUP_DIM),
        'pool_scale': 1.0 + 0.1 * jax.random.normal(ks[7], (N_EVEN, POOL_DIM), f32),
        'w_out_ab': nrm(ks[8], (N_EVEN, D, D), D),
        'ffn_w_gate': nrm(ks[9], (N_EVEN, D, D_FF), D),
        'ffn_w_up': nrm(ks[10], (N_EVEN, D, D_FF), D),
        'ffn_w_down': nrm(ks[11], (N_EVEN, D_FF, D), D_FF),
        'w_in_c': nrm(ks[12], (N_ODD, D, C_IN), D),
        'cmp_pe_k': 0.1 * jax.random.normal(ks[13], (N_ODD, CMP_LEN, HEAD_DIM), f32),
        'cmp_pe_v': 0.1 * jax.random.normal(ks[14], (N_ODD, CMP_LEN, HEAD_DIM), f32),
        'cmp_k_w1': nrm(ks[15], (N_ODD, CMP_LEN * HEAD_DIM, CMP_HIDDEN), CMP_LEN * HEAD_DIM),
        'cmp_k_w2': nrm(ks[16], (N_ODD, CMP_HIDDEN, HEAD_DIM), CMP_HIDDEN),
        'cmp_v_w1': nrm(ks[17], (N_ODD, CMP_LEN * HEAD_DIM, CMP_HIDDEN), CMP_LEN * HEAD_DIM),
        'cmp_v_w2': nrm(ks[18], (N_ODD, CMP_HIDDEN, HEAD_DIM), CMP_HIDDEN),
        'w_out_c': nrm(ks[19], (N_ODD, D, D), D),
        'router_w': nrm(ks[20], (N_ODD, D, N_EXPERTS), D),
        'moe_w_gate': nrm(ks[21], (N_ODD, N_EXPERTS, D, D_FF_EXPERT), D),
        'moe_w_up': nrm(ks[22], (N_ODD, N_EXPERTS, D, D_FF_EXPERT), D),
        'moe_w_down': nrm(ks[23], (N_ODD, N_EXPERTS, D_FF_EXPERT, D), D_FF_EXPERT),
        'xa_wq': nrm(ks[24], (DEPTH, D, XA_DIM), D),
        'xa_wkv': nrm(ks[25], (DEPTH, D, 2 * XA_DIM), D),
        'xa_wo': nrm(ks[26], (DEPTH, XA_DIM, D), XA_DIM),
    }


def reference(x, mem, positions, norm_g, mem_g, final_g, w_in_ab, pool_w, pool_scale, w_out_ab,
              ffn_w_gate, ffn_w_up, ffn_w_down, w_in_c, cmp_pe_k, cmp_pe_v, cmp_k_w1, cmp_k_w2,
              cmp_v_w1, cmp_v_w2, w_out_c, router_w, moe_w_gate, moe_w_up, moe_w_down,
              xa_wq, xa_wkv, xa_wo):
    cos, sin = rope_tables(positions)
    mem_n = rmsnorm(mem, mem_g)
    for layer in range(DEPTH):
        i = layer // 2
        h = rmsnorm(x, norm_g[layer, 0])
        if layer % 2 == 0:
            x = x + pool_moba_mixer(h, w_in_ab[i], pool_w[i], pool_scale[i], w_out_ab[i], cos, sin)
        else:
            x = x + nsa_mixer(h, w_in_c[i], cmp_pe_k[i], cmp_pe_v[i], cmp_k_w1[i], cmp_k_w2[i],
                              cmp_v_w1[i], cmp_v_w2[i], w_out_c[i], cos, sin)
        h = rmsnorm(x, norm_g[layer, 1])
        x = x + memory_cross_attention(h, mem_n, xa_wq[layer], xa_wkv[layer], xa_wo[layer])
        h = rmsnorm(x, norm_g[layer, 2])
        if layer % 2 == 0:
            x = x + swiglu(h, ffn_w_gate[i], ffn_w_up[i], ffn_w_down[i])
        else:
            x = x + moe_swiglu(h, router_w[i], moe_w_gate[i], moe_w_up[i], moe_w_down[i])
    return rmsnorm(x, final_g)
```

```cpp
#include <hip/hip_runtime.h>
#include <cstdio>
#include <cstdint>
#include <cmath>
#include <cstddef>

#ifndef MK_SINGLE
#define MK_SINGLE 1
#endif

#ifndef PHMASK
#define PHMASK 0xFFFFFFu
#endif
#define ON(n) (((PHMASK) >> (n)) & 1u)
#define GAS __attribute__((address_space(1)))
#define LAS __attribute__((address_space(3)))
typedef unsigned short bf16;
typedef short bf16x8 __attribute__((ext_vector_type(8)));
typedef short s16x4 __attribute__((ext_vector_type(4)));
typedef float f32x4 __attribute__((ext_vector_type(4)));
typedef float f32x2 __attribute__((ext_vector_type(2)));
typedef float f32x16 __attribute__((ext_vector_type(16)));
typedef unsigned u32x4 __attribute__((ext_vector_type(4)));
typedef unsigned u32x2 __attribute__((ext_vector_type(2)));
typedef __bf16 bf16x2_t __attribute__((ext_vector_type(2)));

constexpr int NB = 8, SEQ = 2048, DM = 1024, MTOK = NB * SEQ, MEML = 256;
constexpr int AB_IN = 2560, MOBA_DIMC = 768, C_IN = 2608, C_IN_PAD = 2816;
constexpr int DFF = 2816, DFFE = 3584, NEXP = 8;
constexpr int MOE_MAX_TILES = 136, MOE_MAX_ROWS = MOE_MAX_TILES * 256;
constexpr int CMP_SPLIT = 8;
constexpr float NORM_EPS = 1e-5f;
constexpr float C2 = 0.125f * 1.4426950408889634f;

constexpr size_t MiB = 1u << 20, KiB = 1024;
constexpr size_t WS_CTL = 0, CTL_ZERO_BYTES = 64 * KiB;
constexpr size_t WS_W_INAB = 1 * MiB, WS_W_OUTAB = 11 * MiB, WS_W_FFNGU = 15 * MiB, WS_W_FFND = 37 * MiB, WS_W_INC = 48 * MiB, WS_W_CW1 = 59 * MiB,
                 WS_W_OUTC = 63 * MiB, WS_W_XQ = 67 * MiB, WS_W_XKV = 69 * MiB, WS_W_XO = 73 * MiB, WS_W_MOEGU = 75 * MiB, WS_W_MOED = 187 * MiB;
constexpr size_t WS_XB = 243 * MiB, WS_SSQ = 275 * MiB, WS_MISC = 276 * MiB, WS_MEMB = 280 * MiB, WS_XK = 284 * MiB, WS_XV = 288 * MiB,
                 WS_YB = 292 * MiB, WS_XQ = 324 * MiB, WS_XO = 332 * MiB, WS_ROUTE = 340 * MiB, WS_REGA = 342 * MiB, WS_REGB = 538 * MiB, WS_END = 776 * MiB;
constexpr size_t MISC_CS = 0, MISC_KMEAN = 128 * KiB, MISC_KCMP = 512 * KiB, MISC_VCMP = 1024 * KiB;
constexpr size_t RT_TOKE = 0, RT_TOKPOS = 128 * KiB, RT_TOKW = 256 * KiB, RT_TOKRSTD = 384 * KiB, RT_ROWTOK = 512 * KiB, RT_ROWW = 704 * KiB, RT_ROWRSTD = 896 * KiB, RT_TILEE = 1088 * KiB;
constexpr size_t RA_UPOOL = 0, RA_QB = 16 * MiB, RA_KB = 40 * MiB, RA_VB = 64 * MiB;
constexpr size_t RA_QRAW = 0, RA_QROT = 32 * MiB, RA_ACMPK = 64 * MiB, RA_ACMPV = 80 * MiB, RA_KS = 96 * MiB, RA_VS = 104 * MiB, RA_KW = 112 * MiB, RA_VW = 120 * MiB,
                 RA_GATES = 128 * MiB, RA_CPART = 132 * MiB;
constexpr size_t RA_YMOE = 0, RA_XPERM = 128 * MiB;
constexpr int CW_BAR = 4096, CW_CNT = 8192;

constexpr int RING_BYTES = 131072, LDSCTL_OFF = RING_BYTES, MISC_OFF = LDSCTL_OFF + 320, LDS_BYTES = 147456;
constexpr int NWAVES = 8;

__device__ __forceinline__ unsigned f2bf(float f) { unsigned u = __builtin_bit_cast(unsigned, f); return (u + 0x7fffu + ((u >> 16) & 1u)) >> 16; }
__device__ __forceinline__ unsigned pk2(float lo, float hi) { f32x2 v = {lo, hi}; bf16x2_t b = __builtin_convertvector(v, bf16x2_t); return __builtin_bit_cast(unsigned, b); }
__device__ __forceinline__ float bf2f(unsigned short b) { return __builtin_bit_cast(float, (unsigned)b << 16); }
__device__ __forceinline__ float wave_sum(float v) {
#pragma unroll
    for (int o = 1; o < 64; o <<= 1) v += __shfl_xor(v, o);
    return v;
}
__device__ __forceinline__ float fast_exp2(float x) { return __builtin_amdgcn_exp2f(x); }
__device__ __forceinline__ float fast_rcp(float x) { return __builtin_amdgcn_rcpf(x); }
__device__ __forceinline__ float silu_f(float x) { return x * fast_rcp(1.f + fast_exp2(-1.4426950408889634f * x)); }
__device__ __forceinline__ float sigmoid_f(float x) { return fast_rcp(1.f + fast_exp2(-1.4426950408889634f * x)); }
__device__ __forceinline__ float gelu_tanh_f(float x) {
    const float u = 0.7978845608028654f * (x + 0.044715f * x * x * x);
    const float t = 1.f - 2.f * fast_rcp(1.f + fast_exp2(2.f * 1.4426950408889634f * u));
    return 0.5f * x * (1.f + t);
}
#define LDS_WAIT() asm volatile("s_waitcnt lgkmcnt(0)" ::: "memory")

namespace pg8 {
#define PG8_LAS __attribute__((address_space(3)))
constexpr int BM = 256, BK = 64, HALF = 128, HTB = HALF * BK * 2, NXCD = 8, WGM = 8;
__host__ __device__ __forceinline__ int lds_byte(int r, int c) { const int st = (r >> 4) * 2 + (c >> 5), rr = r & 15, cc = c & 31, ob = rr * 64 + cc * 2; return st * 1024 + (ob ^ (((ob >> 9) & 1) << 5)); }
__host__ __device__ __forceinline__ void stage_rc(int b, int& R, int& C) { const int st = b / 1024, sb = b % 1024, swz = sb ^ (((sb >> 9) & 1) << 5); R = (st >> 1) * 16 + swz / 64; C = (st & 1) * 32 + (swz % 64) / 2; }
__host__ __device__ __forceinline__ int perm32(int rho) { const int n = rho >> 4, i = rho & 15; return 8 * (i >> 2) + 4 * n + (i & 3); }

struct Unit { int pm, pn, aux; size_t oa, ob; };
struct Gemm { const bf16* A; const bf16* Bt; int lda, ldb, K; };

struct StaticOrder {
    int nM, nN, nwg, G, c, lda, ldb;
    __device__ void init(int M, int N, int G_, int c_, int lda_, int ldb_) { nM = M / BM; nN = N / BM; nwg = nM * nN; G = G_; c = c_; lda = lda_; ldb = ldb_; }
    __device__ bool next(int i, Unit& u) const {
        const long L = (long)i * G + c; if (L >= nwg) return false;
        int wgid = (int)L; { const int q = nwg / NXCD, r = nwg % NXCD, xcd = wgid % NXCD, off = wgid / NXCD; wgid = (xcd < r ? xcd * (q + 1) : r * (q + 1) + (xcd - r) * q) + off; }
        const int nig = WGM * nN, gid = wgid / nig, fm = gid * WGM, gsz = (nM - fm) < WGM ? (nM - fm) : WGM;
        u.pm = fm + ((wgid % nig) % gsz); u.pn = (wgid % nig) / gsz; u.aux = 0;
        u.oa = (size_t)u.pm * BM * lda * 2; u.ob = (size_t)u.pn * BM * ldb * 2; return true;
    }
};

template <class Epi, class Sched>
__device__ __forceinline__ void gemm_phase(PG8_LAS unsigned char* lds, const Gemm g, const Sched& S, const Epi& E, const int tid) {
    const int wid = __builtin_amdgcn_readfirstlane(tid >> 6), lane = tid & 63, wr = wid >> 2, wc = wid & 3, fr = lane & 15, fq = lane >> 4;
    const int K = g.K, nt = K / BK;
    unsigned voffA[2], voffB[2];
#pragma unroll
    for (int i = 0; i < 2; ++i) { int R, C; stage_rc(tid * 16 + i * 8192, R, C); const int Rb = Epi::PERM ? ((R & ~31) + perm32(R & 31)) : R;
        voffA[i] = (unsigned)(R * g.lda + C) * 2u; voffB[i] = (unsigned)(Rb * g.ldb + C) * 2u; }
    const size_t kstep = (size_t)(BK * 2);
    const size_t hstepA = (size_t)HALF * g.lda * 2, hstepB = (size_t)HALF * g.ldb * 2;
    const unsigned ldsw = (unsigned)wid * 1024u;
    const int aoff = lds_byte(wr * 64 + fr, fq * 8), boff = lds_byte(wc * 32 + fr, fq * 8);
#define PG8_SA(b, h) (((b) * 2 + (h)) * HTB)
#define PG8_SB(b, h) ((4 + (b) * 2 + (h)) * HTB)
#define PG8_STAGE(bufoff, gbase, voff) do { _Pragma("unroll") for (int _i = 0; _i < 2; ++_i) \
        __builtin_amdgcn_global_load_lds((const unsigned*)((const char*)(gbase) + (voff)[_i]), (PG8_LAS unsigned*)(lds + (bufoff) + ldsw + _i * 8192), 16, 0, 0); } while (0)
#define PG8_LDA(dst, b, h) do { _Pragma("unroll") for (int m = 0; m < 4; ++m) _Pragma("unroll") for (int k = 0; k < 2; ++k) dst[m][k] = *(const PG8_LAS bf16x8*)(lds + PG8_SA(b, h) + aoff + m * 2048 + k * 1024); } while (0)
#define PG8_LDB(dst, b, h) do { _Pragma("unroll") for (int n = 0; n < 2; ++n) _Pragma("unroll") for (int k = 0; k < 2; ++k) dst[n][k] = *(const PG8_LAS bf16x8*)(lds + PG8_SB(b, h) + boff + n * 2048 + k * 1024); } while (0)
#define PG8_MMA(ai, bj, At, Bt) do { __builtin_amdgcn_s_setprio(1); _Pragma("unroll") for (int m = 0; m < 4; ++m) _Pragma("unroll") for (int n = 0; n < 2; ++n) _Pragma("unroll") for (int k = 0; k < 2; ++k) \
        acc[ai][bj][m][n] = __builtin_amdgcn_mfma_f32_16x16x32_bf16(Bt[n][k], At[m][k], acc[ai][bj][m][n], 0, 0, 0); __builtin_amdgcn_s_setprio(0); } while (0)
#define PG8_WAIT_V(n) asm volatile("s_waitcnt vmcnt(" #n ")" ::: "memory")
#define PG8_WAIT_L(n) asm volatile("s_waitcnt lgkmcnt(" #n ")" ::: "memory")
#define PG8_BAR __builtin_amdgcn_s_barrier()
#define PG8_SCHED __builtin_amdgcn_sched_barrier(0)
    Unit cur, nxt; int ui = 0;
    if (!S.next(0, cur)) return;
    f32x4 acc[2][2][4][2];
#pragma unroll
    for (int a = 0; a < 2; ++a)
#pragma unroll
        for (int b = 0; b < 2; ++b)
#pragma unroll
            for (int m = 0; m < 4; ++m)
#pragma unroll
                for (int n = 0; n < 2; ++n) acc[a][b][m][n] = (f32x4){0.f, 0.f, 0.f, 0.f};
    bf16x8 At[4][2], B0[2][2], B1[2][2];
    const char* cA = (const char*)g.A + cur.oa; const char* cB = (const char*)g.Bt + cur.ob;
    PG8_STAGE(PG8_SB(0, 0), cB, voffB); PG8_STAGE(PG8_SB(0, 1), cB + hstepB, voffB); PG8_STAGE(PG8_SA(0, 0), cA, voffA); PG8_STAGE(PG8_SA(0, 1), cA + hstepA, voffA);
    if (wr == 1) PG8_BAR;
    PG8_WAIT_V(2); PG8_BAR;
    PG8_STAGE(PG8_SB(1, 0), cB + kstep, voffB); PG8_STAGE(PG8_SA(1, 0), cA + kstep, voffA); PG8_STAGE(PG8_SB(1, 1), cB + hstepB + kstep, voffB);
    PG8_WAIT_V(6); PG8_BAR;
    for (;;) {
        const bool has_next = S.next(ui + 1, nxt);
        const char* nA = has_next ? (const char*)g.A + nxt.oa : cA; const char* nB = has_next ? (const char*)g.Bt + nxt.ob : cB;
#pragma nounroll
        for (int t = 0; t < nt; t += 2) {
            const bool last = (t == nt - 2);
            const char* a1 = cA + (size_t)(t + 1) * kstep;
            const char* a2 = last ? nA : cA + (size_t)(t + 2) * kstep; const char* b2 = last ? nB : cB + (size_t)(t + 2) * kstep;
            const char* a3 = a2 + kstep; const char* b3 = b2 + kstep;
            PG8_LDB(B0, 0, 0); PG8_LDB(B1, 0, 1); PG8_SCHED; PG8_LDA(At, 0, 0); PG8_STAGE(PG8_SA(1, 1), a1 + hstepA, voffA);
            PG8_WAIT_V(8); PG8_WAIT_L(0); PG8_BAR; PG8_MMA(0, 0, At, B0); PG8_MMA(0, 1, At, B1); PG8_BAR; PG8_SCHED;
            PG8_LDA(At, 0, 1); PG8_STAGE(PG8_SB(0, 0), b2, voffB); PG8_STAGE(PG8_SB(0, 1), b2 + hstepB, voffB); PG8_STAGE(PG8_SA(0, 0), a2, voffA);
            PG8_WAIT_V(8); PG8_WAIT_L(0); PG8_BAR; PG8_MMA(1, 0, At, B0); PG8_MMA(1, 1, At, B1); PG8_BAR; PG8_SCHED;
            PG8_LDB(B0, 1, 0); PG8_LDB(B1, 1, 1); PG8_SCHED; PG8_LDA(At, 1, 0); PG8_STAGE(PG8_SA(0, 1), a2 + hstepA, voffA);
            PG8_WAIT_V(8); PG8_WAIT_L(0); PG8_BAR; PG8_MMA(0, 0, At, B0); PG8_MMA(0, 1, At, B1); PG8_BAR; PG8_SCHED;
            PG8_LDA(At, 1, 1); PG8_STAGE(PG8_SB(1, 0), b3, voffB); PG8_STAGE(PG8_SB(1, 1), b3 + hstepB, voffB); PG8_STAGE(PG8_SA(1, 0), a3, voffA);
            PG8_WAIT_V(8); PG8_WAIT_L(0); PG8_BAR; PG8_MMA(1, 0, At, B0); PG8_MMA(1, 1, At, B1); PG8_BAR; PG8_SCHED;
        }
        if (wr == 0) PG8_BAR;
        { int fr_ = fr, fq_ = fq; asm volatile("" : "+v"(fr_), "+v"(fq_)); E(acc, cur, wr, wc, fr_, fq_); }
        if (!has_next) break;
#pragma unroll
        for (int a = 0; a < 2; ++a)
#pragma unroll
            for (int b = 0; b < 2; ++b)
#pragma unroll
                for (int m = 0; m < 4; ++m)
#pragma unroll
                    for (int n = 0; n < 2; ++n) acc[a][b][m][n] = (f32x4){0.f, 0.f, 0.f, 0.f};
        cur = nxt; cA = nA; cB = nB; ++ui;
        if (wr == 1) PG8_BAR;
    }
    PG8_WAIT_V(0);
    PG8_BAR;
#undef PG8_SA
#undef PG8_SB
#undef PG8_STAGE
#undef PG8_LDA
#undef PG8_LDB
#undef PG8_MMA
#undef PG8_WAIT_V
#undef PG8_WAIT_L
#undef PG8_BAR
#undef PG8_SCHED
}

typedef f32x4 Acc[2][2][4][2];

__device__ __forceinline__ void load_rstd(const float* ssq, int row0, int fq, float (&rs)[2][4]) {
#pragma unroll
    for (int ai = 0; ai < 2; ++ai)
#pragma unroll
        for (int m = 0; m < 4; ++m) {
            const float* p = ssq + (size_t)(fq * 4) * MTOK + row0 + ai * HALF + m * 16;
            float s = (p[0] + p[MTOK]) + (p[2 * MTOK] + p[3 * MTOK]);
            s += __shfl_xor(s, 16); s += __shfl_xor(s, 32);
            rs[ai][m] = rsqrtf(s * (1.f / DM) + NORM_EPS);
        }
}
__device__ __forceinline__ float row_rstd(const float* ssq, int row, int fq) {
    const float* p = ssq + (size_t)(fq * 4) * MTOK + row;
    float s = (p[0] + p[MTOK]) + (p[2 * MTOK] + p[3 * MTOK]);
    s += __shfl_xor(s, 16); s += __shfl_xor(s, 32);
    return rsqrtf(s * (1.f / DM) + NORM_EPS);
}
__device__ __forceinline__ u32x4 pack8(const f32x4& a, const f32x4& b) { u32x4 w; w.x = pk2(a[0], a[1]); w.y = pk2(a[2], a[3]); w.z = pk2(b[0], b[1]); w.w = pk2(b[2], b[3]); return w; }
__device__ __forceinline__ void rope8(f32x4& v0, f32x4& v1, const float* cs, int fq) {
    const f32x4 c0 = *(const f32x4*)(cs), c1 = *(const f32x4*)(cs + 4), s0 = *(const f32x4*)(cs + 8), s1 = *(const f32x4*)(cs + 12);
    f32x4 p0, p1;
#pragma unroll
    for (int e = 0; e < 4; ++e) { p0[e] = __shfl_xor(v0[e], 16); p1[e] = __shfl_xor(v1[e], 16); }
    if (fq == 0) { v0 = v0 * c0 - p0 * s0; v1 = v1 * c1 - p1 * s1; }
    else if (fq == 1) { v0 = p0 * s0 + v0 * c0; v1 = p1 * s1 + v1 * c1; }
}

struct EpiInAB {
    static constexpr bool PERM = true;
    const float* ssq; const float* cs; unsigned char* ra;
    __device__ __forceinline__ void operator()(const Acc& acc, const Unit& u, int wr, int wc, int fr, int fq) const {
        const int row0 = u.pm * BM + wr * 64 + fr;
        float rs[2][4]; load_rstd(ssq, row0, fq, rs);
        if (u.pn == 0) {
#pragma unroll
            for (int ai = 0; ai < 2; ++ai)
#pragma unroll
                for (int m = 0; m < 4; ++m) { const int row = row0 + ai * HALF + m * 16; float* rp = (float*)(ra + RA_UPOOL) + (size_t)row * 256 + wc * 32 + fq * 8;
#pragma unroll
                    for (int bj = 0; bj < 2; ++bj) { *(f32x4*)(rp + bj * HALF) = acc[ai][bj][m][0] * rs[ai][m]; *(f32x4*)(rp + bj * HALF + 4) = acc[ai][bj][m][1] * rs[ai][m]; } }
        } else {
            const int t = (u.pn - 1) / 3, cb = ((u.pn - 1) % 3) * 256;
            bf16* dst = (bf16*)(ra + RA_QB + (size_t)t * (RA_KB - RA_QB));
            const bool rope = (t < 2) && ((wc & 1) == 0);
#pragma unroll
            for (int ai = 0; ai < 2; ++ai)
#pragma unroll
                for (int m = 0; m < 4; ++m) { const int row = row0 + ai * HALF + m * 16; bf16* rp = dst + (size_t)row * MOBA_DIMC + cb + wc * 32 + fq * 8;
                    const float* csr = cs + (size_t)(row & (SEQ - 1)) * 16;
#pragma unroll
                    for (int bj = 0; bj < 2; ++bj) { f32x4 v0 = acc[ai][bj][m][0] * rs[ai][m], v1 = acc[ai][bj][m][1] * rs[ai][m];
                        if (rope) rope8(v0, v1, csr, fq);
                        *(u32x4*)(rp + bj * HALF) = pack8(v0, v1); } }
        }
    }
};

struct EpiInC {
    static constexpr bool PERM = true;
    const float* ssq; const float* cs; unsigned char* ra; const float* pek; const float* pev;
    __device__ __forceinline__ void operator()(const Acc& acc, const Unit& u, int wr, int wc, int fr, int fq) const {
        const int row0 = u.pm * BM + wr * 64 + fr;
        const int pn = u.pn;
        const bool rope = ((wc & 1) == 0);
        if (pn < 4) {
#pragma unroll
            for (int ai = 0; ai < 2; ++ai)
#pragma unroll
                for (int m = 0; m < 4; ++m) { const int row = row0 + ai * HALF + m * 16; const float rsv = row_rstd(ssq, row, fq); const size_t off = (size_t)row * DM + pn * 256 + wc * 32 + fq * 8;
                    const float* csr = cs + (size_t)(row & (SEQ - 1)) * 16;
#pragma unroll
                    for (int bj = 0; bj < 2; ++bj) { f32x4 v0 = acc[ai][bj][m][0] * rsv, v1 = acc[ai][bj][m][1] * rsv;
                        *(u32x4*)((bf16*)(ra + RA_QRAW) + off + bj * HALF) = pack8(v0, v1);
                        if (rope) rope8(v0, v1, csr, fq);
                        *(u32x4*)((bf16*)(ra + RA_QROT) + off + bj * HALF) = pack8(v0, v1); } }
        } else if (pn < 6) {
            bf16* ac = (bf16*)(ra + RA_ACMPK + (size_t)(pn - 4) * (RA_ACMPV - RA_ACMPK)); const float* pe = pek + (ptrdiff_t)(pn - 4) * (pev - pek);
#pragma unroll
            for (int ai = 0; ai < 2; ++ai)
#pragma unroll
                for (int m = 0; m < 4; ++m) { const int row = row0 + ai * HALF + m * 16; const float rsv = row_rstd(ssq, row, fq); const int b = row >> 11, t = row & (SEQ - 1);
#pragma unroll
                    for (int bj = 0; bj < 2; ++bj) { const int c = bj * HALF + wc * 32 + fq * 8, gi = c >> 6, d = c & 63;
                        const f32x4 v0 = acc[ai][bj][m][0] * rsv, v1 = acc[ai][bj][m][1] * rsv;
                        const int n1 = t >> 4, l1 = t & 15;
                        if (n1 <= 126) { const float* pp = pe + l1 * 64 + d; const f32x4 a0 = v0 + *(const f32x4*)pp, a1 = v1 + *(const f32x4*)(pp + 4);
                            *(u32x4*)(ac + ((size_t)((b * 4 + gi) * 128 + n1)) * 2048 + l1 * 64 + d) = pack8(a0, a1); }
                        const int n2 = n1 - 1, l2 = l1 + 16;
                        if (n2 >= 0) { const float* pp = pe + l2 * 64 + d; const f32x4 a0 = v0 + *(const f32x4*)pp, a1 = v1 + *(const f32x4*)(pp + 4);
                            *(u32x4*)(ac + ((size_t)((b * 4 + gi) * 128 + n2)) * 2048 + l2 * 64 + d) = pack8(a0, a1); } } }
        } else if (pn < 10) {
            bf16* dst = (bf16*)(ra + RA_KS + (size_t)(pn - 6) * (RA_VS - RA_KS));
            const bool rp_ = rope && ((pn & 1) == 0);
#pragma unroll
            for (int ai = 0; ai < 2; ++ai)
#pragma unroll
                for (int m = 0; m < 4; ++m) { const int row = row0 + ai * HALF + m * 16; const float rsv = row_rstd(ssq, row, fq); bf16* rp = dst + (size_t)row * 256 + wc * 32 + fq * 8;
                    const float* csr = cs + (size_t)(row & (SEQ - 1)) * 16;
#pragma unroll
                    for (int bj = 0; bj < 2; ++bj) { f32x4 v0 = acc[ai][bj][m][0] * rsv, v1 = acc[ai][bj][m][1] * rsv;
                        if (rp_) rope8(v0, v1, csr, fq);
                        *(u32x4*)(rp + bj * HALF) = pack8(v0, v1); } }
        } else {
            const int c = wc * 32 + fq * 8;
#pragma unroll
            for (int ai = 0; ai < 2; ++ai)
#pragma unroll
                for (int m = 0; m < 4; ++m) { const int row = row0 + ai * HALF + m * 16; const float rsv = row_rstd(ssq, row, fq); float* gp = (float*)(ra + RA_GATES) + (size_t)row * 48 + c;
                    f32x4 v0 = acc[ai][0][m][0] * rsv, v1 = acc[ai][0][m][1] * rsv;
#pragma unroll
                    for (int e = 0; e < 4; ++e) { v0[e] = sigmoid_f(v0[e]); v1[e] = sigmoid_f(v1[e]); }
                    if (c < 48) { *(f32x4*)gp = v0; *(f32x4*)(gp + 4) = v1; } }
        }
    }
};

struct EpiRes {
    static constexpr bool PERM = true;
    float* x; bf16* xb; float* ssq;
    __device__ __forceinline__ void operator()(const Acc& acc, const Unit& u, int wr, int wc, int fr, int fq) const {
        const int row0 = u.pm * BM + wr * 64 + fr;
#pragma unroll
        for (int ai = 0; ai < 2; ++ai)
#pragma unroll
            for (int m = 0; m < 4; ++m) { const int row = row0 + ai * HALF + m * 16; const size_t off = (size_t)row * DM + u.pn * 256 + wc * 32 + fq * 8; float ss = 0.f;
#pragma unroll
                for (int bj = 0; bj < 2; ++bj) { float* xp = x + off + bj * HALF;
                    const f32x4 v0 = *(const f32x4*)xp + acc[ai][bj][m][0], v1 = *(const f32x4*)(xp + 4) + acc[ai][bj][m][1];
                    *(f32x4*)xp = v0; *(f32x4*)(xp + 4) = v1; *(u32x4*)(xb + off + bj * HALF) = pack8(v0, v1);
                    ss += (v0[0] * v0[0] + v0[1] * v0[1]) + (v0[2] * v0[2] + v0[3] * v0[3]) + (v1[0] * v1[0] + v1[1] * v1[1]) + (v1[2] * v1[2] + v1[3] * v1[3]); }
                ss += __shfl_xor(ss, 16); ss += __shfl_xor(ss, 32);
                if (fq == 0) ssq[(size_t)(u.pn * 4 + wc) * MTOK + row] = ss; }
    }
};

struct EpiXQ {
    static constexpr bool PERM = true;
    const float* ssq; bf16* o;
    __device__ __forceinline__ void operator()(const Acc& acc, const Unit& u, int wr, int wc, int fr, int fq) const {
        const int row0 = u.pm * BM + wr * 64 + fr;
        float rs[2][4]; load_rstd(ssq, row0, fq, rs);
#pragma unroll
        for (int ai = 0; ai < 2; ++ai)
#pragma unroll
            for (int m = 0; m < 4; ++m) { const int row = row0 + ai * HALF + m * 16; bf16* rp = o + (size_t)row * 256 + wc * 32 + fq * 8;
#pragma unroll
                for (int bj = 0; bj < 2; ++bj) *(u32x4*)(rp + bj * HALF) = pack8(acc[ai][bj][m][0] * rs[ai][m], acc[ai][bj][m][1] * rs[ai][m]); }
    }
};

struct EpiXKV {
    static constexpr bool PERM = true;
    bf16* xk; bf16* xv;
    __device__ __forceinline__ void operator()(const Acc& acc, const Unit& u, int wr, int wc, int fr, int fq) const {
        const int row0 = u.pm * BM + wr * 64 + fr;
        bf16* dst = xk + (size_t)(u.pn & 1) * (size_t)(xv - xk) + (size_t)(u.pn >> 1) * (NB * MEML * 256);
#pragma unroll
        for (int ai = 0; ai < 2; ++ai)
#pragma unroll
            for (int m = 0; m < 4; ++m) { const int row = row0 + ai * HALF + m * 16; bf16* rp = dst + (size_t)row * 256 + wc * 32 + fq * 8;
#pragma unroll
                for (int bj = 0; bj < 2; ++bj) *(u32x4*)(rp + bj * HALF) = pack8(acc[ai][bj][m][0], acc[ai][bj][m][1]); }
    }
};

template <bool MOE> struct EpiGateUp {
    static constexpr bool PERM = true;
    const float* ssq; const float* rowrstd; bf16* h; int ldh;
    __device__ __forceinline__ void operator()(const Acc& acc, const Unit& u, int wr, int wc, int fr, int fq) const {
        const int row0 = u.pm * BM + wr * 64 + fr;
        float rs[2][4];
        if constexpr (MOE) {
#pragma unroll
            for (int ai = 0; ai < 2; ++ai)
#pragma unroll
                for (int m = 0; m < 4; ++m) rs[ai][m] = rowrstd[row0 + ai * HALF + m * 16];
        } else load_rstd(ssq, row0, fq, rs);
#pragma unroll
        for (int ai = 0; ai < 2; ++ai)
#pragma unroll
            for (int m = 0; m < 4; ++m) { const int row = row0 + ai * HALF + m * 16; const float r = rs[ai][m];
                f32x4 o0, o1;
#pragma unroll
                for (int e = 0; e < 4; ++e) { o0[e] = silu_f(acc[ai][0][m][0][e] * r) * (acc[ai][1][m][0][e] * r); o1[e] = silu_f(acc[ai][0][m][1][e] * r) * (acc[ai][1][m][1][e] * r); }
                *(u32x4*)(h + (size_t)row * ldh + u.pn * 128 + wc * 32 + fq * 8) = pack8(o0, o1); }
    }
};

struct EpiMoeDown {
    static constexpr bool PERM = true;
    const int* rowtok; const float* roww; float* ymoe;
    __device__ __forceinline__ void operator()(const Acc& acc, const Unit& u, int wr, int wc, int fr, int fq) const {
        const int row0 = u.pm * BM + wr * 64 + fr;
#pragma unroll
        for (int ai = 0; ai < 2; ++ai)
#pragma unroll
            for (int m = 0; m < 4; ++m) { const int row = row0 + ai * HALF + m * 16; const int tk = rowtok[row];
                if (tk >= 0) { const float w = roww[row]; float* yp = ymoe + ((size_t)(tk & 1) * MTOK + (tk >> 1)) * DM + u.pn * 256 + wc * 32 + fq * 8;
#pragma unroll
                    for (int bj = 0; bj < 2; ++bj) { *(f32x4*)(yp + bj * HALF) = acc[ai][bj][m][0] * w; *(f32x4*)(yp + bj * HALF + 4) = acc[ai][bj][m][1] * w; } } }
    }
};

struct EpiCmpPart {
    static constexpr bool PERM = true;
    float* cpart;
    __device__ __forceinline__ void operator()(const Acc& acc, const Unit& u, int wr, int wc, int fr, int fq) const {
        const int row0 = u.pm * BM + wr * 64 + fr;
        float* base = cpart + (size_t)u.aux * 4096 * 256;
#pragma unroll
        for (int ai = 0; ai < 2; ++ai)
#pragma unroll
            for (int m = 0; m < 4; ++m) { const int row = row0 + ai * HALF + m * 16; float* rp = base + (size_t)row * 256 + wc * 32 + fq * 8;
#pragma unroll
                for (int bj = 0; bj < 2; ++bj) { *(f32x4*)(rp + bj * HALF) = acc[ai][bj][m][0]; *(f32x4*)(rp + bj * HALF + 4) = acc[ai][bj][m][1]; } }
    }
};

struct CmpOrder {
    int G, c;
    __device__ bool next(int i, Unit& u) const {
        const long L = (long)i * G + c; if (L >= 2 * CMP_SPLIT * 16) return false;
        const int t = (int)L / (CMP_SPLIT * 16), s = ((int)L / 16) % CMP_SPLIT, pm = (int)L % 16;
        u.pm = pm; u.pn = 0; u.aux = t * CMP_SPLIT + s;
        u.oa = ((size_t)(t * 4096 + pm * 256) * 2048 + s * 256) * 2; u.ob = ((size_t)(t * 256) * 2048 + s * 256) * 2; return true;
    }
};
struct MoeOrder {
    const int* tile_e; int nN, G, c, lda, ldb, nper;
    __device__ bool next(int i, Unit& u) const {
        const int nt = __builtin_amdgcn_readfirstlane(tile_e[MOE_MAX_TILES]);
        const long L = (long)i * G + c; if (L >= (long)nt * nN) return false;
        const int pm = (int)(L / nN), pn = (int)(L % nN), e = __builtin_amdgcn_readfirstlane(tile_e[pm]);
        u.pm = pm; u.pn = pn; u.aux = e; u.oa = (size_t)pm * BM * lda * 2; u.ob = ((size_t)e * nper + (size_t)pn * BM) * ldb * 2; return true;
    }
};
}

namespace att {
constexpr int KP = 144, TILE_B = 64 * KP;
constexpr int KV_BYTES = 4 * TILE_B;
#define MFMA32(a, b, c) __builtin_amdgcn_mfma_f32_32x32x16_bf16((a), (b), (c), 0, 0, 0)
typedef short v4i16_t __attribute__((ext_vector_type(4)));
__device__ __forceinline__ s16x4 vtr(const LAS unsigned char* p) { return __builtin_bit_cast(s16x4, __builtin_amdgcn_ds_read_tr16_b64_v4i16((LAS v4i16_t*)p)); }
__device__ __forceinline__ bf16x8 packp(const f32x16& x, int s) {
    u32x4 p; p.x = pk2(x[8 * s], x[8 * s + 1]); p.y = pk2(x[8 * s + 2], x[8 * s + 3]); p.z = pk2(x[8 * s + 4], x[8 * s + 5]); p.w = pk2(x[8 * s + 6], x[8 * s + 7]);
    return __builtin_bit_cast(bf16x8, p);
}
__device__ __forceinline__ short ov_bits(int n, int j) {
    const int jn = n >> 2, q = n & 3;
    if (q < 3) return (jn == j) ? (short)0x3F80 : (short)0;
    return (jn == j || jn + 1 == j) ? (short)0x3F00 : (short)0;
}

struct State { f32x16 o0, o1, o2; float m, l; };
__device__ __forceinline__ void reset(State& s) {
#pragma unroll
    for (int i = 0; i < 16; ++i) { s.o0[i] = 0.f; s.o1[i] = 0.f; s.o2[i] = 0.f; }
    s.m = -1e30f; s.l = 0.f;
}

template <class MK, bool OV>
__device__ __forceinline__ void flash_run(LAS unsigned char* kv, const bf16* Kg, const bf16* Vg, int ld, int jlo, int jhi, const bf16x8 (&qf)[4], State& st, const MK& mk, const int tid) {
    const int lane = tid & 63, r = lane & 31, h = lane >> 5, blk16 = (lane >> 4) & 1, q4 = (lane & 15) >> 2, p4 = lane & 3;
    const int skey = tid >> 3, sch = tid & 7;
    const unsigned sdst = (unsigned)(skey * KP + sch * 16);
    int j = jlo; while (j < jhi && !mk.active(j)) ++j;
    if (j >= jhi) return;
    u32x4 kr = *(const u32x4*)(Kg + (size_t)(64 * j + skey) * ld + sch * 8), vr = *(const u32x4*)(Vg + (size_t)(64 * j + skey) * ld + sch * 8);
    *(LAS u32x4*)(kv + sdst) = kr; *(LAS u32x4*)(kv + 2 * TILE_B + sdst) = vr;
    __syncthreads();
    int cur = 0;
    const unsigned kro = (unsigned)(r * KP + h * 16);
    const unsigned vro = (unsigned)((4 * h + q4) * KP + (16 * blk16 + 4 * p4) * 2);
#pragma nounroll
    for (;;) {
        int jn = j + 1; while (jn < jhi && !mk.active(jn)) ++jn;
        const bool has = jn < jhi;
        if (has) { kr = *(const u32x4*)(Kg + (size_t)(64 * jn + skey) * ld + sch * 8); vr = *(const u32x4*)(Vg + (size_t)(64 * jn + skey) * ld + sch * 8); }
        const int kind = mk.kind(j);
        if (kind != 0) {
            const LAS unsigned char* Kb = kv + cur * TILE_B; const LAS unsigned char* Vb = kv + (2 + cur) * TILE_B;
            f32x16 s0, s1;
#pragma unroll
            for (int i = 0; i < 16; ++i) { s0[i] = 0.f; s1[i] = 0.f; }
#pragma unroll
            for (int ks = 0; ks < 4; ++ks) {
                const bf16x8 k0 = *(const LAS bf16x8*)(Kb + kro + ks * 32), k1 = *(const LAS bf16x8*)(Kb + kro + 32 * KP + ks * 32);
                s0 = MFMA32(k0, qf[ks], s0); s1 = MFMA32(k1, qf[ks], s1);
            }
            float mx = -INFINITY;
#pragma unroll
            for (int i = 0; i < 16; ++i) {
                float a = s0[i] * C2, b = s1[i] * C2;
                if (kind == 2) { const int kk = (i & 3) + 8 * (i >> 2) + 4 * h; if (!mk.ok(j, kk)) a = -INFINITY; if (!mk.ok(j, kk + 32)) b = -INFINITY; }
                s0[i] = a; s1[i] = b; mx = fmaxf(mx, fmaxf(a, b));
            }
            mx = fmaxf(mx, __shfl_xor(mx, 32));
            const float mn = fmaxf(st.m, mx), alpha = fast_exp2(st.m - mn); st.m = mn;
            float ps = 0.f;
#pragma unroll
            for (int i = 0; i < 16; ++i) { s0[i] = fast_exp2(s0[i] - mn); s1[i] = fast_exp2(s1[i] - mn); ps += s0[i] + s1[i]; }
            ps += __shfl_xor(ps, 32);
            st.l = st.l * alpha + ps;
            st.o0 = st.o0 * alpha; st.o1 = st.o1 * alpha; if (OV) st.o2 = st.o2 * alpha;
#pragma unroll
            for (int hf = 0; hf < 2; ++hf)
#pragma unroll
                for (int s = 0; s < 2; ++s) {
                    const bf16x8 pf = packp(hf ? s1 : s0, s);
                    const LAS unsigned char* vb = Vb + vro + (32 * hf + 16 * s) * KP;
                    const s16x4 l0 = vtr(vb), h0 = vtr(vb + 8 * KP), l1 = vtr(vb + 64), h1 = vtr(vb + 8 * KP + 64);
                    st.o0 = MFMA32(__builtin_shufflevector(l0, h0, 0, 1, 2, 3, 4, 5, 6, 7), pf, st.o0);
                    st.o1 = MFMA32(__builtin_shufflevector(l1, h1, 0, 1, 2, 3, 4, 5, 6, 7), pf, st.o1);
                    if (OV) {
                        int r_ = r; asm volatile("" : "+v"(r_));
                        const int jnA = 16 * j + 8 * hf + 4 * s + h - r_, jnB = jnA + 2;
                        u32x4 a;
                        a.x = (jnA == 0) ? 0x3F803F80u : 0u; a.y = ((jnA == 0) ? 0x00003F80u : 0u) | ((jnA == 0 || jnA == -1) ? 0x3F000000u : 0u);
                        a.z = (jnB == 0) ? 0x3F803F80u : 0u; a.w = ((jnB == 0) ? 0x00003F80u : 0u) | ((jnB == 0 || jnB == -1) ? 0x3F000000u : 0u);
                        st.o2 = MFMA32(__builtin_bit_cast(bf16x8, a), pf, st.o2); }
                }
        }
        if (has) { *(LAS u32x4*)(kv + (cur ^ 1) * TILE_B + sdst) = kr; *(LAS u32x4*)(kv + (2 + (cur ^ 1)) * TILE_B + sdst) = vr; }
        __syncthreads();
        if (!has) break;
        j = jn; cur ^= 1;
    }
}

__device__ __forceinline__ void load_q(bf16x8 (&qf)[4], const bf16* qrow, int h) {
#pragma unroll
    for (int ks = 0; ks < 4; ++ks) qf[ks] = *(const bf16x8*)(qrow + ks * 16 + h * 8);
}
__device__ __forceinline__ void store_o(bf16* orow, const f32x16& o0, const f32x16& o1, float sc, int h) {
#pragma unroll
    for (int g = 0; g < 4; ++g) {
        u32x2 a, b; a.x = pk2(o0[4 * g] * sc, o0[4 * g + 1] * sc); a.y = pk2(o0[4 * g + 2] * sc, o0[4 * g + 3] * sc);
        b.x = pk2(o1[4 * g] * sc, o1[4 * g + 1] * sc); b.y = pk2(o1[4 * g + 2] * sc, o1[4 * g + 3] * sc);
        *(u32x2*)(orow + 8 * g + 4 * h) = a; *(u32x2*)(orow + 32 + 8 * g + 4 * h) = b;
    }
}

struct NoMask { __device__ __forceinline__ bool active(int) const { return true; } __device__ __forceinline__ int kind(int) const { return 1; } __device__ __forceinline__ bool ok(int, int) const { return true; } };
struct MobaMask {
    int qb, wq0, tq; unsigned sel, uni;
    __device__ __forceinline__ bool active(int jt) const { const int jb = jt >> 2; return jb >= qb || ((uni >> jb) & 1u); }
    __device__ __forceinline__ int kind(int jt) const { const int jb = jt >> 2; if (jb < qb) return 2; const int k0 = (jt & 3) * 64; if (k0 > wq0 + 31) return 0; if (k0 + 63 <= wq0) return 1; return 2; }
    __device__ __forceinline__ bool ok(int jt, int kk) const { const int jb = jt >> 2; if (jb < qb) return (sel >> jb) & 1u; return (jt & 3) * 64 + kk <= tq; }
};
struct CmpMask {
    int nmax, nlo, nhi;
    __device__ __forceinline__ bool active(int) const { return true; }
    __device__ __forceinline__ int kind(int j) const { if (64 * j > nhi) return 0; if (64 * j + 63 <= nlo) return 1; return 2; }
    __device__ __forceinline__ bool ok(int j, int kk) const { return 64 * j + kk <= nmax; }
};
struct SelMask {
    int tb, tq, wq0; unsigned sel, uni;
    __device__ __forceinline__ bool active(int j) const { return (uni >> j) & 1u; }
    __device__ __forceinline__ int kind(int j) const { return 2; }
    __device__ __forceinline__ bool ok(int j, int kk) const { const bool s = (sel >> j) & 1u; return j < tb ? s : (s && kk <= tq); }
};
struct WinMask {
    int tb, tq;
    __device__ __forceinline__ bool active(int) const { return true; }
    __device__ __forceinline__ int kind(int j) const { return (j == tb || j == tb - 8) ? 2 : 1; }
    __device__ __forceinline__ bool ok(int j, int kk) const { const int d = 64 * (tb - j) + tq - kk; return d >= 0 && d < 512; }
};
}

#define XB_TMO      128
#define XB_XCNT(j)  (256  + 64 * (j))
#define XB_XSUB(j)  (1280 + 64 * (j))
#define XB_XGEN(j)  (2304 + 64 * (j))
#define XB_TOP      3328
#define XB_TOPGEN   3392
#define XCD_BAR_WORDS 3456
#define XB_SPIN_CAP (1u << 18)
__device__ __forceinline__ unsigned xb_ld(unsigned* p)              { return __hip_atomic_load(p, __ATOMIC_RELAXED, __HIP_MEMORY_SCOPE_AGENT); }
__device__ __forceinline__ unsigned xb_add(unsigned* p, unsigned v) { return __hip_atomic_fetch_add(p, v, __ATOMIC_RELAXED, __HIP_MEMORY_SCOPE_AGENT); }
__device__ __forceinline__ unsigned xb_xcc_id() { return (unsigned)__builtin_amdgcn_s_getreg((3 << 11) | 20) & 0xFu; }
#define XB_SPIN(cond, bar) do { unsigned _sp = 0; while (cond) { __builtin_amdgcn_s_sleep(1); \
    if ((++_sp & 255u) == 0u) { if (xb_ld(&(bar)[XB_TMO])) break; if (_sp > XB_SPIN_CAP) { atomicAdd(&(bar)[XB_TMO], 1u); break; } } } } while (0)
struct XcdBarrier { unsigned* bar; unsigned x; volatile LAS unsigned* st; };
__device__ __forceinline__ XcdBarrier xcd_barrier_post(unsigned* bar, volatile LAS unsigned* st) {
    XcdBarrier b; b.bar = bar; b.x = xb_xcc_id(); b.st = st;
    if (threadIdx.x == 0) (void)xb_add(&bar[XB_XCNT(b.x)], 1u);
    return b;
}
__device__ __forceinline__ void xcd_barrier_complete(unsigned* bar, unsigned x, unsigned& nloc, unsigned& nx) {
    const unsigned G = gridDim.x * gridDim.y * gridDim.z;
    unsigned sum, cnt, mine, sp = 0u;
    for (;;) {
        sum = 0u; cnt = 0u; mine = 0u;
#pragma unroll
        for (unsigned j = 0; j < 16; ++j) { const unsigned c = xb_ld(&bar[XB_XCNT(j)]); sum += c; cnt += (c > 0u) ? 1u : 0u; mine = (j == x) ? c : mine; }
        if (sum == G) break;
        __builtin_amdgcn_s_sleep(1);
        if ((++sp & 255u) == 0u) { if (xb_ld(&bar[XB_TMO])) break; if (sp > XB_SPIN_CAP) { atomicAdd(&bar[XB_TMO], 1u); break; } }
    }
    nloc = mine > 0u ? mine : 1u; nx = cnt > 0u ? cnt : 1u;
}
__device__ __forceinline__ void xcd_barrier(const XcdBarrier& b) {
    asm volatile("s_waitcnt vmcnt(0)" ::: "memory");
    __syncthreads();
    if (threadIdx.x == 0) {
        unsigned* bar = b.bar;
        __builtin_amdgcn_s_waitcnt(0);
        unsigned nloc = b.st[0], nx = b.st[1];
        if (nloc == 0u) { xcd_barrier_complete(bar, b.x, nloc, nx); b.st[0] = nloc; b.st[1] = nx; }
        const unsigned old = xb_add(&bar[XB_XSUB(b.x)], 1u);
        const unsigned gen = old / nloc;
        if (old + 1u == (gen + 1u) * nloc) {
            __builtin_amdgcn_fence(__ATOMIC_RELEASE, "agent");
            asm volatile("s_waitcnt vmcnt(0)" ::: "memory");
            const unsigned og = xb_add(&bar[XB_TOP], 1u);
            const unsigned tg = og / nx;
            if (og + 1u == (tg + 1u) * nx) xb_add(&bar[XB_TOPGEN], 1u);
            else XB_SPIN(xb_ld(&bar[XB_TOPGEN]) == tg, bar);
            __builtin_amdgcn_fence(__ATOMIC_ACQUIRE, "agent");
            xb_add(&bar[XB_XGEN(b.x)], 1u);
            asm volatile("s_waitcnt vmcnt(0)" ::: "memory");
        } else {
            XB_SPIN(xb_ld(&bar[XB_XGEN(b.x)]) == gen, bar);
            __builtin_amdgcn_fence(__ATOMIC_ACQUIRE, "agent");
            asm volatile("s_waitcnt vmcnt(0)" ::: "memory");
        }
    }
    __syncthreads();
}

struct ConvJob { const float* src; bf16* dst; const float* g; int K, N, nblk, mode, start, pad; };

__device__ __forceinline__ void conv_item(const float* src, bf16* dst, const float* g, int K, int N, int nblk, int mode, LAS float* scr, int item, int lane) {
    const int kb = item / nblk, nb = item - kb * nblk, k0 = 64 * kb, n0 = 32 * nb;
    const int n = n0 + (lane & 31); const bool inb = n < N;
#pragma unroll 8
    for (int i = 0; i < 32; ++i) { const int kk = 2 * i + (lane >> 5); float v = inb ? src[(size_t)(k0 + kk) * N + n] : 0.f; if (g) v *= g[k0 + kk]; scr[kk * 33 + (lane & 31)] = v; }
    LDS_WAIT(); asm volatile("" ::: "memory");
    const int c = lane & 7;
#pragma unroll
    for (int j = 0; j < 4; ++j) { const int nn = (lane >> 3) + 8 * j, nc = n0 + nn; const LAS float* s = scr + (8 * c) * 33 + nn;
        u32x4 o; o.x = pk2(s[0 * 33], s[1 * 33]); o.y = pk2(s[2 * 33], s[3 * 33]); o.z = pk2(s[4 * 33], s[5 * 33]); o.w = pk2(s[6 * 33], s[7 * 33]);
        if (nc < N) { const int orow = mode == 0 ? nc : (256 * (nc >> 7) + (nc & 127) + (mode == 2 ? 128 : 0)); *(u32x4*)(dst + (size_t)orow * K + k0 + 8 * c) = o; } }
    LDS_WAIT(); asm volatile("" ::: "memory");
}
__device__ __forceinline__ void run_conv_jobs(LAS unsigned char* lds, int njobs, int total, int gw, int NGW, int wave, int lane) {
    const LAS ConvJob* jobs = (const LAS ConvJob*)(lds + 72 * 1024);
    LAS float* scr = (LAS float*)(lds + wave * 8448);
    for (int it = gw; it < total; it += NGW) {
        int ji = 0; while (ji + 1 < njobs && jobs[ji + 1].start <= it) ++ji;
        const float* src = jobs[ji].src; bf16* dst = jobs[ji].dst; const float* g = jobs[ji].g;
        const int K = jobs[ji].K, N = jobs[ji].N, nblk = jobs[ji].nblk, mode = jobs[ji].mode, start = jobs[ji].start;
        conv_item(src, dst, g, K, N, nblk, mode, scr, it - start, lane);
    }
}
#define ADD_JOB(SRC, DST, GP, KK, NN, MODE) do { LAS ConvJob* _j = jobsw + nj; _j->src = (SRC); _j->dst = (DST); _j->g = (GP); _j->K = (KK); _j->N = (NN); _j->nblk = ((NN) + 31) / 32; \
    _j->mode = (MODE); _j->start = tot; _j->pad = 0; tot += ((KK) / 64) * (((NN) + 31) / 32); ++nj; } while (0)

__device__ __forceinline__ float load_row4(const float* row, int lane, f32x4 (&v)[4]) {
    float s = 0.f;
#pragma unroll
    for (int j = 0; j < 4; ++j) { v[j] = *(const f32x4*)(row + 4 * lane + 256 * j); s += (v[j][0] * v[j][0] + v[j][1] * v[j][1]) + (v[j][2] * v[j][2] + v[j][3] * v[j][3]); }
    return wave_sum(s);
}
__device__ __forceinline__ void store_ssq_full(float* ssq, int row, float s, int lane) { if (lane < 16) ssq[(size_t)lane * MTOK + row] = (lane == 0) ? s : 0.f; }
__device__ __forceinline__ void store_row_bf16(bf16* orow, int lane, const f32x4 (&v)[4]) {
#pragma unroll
    for (int j = 0; j < 4; ++j) { u32x2 o; o.x = pk2(v[j][0], v[j][1]); o.y = pk2(v[j][2], v[j][3]); *(u32x2*)(orow + 4 * lane + 256 * j) = o; }
}

struct Args { const void* in[28]; float* out; unsigned char* ws; double invf[8]; int ph_lo, ph_hi; };
constexpr int NPH = 2 + 4 * 13;

#define CAS __attribute__((address_space(4)))
__device__ __forceinline__ const CAS char* karg() { const CAS char* kp = (const CAS char*)__builtin_amdgcn_kernarg_segment_ptr(); asm volatile("" : "+s"(kp)); return kp; }
#define INP(k) ((const void*)(*(const GAS void* const CAS*)(karg() + 8 * (k))))
#define ARG_OUT ((float*)(*(GAS float* const CAS*)(karg() + 224)))
#define ARG_WS (*(GAS unsigned char* const CAS*)(karg() + 232))
#define ARG_INVF(j) (*(const CAS double*)(karg() + 240 + 8 * (j)))
static_assert(offsetof(Args, out) == 224 && offsetof(Args, ws) == 232 && offsetof(Args, invf) == 240 && offsetof(Args, ph_lo) == 304 && sizeof(Args) == 312, "kernarg layout");
__global__ void __launch_bounds__(NWAVES * 64, 2) mk_fwd(Args args) {
    extern __shared__ __attribute__((aligned(16))) unsigned char lds_raw[];
    LAS unsigned char* lds = (LAS unsigned char*)lds_raw;
    volatile LAS unsigned* MISC = (volatile LAS unsigned*)(lds + MISC_OFF);
#define PHASE_IDS int tid = threadIdx.x; asm volatile("" : "+v"(tid)); const int lane = tid & 63, wave = __builtin_amdgcn_readfirstlane(tid >> 6); \
    int bx = blockIdx.x, G = gridDim.x; asm volatile("" : "+s"(bx), "+s"(G)); const int gw = bx * NWAVES + wave, NGW = G * NWAVES; (void)lane; (void)gw; (void)NGW;
#define ws (ARG_WS)
#define ctl ((unsigned*)(ws + WS_CTL))
    for (int u = threadIdx.x; u < (LDS_BYTES - LDSCTL_OFF) / 4; u += NWAVES * 64) ((LAS unsigned*)(lds + LDSCTL_OFF))[u] = 0u;
    __syncthreads();
    if (MK_SINGLE) (void)xcd_barrier_post(ctl + CW_BAR, MISC + 8);
#define PH_LO (*(const CAS int*)(karg() + 304))
#define PH_HI (*(const CAS int*)(karg() + 308))
#define IN(p) (PH_LO <= (p) && (p) < PH_HI)
#define BAR_AFTER(p) do { if (MK_SINGLE && (p) + 1 < PH_HI) { XcdBarrier bar_; bar_.bar = ctl + CW_BAR; bar_.x = xb_xcc_id(); bar_.st = (volatile LAS unsigned*)(lds + MISC_OFF) + 8; xcd_barrier(bar_); } } while (0)

#define in_x ((const float*)INP(0))
#define in_mem ((const float*)INP(1))
#define in_pos ((const int*)INP(2))
#define norm_g ((const float*)INP(3))
#define mem_g ((const float*)INP(4))
#define final_g ((const float*)INP(5))
#define X (ARG_OUT)
#define XB ((bf16*)(ws + WS_XB))
#define SSQ ((float*)(ws + WS_SSQ))
#define CS ((float*)(ws + WS_MISC + MISC_CS))
#define KMEAN ((float*)(ws + WS_MISC + MISC_KMEAN))
#define KCMP ((bf16*)(ws + WS_MISC + MISC_KCMP))
#define VCMP ((bf16*)(ws + WS_MISC + MISC_VCMP))
#define MEMB ((bf16*)(ws + WS_MEMB))
#define XK ((bf16*)(ws + WS_XK))
#define XV ((bf16*)(ws + WS_XV))
#define YB ((bf16*)(ws + WS_YB))
#define XQ ((bf16*)(ws + WS_XQ))
#define XO ((bf16*)(ws + WS_XO))
#define TOKE ((int*)(ws + WS_ROUTE + RT_TOKE))
#define TOKPOS ((int*)(ws + WS_ROUTE + RT_TOKPOS))
#define TOKW ((float*)(ws + WS_ROUTE + RT_TOKW))
#define TOKRSTD ((float*)(ws + WS_ROUTE + RT_TOKRSTD))
#define ROWTOK ((int*)(ws + WS_ROUTE + RT_ROWTOK))
#define ROWW ((float*)(ws + WS_ROUTE + RT_ROWW))
#define ROWRSTD ((float*)(ws + WS_ROUTE + RT_ROWRSTD))
#define TILEE ((int*)(ws + WS_ROUTE + RT_TILEE))
#define RA ((unsigned char*)(ws + WS_REGA))
#define UPOOL ((float*)(RA + RA_UPOOL))
#define QB ((bf16*)(RA + RA_QB))
#define KB ((bf16*)(RA + RA_KB))
#define VB ((bf16*)(RA + RA_VB))
#define QRAW ((bf16*)(RA + RA_QRAW))
#define QROT ((bf16*)(RA + RA_QROT))
#define ACMPK ((bf16*)(RA + RA_ACMPK))
#define KSB ((bf16*)(RA + RA_KS))
#define VSB ((bf16*)(RA + RA_VS))
#define KWB ((bf16*)(RA + RA_KW))
#define VWB ((bf16*)(RA + RA_VW))
#define GATES ((float*)(RA + RA_GATES))
#define CPART ((float*)(RA + RA_CPART))
#define YMOE ((float*)(RA + RA_YMOE))
#define XPERM ((bf16*)(RA + RA_XPERM))
#define HB ((bf16*)(ws + WS_REGB))

    if (ON(0) && IN(0)) {
            PHASE_IDS
        LAS ConvJob* jobsw = (LAS ConvJob*)(lds + 72 * 1024);
        LAS int* jmeta = (LAS int*)(lds + 80 * 1024);
        if (tid == 0) {
            int nj = 0, tot = 0;
#pragma nounroll
            for (int i = 0; i < 2; ++i) {
                ADD_JOB((const float*)INP(6) + (size_t)i * DM * AB_IN, (bf16*)(ws + WS_W_INAB) + (size_t)i * AB_IN * DM, norm_g + (2 * i * 3 + 0) * DM, DM, AB_IN, 0);
                ADD_JOB((const float*)INP(9) + (size_t)i * DM * DM, (bf16*)(ws + WS_W_OUTAB) + (size_t)i * DM * DM, (const float*)nullptr, DM, DM, 0);
                ADD_JOB((const float*)INP(10) + (size_t)i * DM * DFF, (bf16*)(ws + WS_W_FFNGU) + (size_t)i * 2 * DFF * DM, norm_g + (2 * i * 3 + 2) * DM, DM, DFF, 1);
                ADD_JOB((const float*)INP(11) + (size_t)i * DM * DFF, (bf16*)(ws + WS_W_FFNGU) + (size_t)i * 2 * DFF * DM, norm_g + (2 * i * 3 + 2) * DM, DM, DFF, 2);
                ADD_JOB((const float*)INP(12) + (size_t)i * DFF * DM, (bf16*)(ws + WS_W_FFND) + (size_t)i * DM * DFF, (const float*)nullptr, DFF, DM, 0);
                ADD_JOB((const float*)INP(13) + (size_t)i * DM * C_IN, (bf16*)(ws + WS_W_INC) + (size_t)i * C_IN_PAD * DM, norm_g + ((2 * i + 1) * 3 + 0) * DM, DM, C_IN, 0);
                ADD_JOB((const float*)INP(16) + (size_t)i * 2048 * 256, (bf16*)(ws + WS_W_CW1) + (size_t)(i * 2 + 0) * 256 * 2048, (const float*)nullptr, 2048, 256, 0);
                ADD_JOB((const float*)INP(18) + (size_t)i * 2048 * 256, (bf16*)(ws + WS_W_CW1) + (size_t)(i * 2 + 1) * 256 * 2048, (const float*)nullptr, 2048, 256, 0);
                ADD_JOB((const float*)INP(20) + (size_t)i * DM * DM, (bf16*)(ws + WS_W_OUTC) + (size_t)i * DM * DM, (const float*)nullptr, DM, DM, 0);
            }
#pragma nounroll
            for (int l = 0; l < 4; ++l) {
                ADD_JOB((const float*)INP(25) + (size_t)l * DM * 256, (bf16*)(ws + WS_W_XQ) + (size_t)l * 256 * DM, norm_g + (l * 3 + 1) * DM, DM, 256, 0);
                ADD_JOB((const float*)INP(26) + (size_t)l * DM * 512, (bf16*)(ws + WS_W_XKV) + (size_t)l * 512 * DM, (const float*)nullptr, DM, 512, 0);
                ADD_JOB((const float*)INP(27) + (size_t)l * 256 * DM, (bf16*)(ws + WS_W_XO) + (size_t)l * DM * 256, (const float*)nullptr, 256, DM, 0);
            }
#pragma nounroll
            for (int e = 0; e < NEXP; ++e) {
                ADD_JOB((const float*)INP(22) + (size_t)e * DM * DFFE, (bf16*)(ws + WS_W_MOEGU) + (size_t)e * 2 * DFFE * DM, norm_g + (1 * 3 + 2) * DM, DM, DFFE, 1);
                ADD_JOB((const float*)INP(23) + (size_t)e * DM * DFFE, (bf16*)(ws + WS_W_MOEGU) + (size_t)e * 2 * DFFE * DM, norm_g + (1 * 3 + 2) * DM, DM, DFFE, 2);
                ADD_JOB((const float*)INP(24) + (size_t)e * DFFE * DM, (bf16*)(ws + WS_W_MOED) + (size_t)e * DM * DFFE, (const float*)nullptr, DFFE, DM, 0);
            }
            jmeta[0] = nj; jmeta[1] = tot;
        }
        __syncthreads();
        run_conv_jobs(lds, jmeta[0], jmeta[1], gw, NGW, wave, lane);
        for (int idx = bx * 512 + tid; idx < 2 * (C_IN_PAD - C_IN) * (DM / 8); idx += G * 512) {
            const int i = idx / ((C_IN_PAD - C_IN) * (DM / 8)), rem = idx % ((C_IN_PAD - C_IN) * (DM / 8));
            *(u32x4*)((bf16*)(ws + WS_W_INC) + ((size_t)i * C_IN_PAD + C_IN) * DM + (size_t)rem * 8) = (u32x4){0u, 0u, 0u, 0u};
        }
        for (int m = gw; m < MTOK; m += NGW) {
            f32x4 v[4]; const float s = load_row4(in_x + (size_t)m * DM, lane, v);
#pragma unroll
            for (int j = 0; j < 4; ++j) *(f32x4*)(X + (size_t)m * DM + 4 * lane + 256 * j) = v[j];
            store_row_bf16(XB + (size_t)m * DM, lane, v); store_ssq_full(SSQ, m, s, lane);
        }
        for (int m = gw; m < NB * MEML; m += NGW) {
            f32x4 v[4]; const float s = load_row4(in_mem + (size_t)m * DM, lane, v); const float r = rsqrtf(s * (1.f / DM) + NORM_EPS);
#pragma unroll
            for (int j = 0; j < 4; ++j) v[j] = v[j] * r * *(const f32x4*)(mem_g + 4 * lane + 256 * j);
            store_row_bf16(MEMB + (size_t)m * DM, lane, v);
        }
        for (int idx = bx * 512 + tid; idx < SEQ * 8; idx += G * 512) {
            const int t = idx >> 3, j = idx & 7; const double a = (double)in_pos[t] * ARG_INVF(j) * 0.15915494309189535;
            const float fr_ = (float)(a - __builtin_rint(a));
            CS[t * 16 + j] = __builtin_amdgcn_cosf(fr_); CS[t * 16 + 8 + j] = __builtin_amdgcn_sinf(fr_);
        }
        BAR_AFTER(0);
    }
    if (ON(1) && IN(1)) {
            PHASE_IDS
        pg8::Gemm g{MEMB, (const bf16*)(ws + WS_W_XKV), DM, DM, DM}; pg8::StaticOrder S; S.init(NB * MEML, 4 * 512, G, bx, DM, DM);
        pg8::EpiXKV E{XK, XV};
        pg8::gemm_phase<pg8::EpiXKV, pg8::StaticOrder>(lds, g, S, E, tid);
        BAR_AFTER(1);
    }

    for (int l = 0; l < 4; ++l) {
        const int pb = 2 + 13 * l, i2 = l >> 1;
        const bool even = (l & 1) == 0;
        if (IN(pb + 0)) {
            PHASE_IDS
            if (ON(2) && even) {
                pg8::Gemm g{XB, (const bf16*)(ws + WS_W_INAB) + (size_t)i2 * AB_IN * DM, DM, DM, DM}; pg8::StaticOrder S; S.init(MTOK, AB_IN, G, bx, DM, DM);
                pg8::EpiInAB E{SSQ, CS, RA};
                pg8::gemm_phase<pg8::EpiInAB, pg8::StaticOrder>(lds, g, S, E, tid);
            } else if (ON(3) && !even) {
                pg8::Gemm g{XB, (const bf16*)(ws + WS_W_INC) + (size_t)i2 * C_IN_PAD * DM, DM, DM, DM}; pg8::StaticOrder S; S.init(MTOK, C_IN_PAD, G, bx, DM, DM);
                pg8::EpiInC E{SSQ, CS, RA, (const float*)INP(14) + (size_t)i2 * 32 * 64, (const float*)INP(15) + (size_t)i2 * 32 * 64};
                pg8::gemm_phase<pg8::EpiInC, pg8::StaticOrder>(lds, g, S, E, tid);
            }
            BAR_AFTER(pb + 0);
        }
        if (IN(pb + 1)) {
            PHASE_IDS
            if (ON(4) && even) {
                LAS float* red = (LAS float*)lds;
                for (int u = bx; u < NB * 12 * 8; u += G) {
                    const int b = u / 96, h = (u / 8) % 12, blk = u % 8, d = tid & 63, part = tid >> 6;
                    const bf16* kp = KB + ((size_t)(b * SEQ + 256 * blk + 32 * part)) * MOBA_DIMC + h * 64 + d;
                    float s = 0.f;
#pragma unroll 8
                    for (int i = 0; i < 32; ++i) s += bf2f(kp[(size_t)i * MOBA_DIMC]);
                    red[part * 64 + d] = s;
                    __syncthreads();
                    if (tid < 64) { float t = 0.f;
#pragma unroll
                        for (int p = 0; p < 8; ++p) t += red[p * 64 + tid];
                        KMEAN[(size_t)u * 64 + tid] = t * (1.f / 256.f); }
                    __syncthreads();
                }
            } else if (ON(5) && !even) {
                pg8::Gemm g{ACMPK, (const bf16*)(ws + WS_W_CW1) + (size_t)i2 * 2 * 256 * 2048, 2048, 2048, 2048 / CMP_SPLIT}; pg8::CmpOrder S{G, bx};
                pg8::EpiCmpPart E{CPART};
                pg8::gemm_phase<pg8::EpiCmpPart, pg8::CmpOrder>(lds, g, S, E, tid);
            }
            BAR_AFTER(pb + 1);
        }
        if (ON(6) && IN(pb + 2) && !even) {
            PHASE_IDS
            LAS float* hl = (LAS float*)lds;
            for (int u = bx; u < 512; u += G) {
                const int t = u >> 8, R0 = (u & 255) * 16;
#pragma unroll
                for (int q = 0; q < 8; ++q) { const int idx = tid + 512 * q, rr = idx >> 8, cc = idx & 255; float s = 0.f;
#pragma unroll
                    for (int sp = 0; sp < CMP_SPLIT; ++sp) s += CPART[((size_t)(t * CMP_SPLIT + sp) * 4096 + R0 + rr) * 256 + cc];
                    hl[idx] = gelu_tanh_f(s); }
                __syncthreads();
                const float* w2 = (const float*)INP(t ? 19 : 17) + (size_t)i2 * 256 * 64;
                const int rr = tid >> 5, d0 = (tid & 31) * 2; float a0 = 0.f, a1 = 0.f;
#pragma unroll 8
                for (int k = 0; k < 256; ++k) { const float hv = hl[rr * 256 + k]; const f32x2 w = *(const f32x2*)(w2 + k * 64 + d0); a0 += hv * w[0]; a1 += hv * w[1]; }
                const int row = R0 + rr; if ((row & 127) == 127) { a0 = 0.f; a1 = 0.f; }
                *(unsigned*)((t ? VCMP : KCMP) + (size_t)row * 64 + d0) = pk2(a0, a1);
                __syncthreads();
            }
            BAR_AFTER(pb + 2);
        }
        if (IN(pb + 3)) {
            PHASE_IDS
            if (ON(7) && even) {
                for (int u = bx; u < 768 + 512; u += G) {
                    if (u < 768) {
                        const int qb = 7 - u / 96, bh = u % 96, b = bh / 12, h = bh % 12;
                        LAS float* km = (LAS float*)(lds + att::KV_BYTES);
                        LAS unsigned* uni = (LAS unsigned*)(lds + att::KV_BYTES + 2048);
                        if (tid < qb * 64) km[tid] = KMEAN[((size_t)(b * 12 + h) * 8) * 64 + tid];
                        if (tid == 0) *uni = 0u;
                        __syncthreads();
                        const int r = lane & 31, hh = lane >> 5, tq = 32 * wave + r;
                        const size_t tok = (size_t)b * SEQ + 256 * qb + tq;
                        bf16x8 qf[4]; att::load_q(qf, QB + tok * MOBA_DIMC + h * 64, hh);
                        float gt[7];
#pragma unroll
                        for (int j = 0; j < 7; ++j) { float p = -INFINITY;
                            if (j < qb) { p = 0.f;
#pragma unroll
                                for (int ks = 0; ks < 4; ++ks)
#pragma unroll
                                    for (int jj = 0; jj < 8; ++jj) p += bf2f((unsigned short)qf[ks][jj]) * km[j * 64 + ks * 16 + hh * 8 + jj];
                                p += __shfl_xor(p, 32); }
                            gt[j] = p; }
                        unsigned sel = 0u;
#pragma unroll
                        for (int j = 0; j < 7; ++j) { int c = 0;
#pragma unroll
                            for (int j2 = 0; j2 < 7; ++j2) c += (gt[j2] > gt[j] || (gt[j2] == gt[j] && j2 < j)) ? 1 : 0;
                            if (j < qb && c < 3) sel |= 1u << j; }
                        { unsigned o = sel;
#pragma unroll
                          for (int s = 1; s < 64; s <<= 1) o |= __shfl_xor(o, s);
                          if (lane == 0 && o) atomicOr((unsigned*)uni, o); }
                        __syncthreads();
                        att::MobaMask mk; mk.qb = qb; mk.wq0 = 32 * wave; mk.tq = tq; mk.sel = sel; mk.uni = __builtin_amdgcn_readfirstlane(*uni);
                        att::State st; att::reset(st);
                        att::flash_run<att::MobaMask, false>(lds, KB + (size_t)b * SEQ * MOBA_DIMC + h * 64, VB + (size_t)b * SEQ * MOBA_DIMC + h * 64, MOBA_DIMC, 0, 4 * (qb + 1), qf, st, mk, tid);
                        att::store_o(YB + tok * DM + 256 + h * 64, st.o0, st.o1, st.l > 0.f ? 1.f / st.l : 0.f, hh);
                        __syncthreads();
                    } else {
                        const int pu = u - 768, tok0 = pu * 32, t0 = tok0 & (SEQ - 1);
                        LAS float* ub = (LAS float*)lds;
                        LAS float* pl = (LAS float*)(lds + 47 * 1024);
                        for (int idx = tid; idx < 47 * 64; idx += 512) { const int rr = idx >> 6, c4 = (idx & 63) * 4; const int t = t0 - 15 + rr;
                            f32x4 v = {0.f, 0.f, 0.f, 0.f}; if (t >= 0) v = *(const f32x4*)(UPOOL + (size_t)(tok0 - 15 + rr) * 256 + c4);
                            *(LAS f32x4*)(ub + rr * 256 + c4) = v; }
                        __syncthreads();
                        for (int idx = tid; idx < 32 * 256; idx += 512) { const int tt = idx >> 8, c = idx & 255, w = 2 << (c >> 6), t = t0 + tt;
                            const int cnt = (t + 1 < w) ? t + 1 : w; float s = 0.f;
                            for (int q = 0; q < cnt; ++q) s += ub[(15 + tt - q) * 256 + c];
                            pl[idx] = s / (float)cnt - ub[(15 + tt) * 256 + c]; }
                        __syncthreads();
                        { const int c = tid & 255, hf = tid >> 8, gi = c >> 6, d = c & 63;
                          const float* pw = (const float*)INP(7) + ((size_t)(i2 * 4 + gi) * 64) * 64 + d; const float sc = ((const float*)INP(8))[i2 * 256 + c];
                          float a[16];
#pragma unroll
                          for (int q = 0; q < 16; ++q) a[q] = 0.f;
                          for (int k = 0; k < 64; ++k) { const float wv = pw[k * 64];
#pragma unroll
                              for (int q = 0; q < 16; ++q) a[q] += pl[(hf * 16 + q) * 256 + gi * 64 + k] * wv; }
#pragma unroll
                          for (int q = 0; q < 16; ++q) YB[(size_t)(tok0 + hf * 16 + q) * DM + c] = (bf16)f2bf(a[q] * sc); }
                        __syncthreads();
                    }
                }
            } else if (ON(8) && !even) {
                for (int u = bx; u < 1024; u += G) {
                    const int tb = 31 - u / 32, bg = u % 32, b = bg >> 2, g = bg & 3;
                    LAS float* pslc = (LAS float*)(lds + att::KV_BYTES);
                    LAS float* sc = (LAS float*)(lds + att::KV_BYTES + 32768);
                    LAS unsigned* selm = (LAS unsigned*)(lds + att::KV_BYTES + 65536);
                    LAS float* yst = (LAS float*)(lds + att::KV_BYTES) + (size_t)wave * 32 * 64 + lane;
                    const int r = lane & 31, hh = lane >> 5, hd = wave & 3, th = wave >> 2, tq = 32 * th + r, t = 64 * tb + tq;
                    const size_t tok = (size_t)b * SEQ + t; const int head = g * 4 + hd;
                    f32x16 y0, y1;
                    bf16x8 qf[4];
                    att::State st;
                    {
                        att::load_q(qf, QRAW + tok * DM + head * 64, hh);
                        att::CmpMask mk; mk.nmax = (t >= 31) ? ((t - 31) >> 4) : -1;
                        const int tlo = 64 * tb + 32 * th, thi = tlo + 31; mk.nlo = (tlo >= 31) ? ((tlo - 31) >> 4) : -1; mk.nhi = (thi >= 31) ? ((thi - 31) >> 4) : -1;
                        att::reset(st);
                        att::flash_run<att::CmpMask, true>(lds, KCMP + (size_t)bg * 128 * 64, VCMP + (size_t)bg * 128 * 64, 64, 0, tb <= 15 ? 1 : 2, qf, st, mk, tid);
                        const float inv = st.l > 0.f ? 1.f / st.l : 0.f, sg = inv * GATES[tok * 48 + head * 3 + 0];
                        y0 = st.o0 * sg; y1 = st.o1 * sg;
#pragma unroll
                        for (int i = 0; i < 16; ++i) pslc[(hd * 64 + tq) * 32 + (i & 3) + 8 * (i >> 2) + 4 * hh] = st.o2[i] * inv;
                    }
                    __syncthreads();
#pragma nounroll
                    for (int p = 0; p < 4; ++p) { const int tt = p * 16 + (tid >> 5), j = tid & 31;
                        float v = -1.f;
                        if (j <= tb) v = (j == 0 || j == tb || j == tb - 1) ? 1e4f : ((pslc[(0 * 64 + tt) * 32 + j] + pslc[(1 * 64 + tt) * 32 + j]) + (pslc[(2 * 64 + tt) * 32 + j] + pslc[(3 * 64 + tt) * 32 + j]));
                        sc[tt * 32 + j] = v; }
                    __syncthreads();
#pragma nounroll
                    for (int p = 0; p < 4; ++p) { const int tt = p * 16 + (tid >> 5), j = tid & 31; const float my = sc[tt * 32 + j]; int c = 0;
#pragma unroll 8
                        for (int j2 = 0; j2 < 32; ++j2) { const float o = sc[tt * 32 + j2]; c += (o > my || (o == my && j2 < j)) ? 1 : 0; }
                        const unsigned long long bm = __ballot(c < 16 && j <= tb);
                        if ((lane & 31) == 0) selm[tt] = (unsigned)(bm >> (lane & 32)); }
                    __syncthreads();
                    unsigned uni;
                    { unsigned o = selm[lane];
#pragma unroll
                      for (int s = 1; s < 64; s <<= 1) o |= __shfl_xor(o, s);
                      uni = __builtin_amdgcn_readfirstlane(o); }
                    const unsigned sel = selm[tq];
                    __syncthreads();
#pragma unroll
                    for (int i = 0; i < 16; ++i) { yst[i * 64] = y0[i]; yst[(16 + i) * 64] = y1[i]; }
                    att::load_q(qf, QROT + tok * DM + head * 64, hh);
                    {
                        att::SelMask mk; mk.tb = tb; mk.tq = tq; mk.wq0 = 32 * th; mk.sel = sel; mk.uni = uni;
                        att::reset(st);
                        att::flash_run<att::SelMask, false>(lds, KSB + (size_t)b * SEQ * 256 + g * 64, VSB + (size_t)b * SEQ * 256 + g * 64, 256, 0, tb + 1, qf, st, mk, tid);
                        const float sg = (st.l > 0.f ? 1.f / st.l : 0.f) * GATES[tok * 48 + head * 3 + 1];
#pragma unroll
                        for (int i = 0; i < 16; ++i) { yst[i * 64] += st.o0[i] * sg; yst[(16 + i) * 64] += st.o1[i] * sg; }
                    }
                    {
                        att::WinMask mk; mk.tb = tb; mk.tq = tq;
                        att::reset(st);
                        att::flash_run<att::WinMask, false>(lds, KWB + (size_t)b * SEQ * 256 + g * 64, VWB + (size_t)b * SEQ * 256 + g * 64, 256, tb >= 8 ? tb - 8 : 0, tb + 1, qf, st, mk, tid);
                        const float sg = (st.l > 0.f ? 1.f / st.l : 0.f) * GATES[tok * 48 + head * 3 + 2];
#pragma unroll
                        for (int i = 0; i < 16; ++i) { y0[i] = yst[i * 64] + st.o0[i] * sg; y1[i] = yst[(16 + i) * 64] + st.o1[i] * sg; }
                    }
                    att::store_o(YB + tok * DM + head * 64, y0, y1, 1.f, hh);
                    __syncthreads();
                }
            }
            BAR_AFTER(pb + 3);
        }
        if (ON(9) && IN(pb + 4)) {
            PHASE_IDS
            const bf16* W = even ? (const bf16*)(ws + WS_W_OUTAB) + (size_t)i2 * DM * DM : (const bf16*)(ws + WS_W_OUTC) + (size_t)i2 * DM * DM;
            pg8::Gemm g{YB, W, DM, DM, DM}; pg8::StaticOrder S; S.init(MTOK, DM, G, bx, DM, DM);
            pg8::EpiRes E{X, XB, SSQ};
            pg8::gemm_phase<pg8::EpiRes, pg8::StaticOrder>(lds, g, S, E, tid);
            BAR_AFTER(pb + 4);
        }
        if (ON(10) && IN(pb + 5)) {
            PHASE_IDS
            pg8::Gemm g{XB, (const bf16*)(ws + WS_W_XQ) + (size_t)l * 256 * DM, DM, DM, DM}; pg8::StaticOrder S; S.init(MTOK, 256, G, bx, DM, DM);
            pg8::EpiXQ E{SSQ, XQ};
            pg8::gemm_phase<pg8::EpiXQ, pg8::StaticOrder>(lds, g, S, E, tid);
            BAR_AFTER(pb + 5);
        }
        if (ON(11) && IN(pb + 6)) {
            PHASE_IDS
            for (int u = bx; u < 256; u += G) {
                const int b = u >> 5, h = (u >> 3) & 3, qt = u & 7;
                const int r = lane & 31, hh = lane >> 5;
                const size_t tok = (size_t)b * SEQ + 256 * qt + 32 * wave + r;
                bf16x8 qf[4]; att::load_q(qf, XQ + tok * 256 + h * 64, hh);
                att::NoMask mk; att::State st; att::reset(st);
                att::flash_run<att::NoMask, false>(lds, XK + ((size_t)l * NB * MEML + (size_t)b * MEML) * 256 + h * 64, XV + ((size_t)l * NB * MEML + (size_t)b * MEML) * 256 + h * 64, 256, 0, 4, qf, st, mk, tid);
                att::store_o(XO + tok * 256 + h * 64, st.o0, st.o1, 1.f / st.l, hh);
            }
            BAR_AFTER(pb + 6);
        }
        if (ON(12) && IN(pb + 7)) {
            PHASE_IDS
            pg8::Gemm g{XO, (const bf16*)(ws + WS_W_XO) + (size_t)l * DM * 256, 256, 256, 256}; pg8::StaticOrder S; S.init(MTOK, DM, G, bx, 256, 256);
            pg8::EpiRes E{X, XB, SSQ};
            pg8::gemm_phase<pg8::EpiRes, pg8::StaticOrder>(lds, g, S, E, tid);
            BAR_AFTER(pb + 7);
        }
        if (IN(pb + 8)) {
            PHASE_IDS
            if (ON(13) && even) {
                pg8::Gemm g{XB, (const bf16*)(ws + WS_W_FFNGU) + (size_t)i2 * 2 * DFF * DM, DM, DM, DM}; pg8::StaticOrder S; S.init(MTOK, 2 * DFF, G, bx, DM, DM);
                pg8::EpiGateUp<false> E{SSQ, nullptr, HB, DFF};
                pg8::gemm_phase<pg8::EpiGateUp<false>, pg8::StaticOrder>(lds, g, S, E, tid);
            } else if (ON(14) && !even) {
                for (int idx = bx * 512 + tid; idx < MOE_MAX_ROWS; idx += G * 512) ROWTOK[idx] = -1;
                const float* gn = norm_g + (l * 3 + 2) * DM; const float* rw = (const float*)INP(21) + (size_t)i2 * DM * NEXP;
                for (int m = gw; m < MTOK; m += NGW) {
                    f32x4 v[4]; const float s = load_row4(X + (size_t)m * DM, lane, v); const float rstd = rsqrtf(s * (1.f / DM) + NORM_EPS);
                    float lg[NEXP];
#pragma unroll
                    for (int e = 0; e < NEXP; ++e) lg[e] = 0.f;
#pragma unroll
                    for (int j = 0; j < 4; ++j) { const f32x4 gv = *(const f32x4*)(gn + 4 * lane + 256 * j);
#pragma unroll
                        for (int q = 0; q < 4; ++q) { const float hv = v[j][q] * gv[q]; const float* wr_ = rw + (size_t)(4 * lane + 256 * j + q) * NEXP; const f32x4 w0 = *(const f32x4*)wr_, w1 = *(const f32x4*)(wr_ + 4);
                            lg[0] += hv * w0[0]; lg[1] += hv * w0[1]; lg[2] += hv * w0[2]; lg[3] += hv * w0[3]; lg[4] += hv * w1[0]; lg[5] += hv * w1[1]; lg[6] += hv * w1[2]; lg[7] += hv * w1[3]; } }
#pragma unroll
                    for (int e = 0; e < NEXP; ++e) lg[e] = wave_sum(lg[e]) * rstd;
                    int e0 = 0; float v0 = lg[0];
#pragma unroll
                    for (int e = 1; e < NEXP; ++e) if (lg[e] > v0) { v0 = lg[e]; e0 = e; }
                    int e1 = -1; float v1 = -INFINITY;
#pragma unroll
                    for (int e = 0; e < NEXP; ++e) if (e != e0 && lg[e] > v1) { v1 = lg[e]; e1 = e; }
                    if (lane == 0) {
                        const float w1 = 1.f / (1.f + expf(v0 - v1)), w0 = 1.f - w1;
                        const int p0 = (int)xb_add(ctl + CW_CNT + (i2 * NEXP + e0) * 64, 1u), p1 = (int)xb_add(ctl + CW_CNT + (i2 * NEXP + e1) * 64, 1u);
                        TOKE[2 * m] = e0; TOKE[2 * m + 1] = e1; TOKPOS[2 * m] = p0; TOKPOS[2 * m + 1] = p1; TOKW[2 * m] = w0; TOKW[2 * m + 1] = w1; TOKRSTD[m] = rstd;
                    }
                }
            }
            BAR_AFTER(pb + 8);
        }
        if (IN(pb + 9)) {
            PHASE_IDS
            if (ON(15) && even) {
                pg8::Gemm g{HB, (const bf16*)(ws + WS_W_FFND) + (size_t)i2 * DM * DFF, DFF, DFF, DFF}; pg8::StaticOrder S; S.init(MTOK, DM, G, bx, DFF, DFF);
                pg8::EpiRes E{X, XB, SSQ};
                pg8::gemm_phase<pg8::EpiRes, pg8::StaticOrder>(lds, g, S, E, tid);
            } else if (ON(16) && !even) {
                int base[NEXP]; int acc_t = 0;
#pragma unroll
                for (int e = 0; e < NEXP; ++e) { const int c = (int)xb_ld(ctl + CW_CNT + (i2 * NEXP + e) * 64); base[e] = acc_t * 256; const int nt_ = (c + 255) >> 8;
                    if (bx == 0 && tid == 0) for (int q = 0; q < nt_; ++q) TILEE[acc_t + q] = e;
                    acc_t += nt_; }
                if (bx == 0 && tid == 0) TILEE[MOE_MAX_TILES] = acc_t;
                for (int m = gw; m < MTOK; m += NGW) {
                    const int e0 = TOKE[2 * m], e1 = TOKE[2 * m + 1];
                    int b0 = 0, b1 = 0;
#pragma unroll
                    for (int e = 0; e < NEXP; ++e) { b0 = (e == e0) ? base[e] : b0; b1 = (e == e1) ? base[e] : b1; }
                    const int r0 = b0 + TOKPOS[2 * m], r1 = b1 + TOKPOS[2 * m + 1];
                    const u32x4 a = *(const u32x4*)(XB + (size_t)m * DM + 8 * lane), c = *(const u32x4*)(XB + (size_t)m * DM + 512 + 8 * lane);
                    *(u32x4*)(XPERM + (size_t)r0 * DM + 8 * lane) = a; *(u32x4*)(XPERM + (size_t)r0 * DM + 512 + 8 * lane) = c;
                    *(u32x4*)(XPERM + (size_t)r1 * DM + 8 * lane) = a; *(u32x4*)(XPERM + (size_t)r1 * DM + 512 + 8 * lane) = c;
                    if (lane == 0) { const float rs_ = TOKRSTD[m]; ROWTOK[r0] = 2 * m; ROWTOK[r1] = 2 * m + 1; ROWW[r0] = TOKW[2 * m]; ROWW[r1] = TOKW[2 * m + 1]; ROWRSTD[r0] = rs_; ROWRSTD[r1] = rs_; }
                }
            }
            BAR_AFTER(pb + 9);
        }
        if (ON(17) && IN(pb + 10) && !even) {
            PHASE_IDS
            pg8::Gemm g{XPERM, (const bf16*)(ws + WS_W_MOEGU), DM, DM, DM}; pg8::MoeOrder S{TILEE, 2 * DFFE / 256, G, bx, DM, DM, 2 * DFFE};
            pg8::EpiGateUp<true> E{nullptr, ROWRSTD, HB, DFFE};
            pg8::gemm_phase<pg8::EpiGateUp<true>, pg8::MoeOrder>(lds, g, S, E, tid);
            BAR_AFTER(pb + 10);
        }
        if (ON(18) && IN(pb + 11) && !even) {
            PHASE_IDS
            pg8::Gemm g{HB, (const bf16*)(ws + WS_W_MOED), DFFE, DFFE, DFFE}; pg8::MoeOrder S{TILEE, DM / 256, G, bx, DFFE, DFFE, DM};
            pg8::EpiMoeDown E{ROWTOK, ROWW, YMOE};
            pg8::gemm_phase<pg8::EpiMoeDown, pg8::MoeOrder>(lds, g, S, E, tid);
            BAR_AFTER(pb + 11);
        }
        if (ON(19) && IN(pb + 12) && !even) {
            PHASE_IDS
            if (l == 1) {
                LAS ConvJob* jobsw = (LAS ConvJob*)(lds + 72 * 1024);
                LAS int* jmeta = (LAS int*)(lds + 80 * 1024);
                if (tid == 0) {
                    int nj = 0, tot = 0;
#pragma nounroll
                    for (int e = 0; e < NEXP; ++e) {
                        ADD_JOB((const float*)INP(22) + (size_t)(NEXP + e) * DM * DFFE, (bf16*)(ws + WS_W_MOEGU) + (size_t)e * 2 * DFFE * DM, norm_g + (3 * 3 + 2) * DM, DM, DFFE, 1);
                        ADD_JOB((const float*)INP(23) + (size_t)(NEXP + e) * DM * DFFE, (bf16*)(ws + WS_W_MOEGU) + (size_t)e * 2 * DFFE * DM, norm_g + (3 * 3 + 2) * DM, DM, DFFE, 2);
                        ADD_JOB((const float*)INP(24) + (size_t)(NEXP + e) * DFFE * DM, (bf16*)(ws + WS_W_MOED) + (size_t)e * DM * DFFE, (const float*)nullptr, DFFE, DM, 0);
                    }
                    jmeta[0] = nj; jmeta[1] = tot;
                }
                __syncthreads();
                run_conv_jobs(lds, jmeta[0], jmeta[1], gw, NGW, wave, lane);
            }
            for (int m = gw; m < MTOK; m += NGW) {
                f32x4 v[4]; float s = 0.f;
#pragma unroll
                for (int j = 0; j < 4; ++j) { const size_t o = (size_t)m * DM + 4 * lane + 256 * j;
                    v[j] = (*(const f32x4*)(X + o) + *(const f32x4*)(YMOE + o)) + *(const f32x4*)(YMOE + (size_t)MTOK * DM + o);
                    s += (v[j][0] * v[j][0] + v[j][1] * v[j][1]) + (v[j][2] * v[j][2] + v[j][3] * v[j][3]); }
                s = wave_sum(s);
                if (l == 3) { const float r = rsqrtf(s * (1.f / DM) + NORM_EPS);
#pragma unroll
                    for (int j = 0; j < 4; ++j) *(f32x4*)(X + (size_t)m * DM + 4 * lane + 256 * j) = v[j] * r * *(const f32x4*)(final_g + 4 * lane + 256 * j);
                } else {
#pragma unroll
                    for (int j = 0; j < 4; ++j) *(f32x4*)(X + (size_t)m * DM + 4 * lane + 256 * j) = v[j];
                    store_row_bf16(XB + (size_t)m * DM, lane, v); store_ssq_full(SSQ, m, s, lane);
                }
            }
            BAR_AFTER(pb + 12);
        }
    }
#undef IN
#undef BAR_AFTER
}
#undef ws
#undef ctl
#undef X

static bool phase_applies(int p) {
    if (p < 2) return true;
    const int l = (p - 2) / 13, k = (p - 2) % 13; const bool even = (l & 1) == 0;
    if (even) return k != 2 && k < 10;
    return true;
}
extern "C" void kernel_launch(void* const* d_in, const int* in_sizes, int n_in, void* d_out, int out_size, void* d_ws, size_t ws_size, hipStream_t stream) {
    static int grid = 0;
    if (grid == 0) {
        if (n_in != 28 || out_size != MTOK * DM || ws_size < WS_END) { fprintf(stderr, "kernel_launch: unexpected shapes (n_in %d out %d ws %zu need %zu)\n", n_in, out_size, ws_size, (size_t)WS_END); grid = -1; return; }
        int dev = 0, cus = 0;
        if (hipGetDevice(&dev) != hipSuccess || hipDeviceGetAttribute(&cus, hipDeviceAttributeMultiprocessorCount, dev) != hipSuccess) { grid = -1; return; }
        if (hipFuncSetAttribute((const void*)mk_fwd, hipFuncAttributeMaxDynamicSharedMemorySize, LDS_BYTES) != hipSuccess) { fprintf(stderr, "kernel_launch: hipFuncSetAttribute failed\n"); grid = -1; return; }
        int per_cu = 0;
        if (hipOccupancyMaxActiveBlocksPerMultiprocessor(&per_cu, (const void*)mk_fwd, NWAVES * 64, LDS_BYTES) != hipSuccess || per_cu < 1) fprintf(stderr, "kernel_launch: occupancy query reports %d\n", per_cu);
        (void)hipGetLastError();
        grid = cus;
    }
    if (grid < 0) return;
    (void)hipMemsetAsync((char*)d_ws + WS_CTL, 0, CTL_ZERO_BYTES, stream);
    Args a{};
    for (int i = 0; i < 28; ++i) a.in[i] = d_in[i];
    a.out = (float*)d_out; a.ws = (unsigned char*)d_ws;
    for (int j = 0; j < 8; ++j) a.invf[j] = pow(500000.0, -(double)(2 * j) / 16.0);
#if MK_SINGLE
    a.ph_lo = 0; a.ph_hi = NPH;
    hipLaunchKernelGGL(mk_fwd, dim3(grid), dim3(NWAVES * 64), LDS_BYTES, stream, a);
#else
    for (int p = 0; p < NPH; ++p) {
        if (!phase_applies(p)) continue;
        a.ph_lo = p; a.ph_hi = p + 1;
        hipLaunchKernelGGL(mk_fwd, dim3(grid), dim3(NWAVES * 64), LDS_BYTES, stream, a);
    }
#endif
}
```

```cpp
#include <hip/hip_runtime.h>
#include <cstdio>
#include <cstdint>
#include <cmath>
#include <cstddef>

#ifndef MK_SINGLE
#define MK_SINGLE 1
#endif

#ifndef PHMASK
#define PHMASK 0xFFFFFFu
#endif
#define ON(n) (((PHMASK) >> (n)) & 1u)
#define GAS __attribute__((address_space(1)))
#define LAS __attribute__((address_space(3)))
typedef unsigned short bf16;
typedef short bf16x8 __attribute__((ext_vector_type(8)));
typedef short s16x4 __attribute__((ext_vector_type(4)));
typedef float f32x4 __attribute__((ext_vector_type(4)));
typedef float f32x2 __attribute__((ext_vector_type(2)));
typedef float f32x16 __attribute__((ext_vector_type(16)));
typedef unsigned u32x4 __attribute__((ext_vector_type(4)));
typedef unsigned u32x2 __attribute__((ext_vector_type(2)));
typedef __bf16 bf16x2_t __attribute__((ext_vector_type(2)));

constexpr int NB = 8, SEQ = 2048, DM = 1024, MTOK = NB * SEQ, MEML = 256;
constexpr int AB_IN = 2560, MOBA_DIMC = 768, C_IN = 2608, C_IN_PAD = 2816;
constexpr int DFF = 2816, DFFE = 3584, NEXP = 8;
constexpr int MOE_MAX_TILES = 136, MOE_MAX_ROWS = MOE_MAX_TILES * 256;
constexpr int CMP_SPLIT = 8;
constexpr float NORM_EPS = 1e-5f;
constexpr float C2 = 0.125f * 1.4426950408889634f;

constexpr size_t MiB = 1u << 20, KiB = 1024;
constexpr size_t WS_CTL = 0, CTL_ZERO_BYTES = 64 * KiB;
constexpr size_t WS_W_INAB = 1 * MiB, WS_W_OUTAB = 11 * MiB, WS_W_FFNGU = 15 * MiB, WS_W_FFND = 37 * MiB, WS_W_INC = 48 * MiB, WS_W_CW1 = 59 * MiB,
                 WS_W_OUTC = 63 * MiB, WS_W_XQ = 67 * MiB, WS_W_XKV = 69 * MiB, WS_W_XO = 73 * MiB, WS_W_MOEGU = 75 * MiB, WS_W_MOED = 187 * MiB;
constexpr size_t WS_XB = 243 * MiB, WS_SSQ = 275 * MiB, WS_MISC = 276 * MiB, WS_MEMB = 280 * MiB, WS_XK = 284 * MiB, WS_XV = 288 * MiB,
                 WS_YB = 292 * MiB, WS_XQ = 324 * MiB, WS_XO = 332 * MiB, WS_ROUTE = 340 * MiB, WS_REGA = 342 * MiB, WS_REGB = 538 * MiB, WS_END = 776 * MiB;
constexpr size_t MISC_CS = 0, MISC_KMEAN = 128 * KiB, MISC_KCMP = 512 * KiB, MISC_VCMP = 1024 * KiB;
constexpr size_t RT_TOKE = 0, RT_TOKPOS = 128 * KiB, RT_TOKW = 256 * KiB, RT_TOKRSTD = 384 * KiB, RT_ROWTOK = 512 * KiB, RT_ROWW = 704 * KiB, RT_ROWRSTD = 896 * KiB, RT_TILEE = 1088 * KiB;
constexpr size_t RA_UPOOL = 0, RA_QB = 16 * MiB, RA_KB = 40 * MiB, RA_VB = 64 * MiB;
constexpr size_t RA_QRAW = 0, RA_QROT = 32 * MiB, RA_ACMPK = 64 * MiB, RA_ACMPV = 80 * MiB, RA_KS = 96 * MiB, RA_VS = 104 * MiB, RA_KW = 112 * MiB, RA_VW = 120 * MiB,
                 RA_GATES = 128 * MiB, RA_CPART = 132 * MiB;
constexpr size_t RA_YMOE = 0, RA_XPERM = 128 * MiB;
constexpr int CW_BAR = 4096, CW_CNT = 8192;

constexpr int RING_BYTES = 131072, LDSCTL_OFF = RING_BYTES, MISC_OFF = LDSCTL_OFF + 320, LDS_BYTES = 147456;
constexpr int NWAVES = 8;

__device__ __forceinline__ unsigned f2bf(float f) { unsigned u = __builtin_bit_cast(unsigned, f); return (u + 0x7fffu + ((u >> 16) & 1u)) >> 16; }
__device__ __forceinline__ unsigned pk2(float lo, float hi) { f32x2 v = {lo, hi}; bf16x2_t b = __builtin_convertvector(v, bf16x2_t); return __builtin_bit_cast(unsigned, b); }
__device__ __forceinline__ float bf2f(unsigned short b) { return __builtin_bit_cast(float, (unsigned)b << 16); }
__device__ __forceinline__ float wave_sum(float v) {
#pragma unroll
    for (int o = 1; o < 64; o <<= 1) v += __shfl_xor(v, o);
    return v;
}
__device__ __forceinline__ float fast_exp2(float x) { return __builtin_amdgcn_exp2f(x); }
__device__ __forceinline__ float fast_rcp(float x) { return __builtin_amdgcn_rcpf(x); }
__device__ __forceinline__ float silu_f(float x) { return x * fast_rcp(1.f + fast_exp2(-1.4426950408889634f * x)); }
__device__ __forceinline__ float sigmoid_f(float x) { return fast_rcp(1.f + fast_exp2(-1.4426950408889634f * x)); }
__device__ __forceinline__ float gelu_tanh_f(float x) {
    const float u = 0.7978845608028654f * (x + 0.044715f * x * x * x);
    const float t = 1.f - 2.f * fast_rcp(1.f + fast_exp2(2.f * 1.4426950408889634f * u));
    return 0.5f * x * (1.f + t);
}
#define LDS_WAIT() asm volatile("s_waitcnt lgkmcnt(0)" ::: "memory")

namespace pg8 {
#define PG8_LAS __attribute__((address_space(3)))
constexpr int BM = 256, BK = 64, HALF = 128, HTB = HALF * BK * 2, NXCD = 8, WGM = 8;
__host__ __device__ __forceinline__ int lds_byte(int r, int c) { const int st = (r >> 4) * 2 + (c >> 5), rr = r & 15, cc = c & 31, ob = rr * 64 + cc * 2; return st * 1024 + (ob ^ (((ob >> 9) & 1) << 5)); }
__host__ __device__ __forceinline__ void stage_rc(int b, int& R, int& C) { const int st = b / 1024, sb = b % 1024, swz = sb ^ (((sb >> 9) & 1) << 5); R = (st >> 1) * 16 + swz / 64; C = (st & 1) * 32 + (swz % 64) / 2; }
__host__ __device__ __forceinline__ int perm32(int rho) { const int n = rho >> 4, i = rho & 15; return 8 * (i >> 2) + 4 * n + (i & 3); }

struct Unit { int pm, pn, aux; size_t oa, ob; };
struct Gemm { const bf16* A; const bf16* Bt; int lda, ldb, K; };

struct StaticOrder {
    int nM, nN, nwg, G, c, lda, ldb;
    __device__ void init(int M, int N, int G_, int c_, int lda_, int ldb_) { nM = M / BM; nN = N / BM; nwg = nM * nN; G = G_; c = c_; lda = lda_; ldb = ldb_; }
    __device__ bool next(int i, Unit& u) const {
        const long L = (long)i * G + c; if (L >= nwg) return false;
        int wgid = (int)L; { const int q = nwg / NXCD, r = nwg % NXCD, xcd = wgid % NXCD, off = wgid / NXCD; wgid = (xcd < r ? xcd * (q + 1) : r * (q + 1) + (xcd - r) * q) + off; }
        const int nig = WGM * nN, gid = wgid / nig, fm = gid * WGM, gsz = (nM - fm) < WGM ? (nM - fm) : WGM;
        u.pm = fm + ((wgid % nig) % gsz); u.pn = (wgid % nig) / gsz; u.aux = 0;
        u.oa = (size_t)u.pm * BM * lda * 2; u.ob = (size_t)u.pn * BM * ldb * 2; return true;
    }
};

template <class Epi, class Sched>
__device__ __forceinline__ void gemm_phase(PG8_LAS unsigned char* lds, const Gemm g, const Sched& S, const Epi& E, const int tid) {
    const int wid = __builtin_amdgcn_readfirstlane(tid >> 6), lane = tid & 63, wr = wid >> 2, wc = wid & 3, fr = lane & 15, fq = lane >> 4;
    const int K = g.K, nt = K / BK;
    unsigned voffA[2], voffB[2];
#pragma unroll
    for (int i = 0; i < 2; ++i) { int R, C; stage_rc(tid * 16 + i * 8192, R, C); const int Rb = Epi::PERM ? ((R & ~31) + perm32(R & 31)) : R;
        voffA[i] = (unsigned)(R * g.lda + C) * 2u; voffB[i] = (unsigned)(Rb * g.ldb + C) * 2u; }
    const size_t kstep = (size_t)(BK * 2);
    const size_t hstepA = (size_t)HALF * g.lda * 2, hstepB = (size_t)HALF * g.ldb * 2;
    const unsigned ldsw = (unsigned)wid * 1024u;
    const int aoff = lds_byte(wr * 64 + fr, fq * 8), boff = lds_byte(wc * 32 + fr, fq * 8);
#define PG8_SA(b, h) (((b) * 2 + (h)) * HTB)
#define PG8_SB(b, h) ((4 + (b) * 2 + (h)) * HTB)
#define PG8_STAGE(bufoff, gbase, voff) do { _Pragma("unroll") for (int _i = 0; _i < 2; ++_i) \
        __builtin_amdgcn_global_load_lds((const unsigned*)((const char*)(gbase) + (voff)[_i]), (PG8_LAS unsigned*)(lds + (bufoff) + ldsw + _i * 8192), 16, 0, 0); } while (0)
#define PG8_LDA(dst, b, h) do { _Pragma("unroll") for (int m = 0; m < 4; ++m) _Pragma("unroll") for (int k = 0; k < 2; ++k) dst[m][k] = *(const PG8_LAS bf16x8*)(lds + PG8_SA(b, h) + aoff + m * 2048 + k * 1024); } while (0)
#define PG8_LDB(dst, b, h) do { _Pragma("unroll") for (int n = 0; n < 2; ++n) _Pragma("unroll") for (int k = 0; k < 2; ++k) dst[n][k] = *(const PG8_LAS bf16x8*)(lds + PG8_SB(b, h) + boff + n * 2048 + k * 1024); } while (0)
#define PG8_MMA(ai, bj, At, Bt) do { __builtin_amdgcn_s_setprio(1); _Pragma("unroll") for (int m = 0; m < 4; ++m) _Pragma("unroll") for (int n = 0; n < 2; ++n) _Pragma("unroll") for (int k = 0; k < 2; ++k) \
        acc[ai][bj][m][n] = __builtin_amdgcn_mfma_f32_16x16x32_bf16(Bt[n][k], At[m][k], acc[ai][bj][m][n], 0, 0, 0); __builtin_amdgcn_s_setprio(0); } while (0)
#define PG8_WAIT_V(n) asm volatile("s_waitcnt vmcnt(" #n ")" ::: "memory")
#define PG8_WAIT_L(n) asm volatile("s_waitcnt lgkmcnt(" #n ")" ::: "memory")
#define PG8_BAR __builtin_amdgcn_s_barrier()
#define PG8_SCHED __builtin_amdgcn_sched_barrier(0)
    Unit cur, nxt; int ui = 0;
    if (!S.next(0, cur)) return;
    f32x4 acc[2][2][4][2];
#pragma unroll
    for (int a = 0; a < 2; ++a)
#pragma unroll
        for (int b = 0; b < 2; ++b)
#pragma unroll
            for (int m = 0; m < 4; ++m)
#pragma unroll
                for (int n = 0; n < 2; ++n) acc[a][b][m][n] = (f32x4){0.f, 0.f, 0.f, 0.f};
    bf16x8 At[4][2], B0[2][2], B1[2][2];
    const char* cA = (const char*)g.A + cur.oa; const char* cB = (const char*)g.Bt + cur.ob;
    PG8_STAGE(PG8_SB(0, 0), cB, voffB); PG8_STAGE(PG8_SB(0, 1), cB + hstepB, voffB); PG8_STAGE(PG8_SA(0, 0), cA, voffA); PG8_STAGE(PG8_SA(0, 1), cA + hstepA, voffA);
    if (wr == 1) PG8_BAR;
    PG8_WAIT_V(2); PG8_BAR;
    PG8_STAGE(PG8_SB(1, 0), cB + kstep, voffB); PG8_STAGE(PG8_SA(1, 0), cA + kstep, voffA); PG8_STAGE(PG8_SB(1, 1), cB + hstepB + kstep, voffB);
    PG8_WAIT_V(6); PG8_BAR;
    for (;;) {
        const bool has_next = S.next(ui + 1, nxt);
        const char* nA = has_next ? (const char*)g.A + nxt.oa : cA; const char* nB = has_next ? (const char*)g.Bt + nxt.ob : cB;
#pragma nounroll
        for (int t = 0; t < nt; t += 2) {
            const bool last = (t == nt - 2);
            const char* a1 = cA + (size_t)(t + 1) * kstep;
            const char* a2 = last ? nA : cA + (size_t)(t + 2) * kstep; const char* b2 = last ? nB : cB + (size_t)(t + 2) * kstep;
            const char* a3 = a2 + kstep; const char* b3 = b2 + kstep;
            PG8_LDB(B0, 0, 0); PG8_LDB(B1, 0, 1); PG8_SCHED; PG8_LDA(At, 0, 0); PG8_STAGE(PG8_SA(1, 1), a1 + hstepA, voffA);
            PG8_WAIT_V(8); PG8_WAIT_L(0); PG8_BAR; PG8_MMA(0, 0, At, B0); PG8_MMA(0, 1, At, B1); PG8_BAR; PG8_SCHED;
            PG8_LDA(At, 0, 1); PG8_STAGE(PG8_SB(0, 0), b2, voffB); PG8_STAGE(PG8_SB(0, 1), b2 + hstepB, voffB); PG8_STAGE(PG8_SA(0, 0), a2, voffA);
            PG8_WAIT_V(8); PG8_WAIT_L(0); PG8_BAR; PG8_MMA(1, 0, At, B0); PG8_MMA(1, 1, At, B1); PG8_BAR; PG8_SCHED;
            PG8_LDB(B0, 1, 0); PG8_LDB(B1, 1, 1); PG8_SCHED; PG8_LDA(At, 1, 0); PG8_STAGE(PG8_SA(0, 1), a2 + hstepA, voffA);
            PG8_WAIT_V(8); PG8_WAIT_L(0); PG8_BAR; PG8_MMA(0, 0, At, B0); PG8_MMA(0, 1, At, B1); PG8_BAR; PG8_SCHED;
            PG8_LDA(At, 1, 1); PG8_STAGE(PG8_SB(1, 0), b3, voffB); PG8_STAGE(PG8_SB(1, 1), b3 + hstepB, voffB); PG8_STAGE(PG8_SA(1, 0), a3, voffA);
            PG8_WAIT_V(8); PG8_WAIT_L(0); PG8_BAR; PG8_MMA(1, 0, At, B0); PG8_MMA(1, 1, At, B1); PG8_BAR; PG8_SCHED;
        }
        if (wr == 0) PG8_BAR;
        { int fr_ = fr, fq_ = fq; asm volatile("" : "+v"(fr_), "+v"(fq_)); E(acc, cur, wr, wc, fr_, fq_); }
        if (!has_next) break;
#pragma unroll
        for (int a = 0; a < 2; ++a)
#pragma unroll
            for (int b = 0; b < 2; ++b)
#pragma unroll
                for (int m = 0; m < 4; ++m)
#pragma unroll
                    for (int n = 0; n < 2; ++n) acc[a][b][m][n] = (f32x4){0.f, 0.f, 0.f, 0.f};
        cur = nxt; cA = nA; cB = nB; ++ui;
        if (wr == 1) PG8_BAR;
    }
    PG8_WAIT_V(0);
    PG8_BAR;
#undef PG8_SA
#undef PG8_SB
#undef PG8_STAGE
#undef PG8_LDA
#undef PG8_LDB
#undef PG8_MMA
#undef PG8_WAIT_V
#undef PG8_WAIT_L
#undef PG8_BAR
#undef PG8_SCHED
}

typedef f32x4 Acc[2][2][4][2];

__device__ __forceinline__ void load_rstd(const float* ssq, int row0, int fq, float (&rs)[2][4]) {
#pragma unroll
    for (int ai = 0; ai < 2; ++ai)
#pragma unroll
        for (int m = 0; m < 4; ++m) {
            const float* p = ssq + (size_t)(fq * 4) * MTOK + row0 + ai * HALF + m * 16;
            float s = (p[0] + p[MTOK]) + (p[2 * MTOK] + p[3 * MTOK]);
            s += __shfl_xor(s, 16); s += __shfl_xor(s, 32);
            rs[ai][m] = rsqrtf(s * (1.f / DM) + NORM_EPS);
        }
}
__device__ __forceinline__ float row_rstd(const float* ssq, int row, int fq) {
    const float* p = ssq + (size_t)(fq * 4) * MTOK + row;
    float s = (p[0] + p[MTOK]) + (p[2 * MTOK] + p[3 * MTOK]);
    s += __shfl_xor(s, 16); s += __shfl_xor(s, 32);
    return rsqrtf(s * (1.f / DM) + NORM_EPS);
}
__device__ __forceinline__ u32x4 pack8(const f32x4& a, const f32x4& b) { u32x4 w; w.x = pk2(a[0], a[1]); w.y = pk2(a[2], a[3]); w.z = pk2(b[0], b[1]); w.w = pk2(b[2], b[3]); return w; }
__device__ __forceinline__ void rope8(f32x4& v0, f32x4& v1, const float* cs, int fq) {
    const f32x4 c0 = *(const f32x4*)(cs), c1 = *(const f32x4*)(cs + 4), s0 = *(const f32x4*)(cs + 8), s1 = *(const f32x4*)(cs + 12);
    f32x4 p0, p1;
#pragma unroll
    for (int e = 0; e < 4; ++e) { p0[e] = __shfl_xor(v0[e], 16); p1[e] = __shfl_xor(v1[e], 16); }
    if (fq == 0) { v0 = v0 * c0 - p0 * s0; v1 = v1 * c1 - p1 * s1; }
    else if (fq == 1) { v0 = p0 * s0 + v0 * c0; v1 = p1 * s1 + v1 * c1; }
}

struct EpiInAB {
    static constexpr bool PERM = true;
    const float* ssq; const float* cs; unsigned char* ra;
    __device__ __forceinline__ void operator()(const Acc& acc, const Unit& u, int wr, int wc, int fr, int fq) const {
        const int row0 = u.pm * BM + wr * 64 + fr;
        float rs[2][4]; load_rstd(ssq, row0, fq, rs);
        if (u.pn == 0) {
#pragma unroll
            for (int ai = 0; ai < 2; ++ai)
#pragma unroll
                for (int m = 0; m < 4; ++m) { const int row = row0 + ai * HALF + m * 16; float* rp = (float*)(ra + RA_UPOOL) + (size_t)row * 256 + wc * 32 + fq * 8;
#pragma unroll
                    for (int bj = 0; bj < 2; ++bj) { *(f32x4*)(rp + bj * HALF) = acc[ai][bj][m][0] * rs[ai][m]; *(f32x4*)(rp + bj * HALF + 4) = acc[ai][bj][m][1] * rs[ai][m]; } }
        } else {
            const int t = (u.pn - 1) / 3, cb = ((u.pn - 1) % 3) * 256;
            bf16* dst = (bf16*)(ra + RA_QB + (size_t)t * (RA_KB - RA_QB));
            const bool rope = (t < 2) && ((wc & 1) == 0);
#pragma unroll
            for (int ai = 0; ai < 2; ++ai)
#pragma unroll
                for (int m = 0; m < 4; ++m) { const int row = row0 + ai * HALF + m * 16; bf16* rp = dst + (size_t)row * MOBA_DIMC + cb + wc * 32 + fq * 8;
                    const float* csr = cs + (size_t)(row & (SEQ - 1)) * 16;
#pragma unroll
                    for (int bj = 0; bj < 2; ++bj) { f32x4 v0 = acc[ai][bj][m][0] * rs[ai][m], v1 = acc[ai][bj][m][1] * rs[ai][m];
                        if (rope) rope8(v0, v1, csr, fq);
                        *(u32x4*)(rp + bj * HALF) = pack8(v0, v1); } }
        }
    }
};

struct EpiInC {
    static constexpr bool PERM = true;
    const float* ssq; const float* cs; unsigned char* ra; const float* pek; const float* pev;
    __device__ __forceinline__ void operator()(const Acc& acc, const Unit& u, int wr, int wc, int fr, int fq) const {
        const int row0 = u.pm * BM + wr * 64 + fr;
        const int pn = u.pn;
        const bool rope = ((wc & 1) == 0);
        if (pn < 4) {
#pragma unroll
            for (int ai = 0; ai < 2; ++ai)
#pragma unroll
                for (int m = 0; m < 4; ++m) { const int row = row0 + ai * HALF + m * 16; const float rsv = row_rstd(ssq, row, fq); const size_t off = (size_t)row * DM + pn * 256 + wc * 32 + fq * 8;
                    const float* csr = cs + (size_t)(row & (SEQ - 1)) * 16;
#pragma unroll
                    for (int bj = 0; bj < 2; ++bj) { f32x4 v0 = acc[ai][bj][m][0] * rsv, v1 = acc[ai][bj][m][1] * rsv;
                        *(u32x4*)((bf16*)(ra + RA_QRAW) + off + bj * HALF) = pack8(v0, v1);
                        if (rope) rope8(v0, v1, csr, fq);
                        *(u32x4*)((bf16*)(ra + RA_QROT) + off + bj * HALF) = pack8(v0, v1); } }
        } else if (pn < 6) {
            bf16* ac = (bf16*)(ra + RA_ACMPK + (size_t)(pn - 4) * (RA_ACMPV - RA_ACMPK)); const float* pe = pek + (ptrdiff_t)(pn - 4) * (pev - pek);
#pragma unroll
            for (int ai = 0; ai < 2; ++ai)
#pragma unroll
                for (int m = 0; m < 4; ++m) { const int row = row0 + ai * HALF + m * 16; const float rsv = row_rstd(ssq, row, fq); const int b = row >> 11, t = row & (SEQ - 1);
#pragma unroll
                    for (int bj = 0; bj < 2; ++bj) { const int c = bj * HALF + wc * 32 + fq * 8, gi = c >> 6, d = c & 63;
                        const f32x4 v0 = acc[ai][bj][m][0] * rsv, v1 = acc[ai][bj][m][1] * rsv;
                        const int n1 = t >> 4, l1 = t & 15;
                        if (n1 <= 126) { const float* pp = pe + l1 * 64 + d; const f32x4 a0 = v0 + *(const f32x4*)pp, a1 = v1 + *(const f32x4*)(pp + 4);
                            *(u32x4*)(ac + ((size_t)((b * 4 + gi) * 128 + n1)) * 2048 + l1 * 64 + d) = pack8(a0, a1); }
                        const int n2 = n1 - 1, l2 = l1 + 16;
                        if (n2 >= 0) { const float* pp = pe + l2 * 64 + d; const f32x4 a0 = v0 + *(const f32x4*)pp, a1 = v1 + *(const f32x4*)(pp + 4);
                            *(u32x4*)(ac + ((size_t)((b * 4 + gi) * 128 + n2)) * 2048 + l2 * 64 + d) = pack8(a0, a1); } } }
        } else if (pn < 10) {
            bf16* dst = (bf16*)(ra + RA_KS + (size_t)(pn - 6) * (RA_VS - RA_KS));
            const bool rp_ = rope && ((pn & 1) == 0);
#pragma unroll
            for (int ai = 0; ai < 2; ++ai)
#pragma unroll
                for (int m = 0; m < 4; ++m) { const int row = row0 + ai * HALF + m * 16; const float rsv = row_rstd(ssq, row, fq); bf16* rp = dst + (size_t)row * 256 + wc * 32 + fq * 8;
                    const float* csr = cs + (size_t)(row & (SEQ - 1)) * 16;
#pragma unroll
                    for (int bj = 0; bj < 2; ++bj) { f32x4 v0 = acc[ai][bj][m][0] * rsv, v1 = acc[ai][bj][m][1] * rsv;
                        if (rp_) rope8(v0, v1, csr, fq);
                        *(u32x4*)(rp + bj * HALF) = pack8(v0, v1); } }
        } else {
            const int c = wc * 32 + fq * 8;
#pragma unroll
            for (int ai = 0; ai < 2; ++ai)
#pragma unroll
                for (int m = 0; m < 4; ++m) { const int row = row0 + ai * HALF + m * 16; const float rsv = row_rstd(ssq, row, fq); float* gp = (float*)(ra + RA_GATES) + (size_t)row * 48 + c;
                    f32x4 v0 = acc[ai][0][m][0] * rsv, v1 = acc[ai][0][m][1] * rsv;
#pragma unroll
                    for (int e = 0; e < 4; ++e) { v0[e] = sigmoid_f(v0[e]); v1[e] = sigmoid_f(v1[e]); }
                    if (c < 48) { *(f32x4*)gp = v0; *(f32x4*)(gp + 4) = v1; } }
        }
    }
};

struct EpiRes {
    static constexpr bool PERM = true;
    float* x; bf16* xb; float* ssq;
    __device__ __forceinline__ void operator()(const Acc& acc, const Unit& u, int wr, int wc, int fr, int fq) const {
        const int row0 = u.pm * BM + wr * 64 + fr;
#pragma unroll
        for (int ai = 0; ai < 2; ++ai)
#pragma unroll
            for (int m = 0; m < 4; ++m) { const int row = row0 + ai * HALF + m * 16; const size_t off = (size_t)row * DM + u.pn * 256 + wc * 32 + fq * 8; float ss = 0.f;
#pragma unroll
                for (int bj = 0; bj < 2; ++bj) { float* xp = x + off + bj * HALF;
                    const f32x4 v0 = *(const f32x4*)xp + acc[ai][bj][m][0], v1 = *(const f32x4*)(xp + 4) + acc[ai][bj][m][1];
                    *(f32x4*)xp = v0; *(f32x4*)(xp + 4) = v1; *(u32x4*)(xb + off + bj * HALF) = pack8(v0, v1);
                    ss += (v0[0] * v0[0] + v0[1] * v0[1]) + (v0[2] * v0[2] + v0[3] * v0[3]) + (v1[0] * v1[0] + v1[1] * v1[1]) + (v1[2] * v1[2] + v1[3] * v1[3]); }
                ss += __shfl_xor(ss, 16); ss += __shfl_xor(ss, 32);
                if (fq == 0) ssq[(size_t)(u.pn * 4 + wc) * MTOK + row] = ss; }
    }
};

struct EpiXQ {
    static constexpr bool PERM = true;
    const float* ssq; bf16* o;
    __device__ __forceinline__ void operator()(const Acc& acc, const Unit& u, int wr, int wc, int fr, int fq) const {
        const int row0 = u.pm * BM + wr * 64 + fr;
        float rs[2][4]; load_rstd(ssq, row0, fq, rs);
#pragma unroll
        for (int ai = 0; ai < 2; ++ai)
#pragma unroll
            for (int m = 0; m < 4; ++m) { const int row = row0 + ai * HALF + m * 16; bf16* rp = o + (size_t)row * 256 + wc * 32 + fq * 8;
#pragma unroll
                for (int bj = 0; bj < 2; ++bj) *(u32x4*)(rp + bj * HALF) = pack8(acc[ai][bj][m][0] * rs[ai][m], acc[ai][bj][m][1] * rs[ai][m]); }
    }
};

struct EpiXKV {
    static constexpr bool PERM = true;
    bf16* xk; bf16* xv;
    __device__ __forceinline__ void operator()(const Acc& acc, const Unit& u, int wr, int wc, int fr, int fq) const {
        const int row0 = u.pm * BM + wr * 64 + fr;
        bf16* dst = xk + (size_t)(u.pn & 1) * (size_t)(xv - xk) + (size_t)(u.pn >> 1) * (NB * MEML * 256);
#pragma unroll
        for (int ai = 0; ai < 2; ++ai)
#pragma unroll
            for (int m = 0; m < 4; ++m) { const int row = row0 + ai * HALF + m * 16; bf16* rp = dst + (size_t)row * 256 + wc * 32 + fq * 8;
#pragma unroll
                for (int bj = 0; bj < 2; ++bj) *(u32x4*)(rp + bj * HALF) = pack8(acc[ai][bj][m][0], acc[ai][bj][m][1]); }
    }
};

template <bool MOE> struct EpiGateUp {
    static constexpr bool PERM = true;
    const float* ssq; const float* rowrstd; bf16* h; int ldh;
    __device__ __forceinline__ void operator()(const Acc& acc, const Unit& u, int wr, int wc, int fr, int fq) const {
        const int row0 = u.pm * BM + wr * 64 + fr;
        float rs[2][4];
        if constexpr (MOE) {
#pragma unroll
            for (int ai = 0; ai < 2; ++ai)
#pragma unroll
                for (int m = 0; m < 4; ++m) rs[ai][m] = rowrstd[row0 + ai * HALF + m * 16];
        } else load_rstd(ssq, row0, fq, rs);
#pragma unroll
        for (int ai = 0; ai < 2; ++ai)
#pragma unroll
            for (int m = 0; m < 4; ++m) { const int row = row0 + ai * HALF + m * 16; const float r = rs[ai][m];
                f32x4 o0, o1;
#pragma unroll
                for (int e = 0; e < 4; ++e) { o0[e] = silu_f(acc[ai][0][m][0][e] * r) * (acc[ai][1][m][0][e] * r); o1[e] = silu_f(acc[ai][0][m][1][e] * r) * (acc[ai][1][m][1][e] * r); }
                *(u32x4*)(h + (size_t)row * ldh + u.pn * 128 + wc * 32 + fq * 8) = pack8(o0, o1); }
    }
};

struct EpiMoeDown {
    static constexpr bool PERM = true;
    const int* rowtok; const float* roww; float* ymoe;
    __device__ __forceinline__ void operator()(const Acc& acc, const Unit& u, int wr, int wc, int fr, int fq) const {
        const int row0 = u.pm * BM + wr * 64 + fr;
#pragma unroll
        for (int ai = 0; ai < 2; ++ai)
#pragma unroll
            for (int m = 0; m < 4; ++m) { const int row = row0 + ai * HALF + m * 16; const int tk = rowtok[row];
                if (tk >= 0) { const float w = roww[row]; float* yp = ymoe + ((size_t)(tk & 1) * MTOK + (tk >> 1)) * DM + u.pn * 256 + wc * 32 + fq * 8;
#pragma unroll
                    for (int bj = 0; bj < 2; ++bj) { *(f32x4*)(yp + bj * HALF) = acc[ai][bj][m][0] * w; *(f32x4*)(yp + bj * HALF + 4) = acc[ai][bj][m][1] * w; } } }
    }
};

struct EpiCmpPart {
    static constexpr bool PERM = true;
    float* cpart;
    __device__ __forceinline__ void operator()(const Acc& acc, const Unit& u, int wr, int wc, int fr, int fq) const {
        const int row0 = u.pm * BM + wr * 64 + fr;
        float* base = cpart + (size_t)u.aux * 4096 * 256;
#pragma unroll
        for (int ai = 0; ai < 2; ++ai)
#pragma unroll
            for (int m = 0; m < 4; ++m) { const int row = row0 + ai * HALF + m * 16; float* rp = base + (size_t)row * 256 + wc * 32 + fq * 8;
#pragma unroll
                for (int bj = 0; bj < 2; ++bj) { *(f32x4*)(rp + bj * HALF) = acc[ai][bj][m][0]; *(f32x4*)(rp + bj * HALF + 4) = acc[ai][bj][m][1]; } }
    }
};

struct CmpOrder {
    int G, c;
    __device__ bool next(int i, Unit& u) const {
        const long L = (long)i * G + c; if (L >= 2 * CMP_SPLIT * 16) return false;
        const int t = (int)L / (CMP_SPLIT * 16), s = ((int)L / 16) % CMP_SPLIT, pm = (int)L % 16;
        u.pm = pm; u.pn = 0; u.aux = t * CMP_SPLIT + s;
        u.oa = ((size_t)(t * 4096 + pm * 256) * 2048 + s * 256) * 2; u.ob = ((size_t)(t * 256) * 2048 + s * 256) * 2; return true;
    }
};
struct MoeOrder {
    const int* tile_e; int nN, G, c, lda, ldb, nper;
    __device__ bool next(int i, Unit& u) const {
        const int nt = __builtin_amdgcn_readfirstlane(tile_e[MOE_MAX_TILES]);
        const long L = (long)i * G + c; if (L >= (long)nt * nN) return false;
        const int pm = (int)(L / nN), pn = (int)(L % nN), e = __builtin_amdgcn_readfirstlane(tile_e[pm]);
        u.pm = pm; u.pn = pn; u.aux = e; u.oa = (size_t)pm * BM * lda * 2; u.ob = ((size_t)e * nper + (size_t)pn * BM) * ldb * 2; return true;
    }
};
}

namespace att {
constexpr int KP = 144, TILE_B = 64 * KP;
constexpr int KV_BYTES = 4 * TILE_B;
#define MFMA32(a, b, c) __builtin_amdgcn_mfma_f32_32x32x16_bf16((a), (b), (c), 0, 0, 0)
typedef short v4i16_t __attribute__((ext_vector_type(4)));
__device__ __forceinline__ s16x4 vtr(const LAS unsigned char* p) { return __builtin_bit_cast(s16x4, __builtin_amdgcn_ds_read_tr16_b64_v4i16((LAS v4i16_t*)p)); }
__device__ __forceinline__ bf16x8 packp(const f32x16& x, int s) {
    u32x4 p; p.x = pk2(x[8 * s], x[8 * s + 1]); p.y = pk2(x[8 * s + 2], x[8 * s + 3]); p.z = pk2(x[8 * s + 4], x[8 * s + 5]); p.w = pk2(x[8 * s + 6], x[8 * s + 7]);
    return __builtin_bit_cast(bf16x8, p);
}
__device__ __forceinline__ short ov_bits(int n, int j) {
    const int jn = n >> 2, q = n & 3;
    if (q < 3) return (jn == j) ? (short)0x3F80 : (short)0;
    return (jn == j || jn + 1 == j) ? (short)0x3F00 : (short)0;
}

struct State { f32x16 o0, o1, o2; float m, l; };
__device__ __forceinline__ void reset(State& s) {
#pragma unroll
    for (int i = 0; i < 16; ++i) { s.o0[i] = 0.f; s.o1[i] = 0.f; s.o2[i] = 0.f; }
    s.m = -1e30f; s.l = 0.f;
}

template <class MK, bool OV>
__device__ __forceinline__ void flash_run(LAS unsigned char* kv, const bf16* Kg, const bf16* Vg, int ld, int jlo, int jhi, const bf16x8 (&qf)[4], State& st, const MK& mk, const int tid) {
    const int lane = tid & 63, r = lane & 31, h = lane >> 5, blk16 = (lane >> 4) & 1, q4 = (lane & 15) >> 2, p4 = lane & 3;
    const int skey = tid >> 3, sch = tid & 7;
    const unsigned sdst = (unsigned)(skey * KP + sch * 16);
    int j = jlo; while (j < jhi && !mk.active(j)) ++j;
    if (j >= jhi) return;
    u32x4 kr = *(const u32x4*)(Kg + (size_t)(64 * j + skey) * ld + sch * 8), vr = *(const u32x4*)(Vg + (size_t)(64 * j + skey) * ld + sch * 8);
    *(LAS u32x4*)(kv + sdst) = kr; *(LAS u32x4*)(kv + 2 * TILE_B + sdst) = vr;
    __syncthreads();
    int cur = 0;
    const unsigned kro = (unsigned)(r * KP + h * 16);
    const unsigned vro = (unsigned)((4 * h + q4) * KP + (16 * blk16 + 4 * p4) * 2);
#pragma nounroll
    for (;;) {
        int jn = j + 1; while (jn < jhi && !mk.active(jn)) ++jn;
        const bool has = jn < jhi;
        if (has) { kr = *(const u32x4*)(Kg + (size_t)(64 * jn + skey) * ld + sch * 8); vr = *(const u32x4*)(Vg + (size_t)(64 * jn + skey) * ld + sch * 8); }
        const int kind = mk.kind(j);
        if (kind != 0) {
            const LAS unsigned char* Kb = kv + cur * TILE_B; const LAS unsigned char* Vb = kv + (2 + cur) * TILE_B;
            f32x16 s0, s1;
#pragma unroll
            for (int i = 0; i < 16; ++i) { s0[i] = 0.f; s1[i] = 0.f; }
#pragma unroll
            for (int ks = 0; ks < 4; ++ks) {
                const bf16x8 k0 = *(const LAS bf16x8*)(Kb + kro + ks * 32), k1 = *(const LAS bf16x8*)(Kb + kro + 32 * KP + ks * 32);
                s0 = MFMA32(k0, qf[ks], s0); s1 = MFMA32(k1, qf[ks], s1);
            }
            float mx = -INFINITY;
#pragma unroll
            for (int i = 0; i < 16; ++i) {
                float a = s0[i] * C2, b = s1[i] * C2;
                if (kind == 2) { const int kk = (i & 3) + 8 * (i >> 2) + 4 * h; if (!mk.ok(j, kk)) a = -INFINITY; if (!mk.ok(j, kk + 32)) b = -INFINITY; }
                s0[i] = a; s1[i] = b; mx = fmaxf(mx, fmaxf(a, b));
            }
            mx = fmaxf(mx, __shfl_xor(mx, 32));
            const float mn = fmaxf(st.m, mx), alpha = fast_exp2(st.m - mn); st.m = mn;
            float ps = 0.f;
#pragma unroll
            for (int i = 0; i < 16; ++i) { s0[i] = fast_exp2(s0[i] - mn); s1[i] = fast_exp2(s1[i] - mn); ps += s0[i] + s1[i]; }
            ps += __shfl_xor(ps, 32);
            st.l = st.l * alpha + ps;
            st.o0 = st.o0 * alpha; st.o1 = st.o1 * alpha; if (OV) st.o2 = st.o2 * alpha;
#pragma unroll
            for (int hf = 0; hf < 2; ++hf)
#pragma unroll
                for (int s = 0; s < 2; ++s) {
                    const bf16x8 pf = packp(hf ? s1 : s0, s);
                    const LAS unsigned char* vb = Vb + vro + (32 * hf + 16 * s) * KP;
                    const s16x4 l0 = vtr(vb), h0 = vtr(vb + 8 * KP), l1 = vtr(vb + 64), h1 = vtr(vb + 8 * KP + 64);
                    st.o0 = MFMA32(__builtin_shufflevector(l0, h0, 0, 1, 2, 3, 4, 5, 6, 7), pf, st.o0);
                    st.o1 = MFMA32(__builtin_shufflevector(l1, h1, 0, 1, 2, 3, 4, 5, 6, 7), pf, st.o1);
                    if (OV) {
                        int r_ = r; asm volatile("" : "+v"(r_));
                        const int jnA = 16 * j + 8 * hf + 4 * s + h - r_, jnB = jnA + 2;
                        u32x4 a;
                        a.x = (jnA == 0) ? 0x3F803F80u : 0u; a.y = ((jnA == 0) ? 0x00003F80u : 0u) | ((jnA == 0 || jnA == -1) ? 0x3F000000u : 0u);
                        a.z = (jnB == 0) ? 0x3F803F80u : 0u; a.w = ((jnB == 0) ? 0x00003F80u : 0u) | ((jnB == 0 || jnB == -1) ? 0x3F000000u : 0u);
                        st.o2 = MFMA32(__builtin_bit_cast(bf16x8, a), pf, st.o2); }
                }
        }
        if (has) { *(LAS u32x4*)(kv + (cur ^ 1) * TILE_B + sdst) = kr; *(LAS u32x4*)(kv + (2 + (cur ^ 1)) * TILE_B + sdst) = vr; }
        __syncthreads();
        if (!has) break;
        j = jn; cur ^= 1;
    }
}

__device__ __forceinline__ void load_q(bf16x8 (&qf)[4], const bf16* qrow, int h) {
#pragma unroll
    for (int ks = 0; ks < 4; ++ks) qf[ks] = *(const bf16x8*)(qrow + ks * 16 + h * 8);
}
__device__ __forceinline__ void store_o(bf16* orow, const f32x16& o0, const f32x16& o1, float sc, int h) {
#pragma unroll
    for (int g = 0; g < 4; ++g) {
        u32x2 a, b; a.x = pk2(o0[4 * g] * sc, o0[4 * g + 1] * sc); a.y = pk2(o0[4 * g + 2] * sc, o0[4 * g + 3] * sc);
        b.x = pk2(o1[4 * g] * sc, o1[4 * g + 1] * sc); b.y = pk2(o1[4 * g + 2] * sc, o1[4 * g + 3] * sc);
        *(u32x2*)(orow + 8 * g + 4 * h) = a; *(u32x2*)(orow + 32 + 8 * g + 4 * h) = b;
    }
}

struct NoMask { __device__ __forceinline__ bool active(int) const { return true; } __device__ __forceinline__ int kind(int) const { return 1; } __device__ __forceinline__ bool ok(int, int) const { return true; } };
struct MobaMask {
    int qb, wq0, tq; unsigned sel, uni;
    __device__ __forceinline__ bool active(int jt) const { const int jb = jt >> 2; return jb >= qb || ((uni >> jb) & 1u); }
    __device__ __forceinline__ int kind(int jt) const { const int jb = jt >> 2; if (jb < qb) return 2; const int k0 = (jt & 3) * 64; if (k0 > wq0 + 31) return 0; if (k0 + 63 <= wq0) return 1; return 2; }
    __device__ __forceinline__ bool ok(int jt, int kk) const { const int jb = jt >> 2; if (jb < qb) return (sel >> jb) & 1u; return (jt & 3) * 64 + kk <= tq; }
};
struct CmpMask {
    int nmax, nlo, nhi;
    __device__ __forceinline__ bool active(int) const { return true; }
    __device__ __forceinline__ int kind(int j) const { if (64 * j > nhi) return 0; if (64 * j + 63 <= nlo) return 1; return 2; }
    __device__ __forceinline__ bool ok(int j, int kk) const { return 64 * j + kk <= nmax; }
};
struct SelMask {
    int tb, tq, wq0; unsigned sel, uni;
    __device__ __forceinline__ bool active(int j) const { return (uni >> j) & 1u; }
    __device__ __forceinline__ int kind(int j) const { return 2; }
    __device__ __forceinline__ bool ok(int j, int kk) const { const bool s = (sel >> j) & 1u; return j < tb ? s : (s && kk <= tq); }
};
struct WinMask {
    int tb, tq;
    __device__ __forceinline__ bool active(int) const { return true; }
    __device__ __forceinline__ int kind(int j) const { return (j == tb || j == tb - 8) ? 2 : 1; }
    __device__ __forceinline__ bool ok(int j, int kk) const { const int d = 64 * (tb - j) + tq - kk; return d >= 0 && d < 512; }
};
}

#define XB_TMO      128
#define XB_XCNT(j)  (256  + 64 * (j))
#define XB_XSUB(j)  (1280 + 64 * (j))
#define XB_XGEN(j)  (2304 + 64 * (j))
#define XB_TOP      3328
#define XB_TOPGEN   3392
#define XCD_BAR_WORDS 3456
#define XB_SPIN_CAP (1u << 18)
__device__ __forceinline__ unsigned xb_ld(unsigned* p)              { return __hip_atomic_load(p, __ATOMIC_RELAXED, __HIP_MEMORY_SCOPE_AGENT); }
__device__ __forceinline__ unsigned xb_add(unsigned* p, unsigned v) { return __hip_atomic_fetch_add(p, v, __ATOMIC_RELAXED, __HIP_MEMORY_SCOPE_AGENT); }
__device__ __forceinline__ unsigned xb_xcc_id() { return (unsigned)__builtin_amdgcn_s_getreg((3 << 11) | 20) & 0xFu; }
#define XB_SPIN(cond, bar) do { unsigned _sp = 0; while (cond) { __builtin_amdgcn_s_sleep(1); \
    if ((++_sp & 255u) == 0u) { if (xb_ld(&(bar)[XB_TMO])) break; if (_sp > XB_SPIN_CAP) { atomicAdd(&(bar)[XB_TMO], 1u); break; } } } } while (0)
struct XcdBarrier { unsigned* bar; unsigned x; volatile LAS unsigned* st; };
__device__ __forceinline__ XcdBarrier xcd_barrier_post(unsigned* bar, volatile LAS unsigned* st) {
    XcdBarrier b; b.bar = bar; b.x = xb_xcc_id(); b.st = st;
    if (threadIdx.x == 0) (void)xb_add(&bar[XB_XCNT(b.x)], 1u);
    return b;
}
__device__ __forceinline__ void xcd_barrier_complete(unsigned* bar, unsigned x, unsigned& nloc, unsigned& nx) {
    const unsigned G = gridDim.x * gridDim.y * gridDim.z;
    unsigned sum, cnt, mine, sp = 0u;
    for (;;) {
        sum = 0u; cnt = 0u; mine = 0u;
#pragma unroll
        for (unsigned j = 0; j < 16; ++j) { const unsigned c = xb_ld(&bar[XB_XCNT(j)]); sum += c; cnt += (c > 0u) ? 1u : 0u; mine = (j == x) ? c : mine; }
        if (sum == G) break;
        __builtin_amdgcn_s_sleep(1);
        if ((++sp & 255u) == 0u) { if (xb_ld(&bar[XB_TMO])) break; if (sp > XB_SPIN_CAP) { atomicAdd(&bar[XB_TMO], 1u); break; } }
    }
    nloc = mine > 0u ? mine : 1u; nx = cnt > 0u ? cnt : 1u;
}
__device__ __forceinline__ void xcd_barrier(const XcdBarrier& b) {
    asm volatile("s_waitcnt vmcnt(0)" ::: "memory");
    __syncthreads();
    if (threadIdx.x == 0) {
        unsigned* bar = b.bar;
        __builtin_amdgcn_s_waitcnt(0);
        unsigned nloc = b.st[0], nx = b.st[1];
        if (nloc == 0u) { xcd_barrier_complete(bar, b.x, nloc, nx); b.st[0] = nloc; b.st[1] = nx; }
        const unsigned old = xb_add(&bar[XB_XSUB(b.x)], 1u);
        const unsigned gen = old / nloc;
        if (old + 1u == (gen + 1u) * nloc) {
            __builtin_amdgcn_fence(__ATOMIC_RELEASE, "agent");
            asm volatile("s_waitcnt vmcnt(0)" ::: "memory");
            const unsigned og = xb_add(&bar[XB_TOP], 1u);
            const unsigned tg = og / nx;
            if (og + 1u == (tg + 1u) * nx) xb_add(&bar[XB_TOPGEN], 1u);
            else XB_SPIN(xb_ld(&bar[XB_TOPGEN]) == tg, bar);
            __builtin_amdgcn_fence(__ATOMIC_ACQUIRE, "agent");
            xb_add(&bar[XB_XGEN(b.x)], 1u);
            asm volatile("s_waitcnt vmcnt(0)" ::: "memory");
        } else {
            XB_SPIN(xb_ld(&bar[XB_XGEN(b.x)]) == gen, bar);
            __builtin_amdgcn_fence(__ATOMIC_ACQUIRE, "agent");
            asm volatile("s_waitcnt vmcnt(0)" ::: "memory");
        }
    }
    __syncthreads();
}

struct ConvJob { const float* src; bf16* dst; const float* g; int K, N, nblk, mode, start, pad; };

__device__ __forceinline__ void conv_item(const float* src, bf16* dst, const float* g, int K, int N, int nblk, int mode, LAS float* scr, int item, int lane) {
    const int kb = item / nblk, nb = item - kb * nblk, k0 = 64 * kb, n0 = 32 * nb;
    const int n = n0 + (lane & 31); const bool inb = n < N;
#pragma unroll 8
    for (int i = 0; i < 32; ++i) { const int kk = 2 * i + (lane >> 5); float v = inb ? src[(size_t)(k0 + kk) * N + n] : 0.f; if (g) v *= g[k0 + kk]; scr[kk * 33 + (lane & 31)] = v; }
    LDS_WAIT(); asm volatile("" ::: "memory");
    const int c = lane & 7;
#pragma unroll
    for (int j = 0; j < 4; ++j) { const int nn = (lane >> 3) + 8 * j, nc = n0 + nn; const LAS float* s = scr + (8 * c) * 33 + nn;
        u32x4 o; o.x = pk2(s[0 * 33], s[1 * 33]); o.y = pk2(s[2 * 33], s[3 * 33]); o.z = pk2(s[4 * 33], s[5 * 33]); o.w = pk2(s[6 * 33], s[7 * 33]);
        if (nc < N) { const int orow = mode == 0 ? nc : (256 * (nc >> 7) + (nc & 127) + (mode == 2 ? 128 : 0)); *(u32x4*)(dst + (size_t)orow * K + k0 + 8 * c) = o; } }
    LDS_WAIT(); asm volatile("" ::: "memory");
}
__device__ __forceinline__ void run_conv_jobs(LAS unsigned char* lds, int njobs, int total, int gw, int NGW, int wave, int lane) {
    const LAS ConvJob* jobs = (const LAS ConvJob*)(lds + 72 * 1024);
    LAS float* scr = (LAS float*)(lds + wave * 8448);
    for (int it = gw; it < total; it += NGW) {
        int ji = 0; while (ji + 1 < njobs && jobs[ji + 1].start <= it) ++ji;
        const float* src = jobs[ji].src; bf16* dst = jobs[ji].dst; const float* g = jobs[ji].g;
        const int K = jobs[ji].K, N = jobs[ji].N, nblk = jobs[ji].nblk, mode = jobs[ji].mode, start = jobs[ji].start;
        conv_item(src, dst, g, K, N, nblk, mode, scr, it - start, lane);
    }
}
#define ADD_JOB(SRC, DST, GP, KK, NN, MODE) do { LAS ConvJob* _j = jobsw + nj; _j->src = (SRC); _j->dst = (DST); _j->g = (GP); _j->K = (KK); _j->N = (NN); _j->nblk = ((NN) + 31) / 32; \
    _j->mode = (MODE); _j->start = tot; _j->pad = 0; tot += ((KK) / 64) * (((NN) + 31) / 32); ++nj; } while (0)

__device__ __forceinline__ float load_row4(const float* row, int lane, f32x4 (&v)[4]) {
    float s = 0.f;
#pragma unroll
    for (int j = 0; j < 4; ++j) { v[j] = *(const f32x4*)(row + 4 * lane + 256 * j); s += (v[j][0] * v[j][0] + v[j][1] * v[j][1]) + (v[j][2] * v[j][2] + v[j][3] * v[j][3]); }
    return wave_sum(s);
}
__device__ __forceinline__ void store_ssq_full(float* ssq, int row, float s, int lane) { if (lane < 16) ssq[(size_t)lane * MTOK + row] = (lane == 0) ? s : 0.f; }
__device__ __forceinline__ void store_row_bf16(bf16* orow, int lane, const f32x4 (&v)[4]) {
#pragma unroll
    for (int j = 0; j < 4; ++j) { u32x2 o; o.x = pk2(v[j][0], v[j][1]); o.y = pk2(v[j][2], v[j][3]); *(u32x2*)(orow + 4 * lane + 256 * j) = o; }
}

struct Args { const void* in[28]; float* out; unsigned char* ws; double invf[8]; int ph_lo, ph_hi; };
constexpr int NPH = 2 + 4 * 13;

#define CAS __attribute__((address_space(4)))
__device__ __forceinline__ const CAS char* karg() { const CAS char* kp = (const CAS char*)__builtin_amdgcn_kernarg_segment_ptr(); asm volatile("" : "+s"(kp)); return kp; }
#define INP(k) ((const void*)(*(const GAS void* const CAS*)(karg() + 8 * (k))))
#define ARG_OUT ((float*)(*(GAS float* const CAS*)(karg() + 224)))
#define ARG_WS (*(GAS unsigned char* const CAS*)(karg() + 232))
#define ARG_INVF(j) (*(const CAS double*)(karg() + 240 + 8 * (j)))
static_assert(offsetof(Args, out) == 224 && offsetof(Args, ws) == 232 && offsetof(Args, invf) == 240 && offsetof(Args, ph_lo) == 304 && sizeof(Args) == 312, "kernarg layout");
__global__ void __launch_bounds__(NWAVES * 64, 2) mk_fwd(Args args) {
    extern __shared__ __attribute__((aligned(16))) unsigned char lds_raw[];
    LAS unsigned char* lds = (LAS unsigned char*)lds_raw;
    volatile LAS unsigned* MISC = (volatile LAS unsigned*)(lds + MISC_OFF);
#define PHASE_IDS int tid = threadIdx.x; asm volatile("" : "+v"(tid)); const int lane = tid & 63, wave = __builtin_amdgcn_readfirstlane(tid >> 6); \
    int bx = blockIdx.x, G = gridDim.x; asm volatile("" : "+s"(bx), "+s"(G)); const int gw = bx * NWAVES + wave, NGW = G * NWAVES; (void)lane; (void)gw; (void)NGW;
#define ws (ARG_WS)
#define ctl ((unsigned*)(ws + WS_CTL))
    for (int u = threadIdx.x; u < (LDS_BYTES - LDSCTL_OFF) / 4; u += NWAVES * 64) ((LAS unsigned*)(lds + LDSCTL_OFF))[u] = 0u;
    __syncthreads();
    if (MK_SINGLE) (void)xcd_barrier_post(ctl + CW_BAR, MISC + 8);
#define PH_LO (*(const CAS int*)(karg() + 304))
#define PH_HI (*(const CAS int*)(karg() + 308))
#define IN(p) (PH_LO <= (p) && (p) < PH_HI)
#define BAR_AFTER(p) do { if (MK_SINGLE && (p) + 1 < PH_HI) { XcdBarrier bar_; bar_.bar = ctl + CW_BAR; bar_.x = xb_xcc_id(); bar_.st = (volatile LAS unsigned*)(lds + MISC_OFF) + 8; xcd_barrier(bar_); } } while (0)

#define in_x ((const float*)INP(0))
#define in_mem ((const float*)INP(1))
#define in_pos ((const int*)INP(2))
#define norm_g ((const float*)INP(3))
#define mem_g ((const float*)INP(4))
#define final_g ((const float*)INP(5))
#define X (ARG_OUT)
#define XB ((bf16*)(ws + WS_XB))
#define SSQ ((float*)(ws + WS_SSQ))
#define CS ((float*)(ws + WS_MISC + MISC_CS))
#define KMEAN ((float*)(ws + WS_MISC + MISC_KMEAN))
#define KCMP ((bf16*)(ws + WS_MISC + MISC_KCMP))
#define VCMP ((bf16*)(ws + WS_MISC + MISC_VCMP))
#define MEMB ((bf16*)(ws + WS_MEMB))
#define XK ((bf16*)(ws + WS_XK))
#define XV ((bf16*)(ws + WS_XV))
#define YB ((bf16*)(ws + WS_YB))
#define XQ ((bf16*)(ws + WS_XQ))
#define XO ((bf16*)(ws + WS_XO))
#define TOKE ((int*)(ws + WS_ROUTE + RT_TOKE))
#define TOKPOS ((int*)(ws + WS_ROUTE + RT_TOKPOS))
#define TOKW ((float*)(ws + WS_ROUTE + RT_TOKW))
#define TOKRSTD ((float*)(ws + WS_ROUTE + RT_TOKRSTD))
#define ROWTOK ((int*)(ws + WS_ROUTE + RT_ROWTOK))
#define ROWW ((float*)(ws + WS_ROUTE + RT_ROWW))
#define ROWRSTD ((float*)(ws + WS_ROUTE + RT_ROWRSTD))
#define TILEE ((int*)(ws + WS_ROUTE + RT_TILEE))
#define RA ((unsigned char*)(ws + WS_REGA))
#define UPOOL ((float*)(RA + RA_UPOOL))
#define QB ((bf16*)(RA + RA_QB))
#define KB ((bf16*)(RA + RA_KB))
#define VB ((bf16*)(RA + RA_VB))
#define QRAW ((bf16*)(RA + RA_QRAW))
#define QROT ((bf16*)(RA + RA_QROT))
#define ACMPK ((bf16*)(RA + RA_ACMPK))
#define KSB ((bf16*)(RA + RA_KS))
#define VSB ((bf16*)(RA + RA_VS))
#define KWB ((bf16*)(RA + RA_KW))
#define VWB ((bf16*)(RA + RA_VW))
#define GATES ((float*)(RA + RA_GATES))
#define CPART ((float*)(RA + RA_CPART))
#define YMOE ((float*)(RA + RA_YMOE))
#define XPERM ((bf16*)(RA + RA_XPERM))
#define HB ((bf16*)(ws + WS_REGB))

    if (ON(0) && IN(0)) {
            PHASE_IDS
        LAS ConvJob* jobsw = (LAS ConvJob*)(lds + 72 * 1024);
        LAS int* jmeta = (LAS int*)(lds + 80 * 1024);
        if (tid == 0) {
            int nj = 0, tot = 0;
#pragma nounroll
            for (int i = 0; i < 2; ++i) {
                ADD_JOB((const float*)INP(6) + (size_t)i * DM * AB_IN, (bf16*)(ws + WS_W_INAB) + (size_t)i * AB_IN * DM, norm_g + (2 * i * 3 + 0) * DM, DM, AB_IN, 0);
                ADD_JOB((const float*)INP(9) + (size_t)i * DM * DM, (bf16*)(ws + WS_W_OUTAB) + (size_t)i * DM * DM, (const float*)nullptr, DM, DM, 0);
                ADD_JOB((const float*)INP(10) + (size_t)i * DM * DFF, (bf16*)(ws + WS_W_FFNGU) + (size_t)i * 2 * DFF * DM, norm_g + (2 * i * 3 + 2) * DM, DM, DFF, 1);
                ADD_JOB((const float*)INP(11) + (size_t)i * DM * DFF, (bf16*)(ws + WS_W_FFNGU) + (size_t)i * 2 * DFF * DM, norm_g + (2 * i * 3 + 2) * DM, DM, DFF, 2);
                ADD_JOB((const float*)INP(12) + (size_t)i * DFF * DM, (bf16*)(ws + WS_W_FFND) + (size_t)i * DM * DFF, (const float*)nullptr, DFF, DM, 0);
                ADD_JOB((const float*)INP(13) + (size_t)i * DM * C_IN, (bf16*)(ws + WS_W_INC) + (size_t)i * C_IN_PAD * DM, norm_g + ((2 * i + 1) * 3 + 0) * DM, DM, C_IN, 0);
                ADD_JOB((const float*)INP(16) + (size_t)i * 2048 * 256, (bf16*)(ws + WS_W_CW1) + (size_t)(i * 2 + 0) * 256 * 2048, (const float*)nullptr, 2048, 256, 0);
                ADD_JOB((const float*)INP(18) + (size_t)i * 2048 * 256, (bf16*)(ws + WS_W_CW1) + (size_t)(i * 2 + 1) * 256 * 2048, (const float*)nullptr, 2048, 256, 0);
                ADD_JOB((const float*)INP(20) + (size_t)i * DM * DM, (bf16*)(ws + WS_W_OUTC) + (size_t)i * DM * DM, (const float*)nullptr, DM, DM, 0);
            }
#pragma nounroll
            for (int l = 0; l < 4; ++l) {
                ADD_JOB((const float*)INP(25) + (size_t)l * DM * 256, (bf16*)(ws + WS_W_XQ) + (size_t)l * 256 * DM, norm_g + (l * 3 + 1) * DM, DM, 256, 0);
                ADD_JOB((const float*)INP(26) + (size_t)l * DM * 512, (bf16*)(ws + WS_W_XKV) + (size_t)l * 512 * DM, (const float*)nullptr, DM, 512, 0);
                ADD_JOB((const float*)INP(27) + (size_t)l * 256 * DM, (bf16*)(ws + WS_W_XO) + (size_t)l * DM * 256, (const float*)nullptr, 256, DM, 0);
            }
#pragma nounroll
            for (int e = 0; e < NEXP; ++e) {
                ADD_JOB((const float*)INP(22) + (size_t)e * DM * DFFE, (bf16*)(ws + WS_W_MOEGU) + (size_t)e * 2 * DFFE * DM, norm_g + (1 * 3 + 2) * DM, DM, DFFE, 1);
                ADD_JOB((const float*)INP(23) + (size_t)e * DM * DFFE, (bf16*)(ws + WS_W_MOEGU) + (size_t)e * 2 * DFFE * DM, norm_g + (1 * 3 + 2) * DM, DM, DFFE, 2);
                ADD_JOB((const float*)INP(24) + (size_t)e * DFFE * DM, (bf16*)(ws + WS_W_MOED) + (size_t)e * DM * DFFE, (const float*)nullptr, DFFE, DM, 0);
            }
            jmeta[0] = nj; jmeta[1] = tot;
        }
        __syncthreads();
        run_conv_jobs(lds, jmeta[0], jmeta[1], gw, NGW, wave, lane);
        for (int idx = bx * 512 + tid; idx < 2 * (C_IN_PAD - C_IN) * (DM / 8); idx += G * 512) {
            const int i = idx / ((C_IN_PAD - C_IN) * (DM / 8)), rem = idx % ((C_IN_PAD - C_IN) * (DM / 8));
            *(u32x4*)((bf16*)(ws + WS_W_INC) + ((size_t)i * C_IN_PAD + C_IN) * DM + (size_t)rem * 8) = (u32x4){0u, 0u, 0u, 0u};
        }
        for (int m = gw; m < MTOK; m += NGW) {
            f32x4 v[4]; const float s = load_row4(in_x + (size_t)m * DM, lane, v);
#pragma unroll
            for (int j = 0; j < 4; ++j) *(f32x4*)(X + (size_t)m * DM + 4 * lane + 256 * j) = v[j];
            store_row_bf16(XB + (size_t)m * DM, lane, v); store_ssq_full(SSQ, m, s, lane);
        }
        for (int m = gw; m < NB * MEML; m += NGW) {
            f32x4 v[4]; const float s = load_row4(in_mem + (size_t)m * DM, lane, v); const float r = rsqrtf(s * (1.f / DM) + NORM_EPS);
#pragma unroll
            for (int j = 0; j < 4; ++j) v[j] = v[j] * r * *(const f32x4*)(mem_g + 4 * lane + 256 * j);
            store_row_bf16(MEMB + (size_t)m * DM, lane, v);
        }
        for (int idx = bx * 512 + tid; idx < SEQ * 8; idx += G * 512) {
            const int t = idx >> 3, j = idx & 7; const double a = (double)in_pos[t] * ARG_INVF(j) * 0.15915494309189535;
            const float fr_ = (float)(a - __builtin_rint(a));
            CS[t * 16 + j] = __builtin_amdgcn_cosf(fr_); CS[t * 16 + 8 + j] = __builtin_amdgcn_sinf(fr_);
        }
        BAR_AFTER(0);
    }
    if (ON(1) && IN(1)) {
            PHASE_IDS
        pg8::Gemm g{MEMB, (const bf16*)(ws + WS_W_XKV), DM, DM, DM}; pg8::StaticOrder S; S.init(NB * MEML, 4 * 512, G, bx, DM, DM);
        pg8::EpiXKV E{XK, XV};
        pg8::gemm_phase<pg8::EpiXKV, pg8::StaticOrder>(lds, g, S, E, tid);
        BAR_AFTER(1);
    }

    for (int l = 0; l < 4; ++l) {
        const int pb = 2 + 13 * l, i2 = l >> 1;
        const bool even = (l & 1) == 0;
        if (IN(pb + 0)) {
            PHASE_IDS
            if (ON(2) && even) {
                pg8::Gemm g{XB, (const bf16*)(ws + WS_W_INAB) + (size_t)i2 * AB_IN * DM, DM, DM, DM}; pg8::StaticOrder S; S.init(MTOK, AB_IN, G, bx, DM, DM);
                pg8::EpiInAB E{SSQ, CS, RA};
                pg8::gemm_phase<pg8::EpiInAB, pg8::StaticOrder>(lds, g, S, E, tid);
            } else if (ON(3) && !even) {
                pg8::Gemm g{XB, (const bf16*)(ws + WS_W_INC) + (size_t)i2 * C_IN_PAD * DM, DM, DM, DM}; pg8::StaticOrder S; S.init(MTOK, C_IN_PAD, G, bx, DM, DM);
                pg8::EpiInC E{SSQ, CS, RA, (const float*)INP(14) + (size_t)i2 * 32 * 64, (const float*)INP(15) + (size_t)i2 * 32 * 64};
                pg8::gemm_phase<pg8::EpiInC, pg8::StaticOrder>(lds, g, S, E, tid);
            }
            BAR_AFTER(pb + 0);
        }
        if (IN(pb + 1)) {
            PHASE_IDS
            if (ON(4) && even) {
                LAS float* red = (LAS float*)lds;
                for (int u = bx; u < NB * 12 * 8; u += G) {
                    const int b = u / 96, h = (u / 8) % 12, blk = u % 8, d = tid & 63, part = tid >> 6;
                    const bf16* kp = KB + ((size_t)(b * SEQ + 256 * blk + 32 * part)) * MOBA_DIMC + h * 64 + d;
                    float s = 0.f;
#pragma unroll 8
                    for (int i = 0; i < 32; ++i) s += bf2f(kp[(size_t)i * MOBA_DIMC]);
                    red[part * 64 + d] = s;
                    __syncthreads();
                    if (tid < 64) { float t = 0.f;
#pragma unroll
                        for (int p = 0; p < 8; ++p) t += red[p * 64 + tid];
                        KMEAN[(size_t)u * 64 + tid] = t * (1.f / 256.f); }
                    __syncthreads();
                }
            } else if (ON(5) && !even) {
                pg8::Gemm g{ACMPK, (const bf16*)(ws + WS_W_CW1) + (size_t)i2 * 2 * 256 * 2048, 2048, 2048, 2048 / CMP_SPLIT}; pg8::CmpOrder S{G, bx};
                pg8::EpiCmpPart E{CPART};
                pg8::gemm_phase<pg8::EpiCmpPart, pg8::CmpOrder>(lds, g, S, E, tid);
            }
            BAR_AFTER(pb + 1);
        }
        if (ON(6) && IN(pb + 2) && !even) {
            PHASE_IDS
            LAS float* hl = (LAS float*)lds;
            for (int u = bx; u < 512; u += G) {
                const int t = u >> 8, R0 = (u & 255) * 16;
#pragma unroll
                for (int q = 0; q < 8; ++q) { const int idx = tid + 512 * q, rr = idx >> 8, cc = idx & 255; float s = 0.f;
#pragma unroll
                    for (int sp = 0; sp < CMP_SPLIT; ++sp) s += CPART[((size_t)(t * CMP_SPLIT + sp) * 4096 + R0 + rr) * 256 + cc];
                    hl[idx] = gelu_tanh_f(s); }
                __syncthreads();
                const float* w2 = (const float*)INP(t ? 19 : 17) + (size_t)i2 * 256 * 64;
                const int rr = tid >> 5, d0 = (tid & 31) * 2; float a0 = 0.f, a1 = 0.f;
#pragma unroll 8
                for (int k = 0; k < 256; ++k) { const float hv = hl[rr * 256 + k]; const f32x2 w = *(const f32x2*)(w2 + k * 64 + d0); a0 += hv * w[0]; a1 += hv * w[1]; }
                const int row = R0 + rr; if ((row & 127) == 127) { a0 = 0.f; a1 = 0.f; }
                *(unsigned*)((t ? VCMP : KCMP) + (size_t)row * 64 + d0) = pk2(a0, a1);
                __syncthreads();
            }
            BAR_AFTER(pb + 2);
        }
        if (IN(pb + 3)) {
            PHASE_IDS
            if (ON(7) && even) {
                for (int u = bx; u < 768 + 512; u += G) {
                    if (u < 768) {
                        const int qb = 7 - u / 96, bh = u % 96, b = bh / 12, h = bh % 12;
                        LAS float* km = (LAS float*)(lds + att::KV_BYTES);
                        LAS unsigned* uni = (LAS unsigned*)(lds + att::KV_BYTES + 2048);
                        if (tid < qb * 64) km[tid] = KMEAN[((size_t)(b * 12 + h) * 8) * 64 + tid];
                        if (tid == 0) *uni = 0u;
                        __syncthreads();
                        const int r = lane & 31, hh = lane >> 5, tq = 32 * wave + r;
                        const size_t tok = (size_t)b * SEQ + 256 * qb + tq;
                        bf16x8 qf[4]; att::load_q(qf, QB + tok * MOBA_DIMC + h * 64, hh);
                        float gt[7];
#pragma unroll
                        for (int j = 0; j < 7; ++j) { float p = -INFINITY;
                            if (j < qb) { p = 0.f;
#pragma unroll
                                for (int ks = 0; ks < 4; ++ks)
#pragma unroll
                                    for (int jj = 0; jj < 8; ++jj) p += bf2f((unsigned short)qf[ks][jj]) * km[j * 64 + ks * 16 + hh * 8 + jj];
                                p += __shfl_xor(p, 32); }
                            gt[j] = p; }
                        unsigned sel = 0u;
#pragma unroll
                        for (int j = 0; j < 7; ++j) { int c = 0;
#pragma unroll
                            for (int j2 = 0; j2 < 7; ++j2) c += (gt[j2] > gt[j] || (gt[j2] == gt[j] && j2 < j)) ? 1 : 0;
                            if (j < qb && c < 3) sel |= 1u << j; }
                        { unsigned o = sel;
#pragma unroll
                          for (int s = 1; s < 64; s <<= 1) o |= __shfl_xor(o, s);
                          if (lane == 0 && o) atomicOr((unsigned*)uni, o); }
                        __syncthreads();
                        att::MobaMask mk; mk.qb = qb; mk.wq0 = 32 * wave; mk.tq = tq; mk.sel = sel; mk.uni = __builtin_amdgcn_readfirstlane(*uni);
                        att::State st; att::reset(st);
                        att::flash_run<att::MobaMask, false>(lds, KB + (size_t)b * SEQ * MOBA_DIMC + h * 64, VB + (size_t)b * SEQ * MOBA_DIMC + h * 64, MOBA_DIMC, 0, 4 * (qb + 1), qf, st, mk, tid);
                        att::store_o(YB + tok * DM + 256 + h * 64, st.o0, st.o1, st.l > 0.f ? 1.f / st.l : 0.f, hh);
                        __syncthreads();
                    } else {
                        const int pu = u - 768, tok0 = pu * 32, t0 = tok0 & (SEQ - 1);
                        LAS float* ub = (LAS float*)lds;
                        LAS float* pl = (LAS float*)(lds + 47 * 1024);
                        for (int idx = tid; idx < 47 * 64; idx += 512) { const int rr = idx >> 6, c4 = (idx & 63) * 4; const int t = t0 - 15 + rr;
                            f32x4 v = {0.f, 0.f, 0.f, 0.f}; if (t >= 0) v = *(const f32x4*)(UPOOL + (size_t)(tok0 - 15 + rr) * 256 + c4);
                            *(LAS f32x4*)(ub + rr * 256 + c4) = v; }
                        __syncthreads();
                        for (int idx = tid; idx < 32 * 256; idx += 512) { const int tt = idx >> 8, c = idx & 255, w = 2 << (c >> 6), t = t0 + tt;
                            const int cnt = (t + 1 < w) ? t + 1 : w; float s = 0.f;
                            for (int q = 0; q < cnt; ++q) s += ub[(15 + tt - q) * 256 + c];
                            pl[idx] = s / (float)cnt - ub[(15 + tt) * 256 + c]; }
                        __syncthreads();
                        { const int c = tid & 255, hf = tid >> 8, gi = c >> 6, d = c & 63;
                          const float* pw = (const float*)INP(7) + ((size_t)(i2 * 4 + gi) * 64) * 64 + d; const float sc = ((const float*)INP(8))[i2 * 256 + c];
                          float a[16];
#pragma unroll
                          for (int q = 0; q < 16; ++q) a[q] = 0.f;
                          for (int k = 0; k < 64; ++k) { const float wv = pw[k * 64];
#pragma unroll
                              for (int q = 0; q < 16; ++q) a[q] += pl[(hf * 16 + q) * 256 + gi * 64 + k] * wv; }
#pragma unroll
                          for (int q = 0; q < 16; ++q) YB[(size_t)(tok0 + hf * 16 + q) * DM + c] = (bf16)f2bf(a[q] * sc); }
                        __syncthreads();
                    }
                }
            } else if (ON(8) && !even) {
                for (int u = bx; u < 1024; u += G) {
                    const int tb = 31 - u / 32, bg = u % 32, b = bg >> 2, g = bg & 3;
                    LAS float* pslc = (LAS float*)(lds + att::KV_BYTES);
                    LAS float* sc = (LAS float*)(lds + att::KV_BYTES + 32768);
                    LAS unsigned* selm = (LAS unsigned*)(lds + att::KV_BYTES + 65536);
                    LAS float* yst = (LAS float*)(lds + att::KV_BYTES) + (size_t)wave * 32 * 64 + lane;
                    const int r = lane & 31, hh = lane >> 5, hd = wave & 3, th = wave >> 2, tq = 32 * th + r, t = 64 * tb + tq;
                    const size_t tok = (size_t)b * SEQ + t; const int head = g * 4 + hd;
                    f32x16 y0, y1;
                    bf16x8 qf[4];
                    att::State st;
                    {
                        att::load_q(qf, QRAW + tok * DM + head * 64, hh);
                        att::CmpMask mk; mk.nmax = (t >= 31) ? ((t - 31) >> 4) : -1;
                        const int tlo = 64 * tb + 32 * th, thi = tlo + 31; mk.nlo = (tlo >= 31) ? ((tlo - 31) >> 4) : -1; mk.nhi = (thi >= 31) ? ((thi - 31) >> 4) : -1;
                        att::reset(st);
                        att::flash_run<att::CmpMask, true>(lds, KCMP + (size_t)bg * 128 * 64, VCMP + (size_t)bg * 128 * 64, 64, 0, tb <= 15 ? 1 : 2, qf, st, mk, tid);
                        const float inv = st.l > 0.f ? 1.f / st.l : 0.f, sg = inv * GATES[tok * 48 + head * 3 + 0];
                        y0 = st.o0 * sg; y1 = st.o1 * sg;
#pragma unroll
                        for (int i = 0; i < 16; ++i) pslc[(hd * 64 + tq) * 32 + (i & 3) + 8 * (i >> 2) + 4 * hh] = st.o2[i] * inv;
                    }
                    __syncthreads();
#pragma nounroll
                    for (int p = 0; p < 4; ++p) { const int tt = p * 16 + (tid >> 5), j = tid & 31;
                        float v = -1.f;
                        if (j <= tb) v = (j == 0 || j == tb || j == tb - 1) ? 1e4f : ((pslc[(0 * 64 + tt) * 32 + j] + pslc[(1 * 64 + tt) * 32 + j]) + (pslc[(2 * 64 + tt) * 32 + j] + pslc[(3 * 64 + tt) * 32 + j]));
                        sc[tt * 32 + j] = v; }
                    __syncthreads();
#pragma nounroll
                    for (int p = 0; p < 4; ++p) { const int tt = p * 16 + (tid >> 5), j = tid & 31; const float my = sc[tt * 32 + j]; int c = 0;
#pragma unroll 8
                        for (int j2 = 0; j2 < 32; ++j2) { const float o = sc[tt * 32 + j2]; c += (o > my || (o == my && j2 < j)) ? 1 : 0; }
                        const unsigned long long bm = __ballot(c < 16 && j <= tb);
                        if ((lane & 31) == 0) selm[tt] = (unsigned)(bm >> (lane & 32)); }
                    __syncthreads();
                    unsigned uni;
                    { unsigned o = selm[lane];
#pragma unroll
                      for (int s = 1; s < 64; s <<= 1) o |= __shfl_xor(o, s);
                      uni = __builtin_amdgcn_readfirstlane(o); }
                    const unsigned sel = selm[tq];
                    __syncthreads();
#pragma unroll
                    for (int i = 0; i < 16; ++i) { yst[i * 64] = y0[i]; yst[(16 + i) * 64] = y1[i]; }
                    att::load_q(qf, QROT + tok * DM + head * 64, hh);
                    {
                        att::SelMask mk; mk.tb = tb; mk.tq = tq; mk.wq0 = 32 * th; mk.sel = sel; mk.uni = uni;
                        att::reset(st);
                        att::flash_run<att::SelMask, false>(lds, KSB + (size_t)b * SEQ * 256 + g * 64, VSB + (size_t)b * SEQ * 256 + g * 64, 256, 0, tb + 1, qf, st, mk, tid);
                        const float sg = (st.l > 0.f ? 1.f / st.l : 0.f) * GATES[tok * 48 + head * 3 + 1];
#pragma unroll
                        for (int i = 0; i < 16; ++i) { yst[i * 64] += st.o0[i] * sg; yst[(16 + i) * 64] += st.o1[i] * sg; }
                    }
                    {
                        att::WinMask mk; mk.tb = tb; mk.tq = tq;
                        att::reset(st);
                        att::flash_run<att::WinMask, false>(lds, KWB + (size_t)b * SEQ * 256 + g * 64, VWB + (size_t)b * SEQ * 256 + g * 64, 256, tb >= 8 ? tb - 8 : 0, tb + 1, qf, st, mk, tid);
                        const float sg = (st.l > 0.f ? 1.f / st.l : 0.f) * GATES[tok * 48 + head * 3 + 2];
#pragma unroll
                        for (int i = 0; i < 16; ++i) { y0[i] = yst[i * 64] + st.o0[i] * sg; y1[i] = yst[(16 + i) * 64] + st.o1[i] * sg; }
                    }
                    att::store_o(YB + tok * DM + head * 64, y0, y1, 1.f, hh);
                    __syncthreads();
                }
            }
            BAR_AFTER(pb + 3);
        }
        if (ON(9) && IN(pb + 4)) {
            PHASE_IDS
            const bf16* W = even ? (const bf16*)(ws + WS_W_OUTAB) + (size_t)i2 * DM * DM : (const bf16*)(ws + WS_W_OUTC) + (size_t)i2 * DM * DM;
            pg8::Gemm g{YB, W, DM, DM, DM}; pg8::StaticOrder S; S.init(MTOK, DM, G, bx, DM, DM);
            pg8::EpiRes E{X, XB, SSQ};
            pg8::gemm_phase<pg8::EpiRes, pg8::StaticOrder>(lds, g, S, E, tid);
            BAR_AFTER(pb + 4);
        }
        if (ON(10) && IN(pb + 5)) {
            PHASE_IDS
            pg8::Gemm g{XB, (const bf16*)(ws + WS_W_XQ) + (size_t)l * 256 * DM, DM, DM, DM}; pg8::StaticOrder S; S.init(MTOK, 256, G, bx, DM, DM);
            pg8::EpiXQ E{SSQ, XQ};
            pg8::gemm_phase<pg8::EpiXQ, pg8::StaticOrder>(lds, g, S, E, tid);
            BAR_AFTER(pb + 5);
        }
        if (ON(11) && IN(pb + 6)) {
            PHASE_IDS
            for (int u = bx; u < 256; u += G) {
                const int b = u >> 5, h = (u >> 3) & 3, qt = u & 7;
                const int r = lane & 31, hh = lane >> 5;
                const size_t tok = (size_t)b * SEQ + 256 * qt + 32 * wave + r;
                bf16x8 qf[4]; att::load_q(qf, XQ + tok * 256 + h * 64, hh);
                att::NoMask mk; att::State st; att::reset(st);
                att::flash_run<att::NoMask, false>(lds, XK + ((size_t)l * NB * MEML + (size_t)b * MEML) * 256 + h * 64, XV + ((size_t)l * NB * MEML + (size_t)b * MEML) * 256 + h * 64, 256, 0, 4, qf, st, mk, tid);
                att::store_o(XO + tok * 256 + h * 64, st.o0, st.o1, 1.f / st.l, hh);
            }
            BAR_AFTER(pb + 6);
        }
        if (ON(12) && IN(pb + 7)) {
            PHASE_IDS
            pg8::Gemm g{XO, (const bf16*)(ws + WS_W_XO) + (size_t)l * DM * 256, 256, 256, 256}; pg8::StaticOrder S; S.init(MTOK, DM, G, bx, 256, 256);
            pg8::EpiRes E{X, XB, SSQ};
            pg8::gemm_phase<pg8::EpiRes, pg8::StaticOrder>(lds, g, S, E, tid);
            BAR_AFTER(pb + 7);
        }
        if (IN(pb + 8)) {
            PHASE_IDS
            if (ON(13) && even) {
                pg8::Gemm g{XB, (const bf16*)(ws + WS_W_FFNGU) + (size_t)i2 * 2 * DFF * DM, DM, DM, DM}; pg8::StaticOrder S; S.init(MTOK, 2 * DFF, G, bx, DM, DM);
                pg8::EpiGateUp<false> E{SSQ, nullptr, HB, DFF};
                pg8::gemm_phase<pg8::EpiGateUp<false>, pg8::StaticOrder>(lds, g, S, E, tid);
            } else if (ON(14) && !even) {
                for (int idx = bx * 512 + tid; idx < MOE_MAX_ROWS; idx += G * 512) ROWTOK[idx] = -1;
                const float* gn = norm_g + (l * 3 + 2) * DM; const float* rw = (const float*)INP(21) + (size_t)i2 * DM * NEXP;
                LAS int* lcnt = (LAS int*)lds;
                LAS int* lte = (LAS int*)(lds + 64);
                LAS int* ltp = (LAS int*)(lds + 64 + 512);
                LAS float* ltw = (LAS float*)(lds + 64 + 1024);
                LAS float* ltr = (LAS float*)(lds + 64 + 1536);
                for (int tb0 = bx * 64; tb0 < MTOK; tb0 += G * 64) {
                    if (tid < 16) lcnt[tid] = 0;
                    __syncthreads();
#pragma nounroll
                    for (int q = 0; q < 8; ++q) {
                        const int tl = wave * 8 + q, m = tb0 + tl;
                        f32x4 v[4]; const float s = load_row4(X + (size_t)m * DM, lane, v); const float rstd = rsqrtf(s * (1.f / DM) + NORM_EPS);
                        float lg[NEXP];
#pragma unroll
                        for (int e = 0; e < NEXP; ++e) lg[e] = 0.f;
#pragma unroll
                        for (int j = 0; j < 4; ++j) { const f32x4 gv = *(const f32x4*)(gn + 4 * lane + 256 * j);
#pragma unroll
                            for (int qq = 0; qq < 4; ++qq) { const float hv = v[j][qq] * gv[qq]; const float* wr_ = rw + (size_t)(4 * lane + 256 * j + qq) * NEXP; const f32x4 w0 = *(const f32x4*)wr_, w1 = *(const f32x4*)(wr_ + 4);
                                lg[0] += hv * w0[0]; lg[1] += hv * w0[1]; lg[2] += hv * w0[2]; lg[3] += hv * w0[3]; lg[4] += hv * w1[0]; lg[5] += hv * w1[1]; lg[6] += hv * w1[2]; lg[7] += hv * w1[3]; } }
#pragma unroll
                        for (int e = 0; e < NEXP; ++e) lg[e] = wave_sum(lg[e]) * rstd;
                        int e0 = 0; float v0 = lg[0];
#pragma unroll
                        for (int e = 1; e < NEXP; ++e) if (lg[e] > v0) { v0 = lg[e]; e0 = e; }
                        int e1 = -1; float v1 = -INFINITY;
#pragma unroll
                        for (int e = 0; e < NEXP; ++e) if (e != e0 && lg[e] > v1) { v1 = lg[e]; e1 = e; }
                        if (lane == 0) {
                            const float w1 = 1.f / (1.f + expf(v0 - v1)), w0 = 1.f - w1;
                            lte[2 * tl] = e0; lte[2 * tl + 1] = e1; ltw[2 * tl] = w0; ltw[2 * tl + 1] = w1; ltr[tl] = rstd;
                            ltp[2 * tl] = atomicAdd((int*)(lcnt + e0), 1); ltp[2 * tl + 1] = atomicAdd((int*)(lcnt + e1), 1);
                        }
                    }
                    __syncthreads();
                    if (tid < NEXP) lcnt[8 + tid] = (int)xb_add(ctl + CW_CNT + (i2 * NEXP + tid) * 64, (unsigned)lcnt[tid]);
                    __syncthreads();
                    if (tid < 128) { const int tl = tid >> 1, m = tb0 + tl, e = lte[tid];
                        TOKE[2 * m + (tid & 1)] = e; TOKPOS[2 * m + (tid & 1)] = lcnt[8 + e] + ltp[tid]; TOKW[2 * m + (tid & 1)] = ltw[tid];
                        if ((tid & 1) == 0) TOKRSTD[m] = ltr[tl]; }
                    __syncthreads();
                }
            }
            BAR_AFTER(pb + 8);
        }
        if (IN(pb + 9)) {
            PHASE_IDS
            if (ON(15) && even) {
                pg8::Gemm g{HB, (const bf16*)(ws + WS_W_FFND) + (size_t)i2 * DM * DFF, DFF, DFF, DFF}; pg8::StaticOrder S; S.init(MTOK, DM, G, bx, DFF, DFF);
                pg8::EpiRes E{X, XB, SSQ};
                pg8::gemm_phase<pg8::EpiRes, pg8::StaticOrder>(lds, g, S, E, tid);
            } else if (ON(16) && !even) {
                int base[NEXP]; int acc_t = 0;
#pragma unroll
                for (int e = 0; e < NEXP; ++e) { const int c = (int)xb_ld(ctl + CW_CNT + (i2 * NEXP + e) * 64); base[e] = acc_t * 256; const int nt_ = (c + 255) >> 8;
                    if (bx == 0 && tid == 0) for (int q = 0; q < nt_; ++q) TILEE[acc_t + q] = e;
                    acc_t += nt_; }
                if (bx == 0 && tid == 0) TILEE[MOE_MAX_TILES] = acc_t;
                for (int m = gw; m < MTOK; m += NGW) {
                    const int e0 = TOKE[2 * m], e1 = TOKE[2 * m + 1];
                    int b0 = 0, b1 = 0;
#pragma unroll
                    for (int e = 0; e < NEXP; ++e) { b0 = (e == e0) ? base[e] : b0; b1 = (e == e1) ? base[e] : b1; }
                    const int r0 = b0 + TOKPOS[2 * m], r1 = b1 + TOKPOS[2 * m + 1];
                    const u32x4 a = *(const u32x4*)(XB + (size_t)m * DM + 8 * lane), c = *(const u32x4*)(XB + (size_t)m * DM + 512 + 8 * lane);
                    *(u32x4*)(XPERM + (size_t)r0 * DM + 8 * lane) = a; *(u32x4*)(XPERM + (size_t)r0 * DM + 512 + 8 * lane) = c;
                    *(u32x4*)(XPERM + (size_t)r1 * DM + 8 * lane) = a; *(u32x4*)(XPERM + (size_t)r1 * DM + 512 + 8 * lane) = c;
                    if (lane == 0) { const float rs_ = TOKRSTD[m]; ROWTOK[r0] = 2 * m; ROWTOK[r1] = 2 * m + 1; ROWW[r0] = TOKW[2 * m]; ROWW[r1] = TOKW[2 * m + 1]; ROWRSTD[r0] = rs_; ROWRSTD[r1] = rs_; }
                }
            }
            BAR_AFTER(pb + 9);
        }
        if (ON(17) && IN(pb + 10) && !even) {
            PHASE_IDS
            pg8::Gemm g{XPERM, (const bf16*)(ws + WS_W_MOEGU), DM, DM, DM}; pg8::MoeOrder S{TILEE, 2 * DFFE / 256, G, bx, DM, DM, 2 * DFFE};
            pg8::EpiGateUp<true> E{nullptr, ROWRSTD, HB, DFFE};
            pg8::gemm_phase<pg8::EpiGateUp<true>, pg8::MoeOrder>(lds, g, S, E, tid);
            BAR_AFTER(pb + 10);
        }
        if (ON(18) && IN(pb + 11) && !even) {
            PHASE_IDS
            pg8::Gemm g{HB, (const bf16*)(ws + WS_W_MOED), DFFE, DFFE, DFFE}; pg8::MoeOrder S{TILEE, DM / 256, G, bx, DFFE, DFFE, DM};
            pg8::EpiMoeDown E{ROWTOK, ROWW, YMOE};
            pg8::gemm_phase<pg8::EpiMoeDown, pg8::MoeOrder>(lds, g, S, E, tid);
            BAR_AFTER(pb + 11);
        }
        if (ON(19) && IN(pb + 12) && !even) {
            PHASE_IDS
            if (l == 1) {
                LAS ConvJob* jobsw = (LAS ConvJob*)(lds + 72 * 1024);
                LAS int* jmeta = (LAS int*)(lds + 80 * 1024);
                if (tid == 0) {
                    int nj = 0, tot = 0;
#pragma nounroll
                    for (int e = 0; e < NEXP; ++e) {
                        ADD_JOB((const float*)INP(22) + (size_t)(NEXP + e) * DM * DFFE, (bf16*)(ws + WS_W_MOEGU) + (size_t)e * 2 * DFFE * DM, norm_g + (3 * 3 + 2) * DM, DM, DFFE, 1);
                        ADD_JOB((const float*)INP(23) + (size_t)(NEXP + e) * DM * DFFE, (bf16*)(ws + WS_W_MOEGU) + (size_t)e * 2 * DFFE * DM, norm_g + (3 * 3 + 2) * DM, DM, DFFE, 2);
                        ADD_JOB((const float*)INP(24) + (size_t)(NEXP + e) * DFFE * DM, (bf16*)(ws + WS_W_MOED) + (size_t)e * DM * DFFE, (const float*)nullptr, DFFE, DM, 0);
                    }
                    jmeta[0] = nj; jmeta[1] = tot;
                }
                __syncthreads();
                run_conv_jobs(lds, jmeta[0], jmeta[1], gw, NGW, wave, lane);
            }
            for (int m = gw; m < MTOK; m += NGW) {
                f32x4 v[4]; float s = 0.f;
#pragma unroll
                for (int j = 0; j < 4; ++j) { const size_t o = (size_t)m * DM + 4 * lane + 256 * j;
                    v[j] = (*(const f32x4*)(X + o) + *(const f32x4*)(YMOE + o)) + *(const f32x4*)(YMOE + (size_t)MTOK * DM + o);
                    s += (v[j][0] * v[j][0] + v[j][1] * v[j][1]) + (v[j][2] * v[j][2] + v[j][3] * v[j][3]); }
                s = wave_sum(s);
                if (l == 3) { const float r = rsqrtf(s * (1.f / DM) + NORM_EPS);
#pragma unroll
                    for (int j = 0; j < 4; ++j) *(f32x4*)(X + (size_t)m * DM + 4 * lane + 256 * j) = v[j] * r * *(const f32x4*)(final_g + 4 * lane + 256 * j);
                } else {
#pragma unroll
                    for (int j = 0; j < 4; ++j) *(f32x4*)(X + (size_t)m * DM + 4 * lane + 256 * j) = v[j];
                    store_row_bf16(XB + (size_t)m * DM, lane, v); store_ssq_full(SSQ, m, s, lane);
                }
            }
            BAR_AFTER(pb + 12);
        }
    }
#undef IN
#undef BAR_AFTER
}
#undef ws
#undef ctl
#undef X

static bool phase_applies(int p) {
    if (p < 2) return true;
    const int l = (p - 2) / 13, k = (p - 2) % 13; const bool even = (l & 1) == 0;
    if (even) return k != 2 && k < 10;
    return true;
}
#ifndef DUP_EVEN
#define DUP_EVEN 0u
#endif
#ifndef DUP_ODD
#define DUP_ODD 0u
#endif
static bool probe_dup(int p) {
    if (p == 0) return (DUP_EVEN >> 13) & 1u;
    if (p == 1) return (DUP_EVEN >> 14) & 1u;
    const int l = (p - 2) / 13, k = (p - 2) % 13;
    return (((l & 1) ? DUP_ODD : DUP_EVEN) >> k) & 1u;
}
extern "C" void kernel_launch(void* const* d_in, const int* in_sizes, int n_in, void* d_out, int out_size, void* d_ws, size_t ws_size, hipStream_t stream) {
    static int grid = 0;
    if (grid == 0) {
        if (n_in != 28 || out_size != MTOK * DM || ws_size < WS_END) { fprintf(stderr, "kernel_launch: unexpected shapes (n_in %d out %d ws %zu need %zu)\n", n_in, out_size, ws_size, (size_t)WS_END); grid = -1; return; }
        int dev = 0, cus = 0;
        if (hipGetDevice(&dev) != hipSuccess || hipDeviceGetAttribute(&cus, hipDeviceAttributeMultiprocessorCount, dev) != hipSuccess) { grid = -1; return; }
        if (hipFuncSetAttribute((const void*)mk_fwd, hipFuncAttributeMaxDynamicSharedMemorySize, LDS_BYTES) != hipSuccess) { fprintf(stderr, "kernel_launch: hipFuncSetAttribute failed\n"); grid = -1; return; }
        int per_cu = 0;
        if (hipOccupancyMaxActiveBlocksPerMultiprocessor(&per_cu, (const void*)mk_fwd, NWAVES * 64, LDS_BYTES) != hipSuccess || per_cu < 1) fprintf(stderr, "kernel_launch: occupancy query reports %d\n", per_cu);
        (void)hipGetLastError();
        grid = cus;
    }
    if (grid < 0) return;
    (void)hipMemsetAsync((char*)d_ws + WS_CTL, 0, CTL_ZERO_BYTES, stream);
    Args a{};
    for (int i = 0; i < 28; ++i) a.in[i] = d_in[i];
    a.out = (float*)d_out; a.ws = (unsigned char*)d_ws;
    for (int j = 0; j < 8; ++j) a.invf[j] = pow(500000.0, -(double)(2 * j) / 16.0);
#if MK_SINGLE
    a.ph_lo = 0; a.ph_hi = NPH;
    hipLaunchKernelGGL(mk_fwd, dim3(grid), dim3(NWAVES * 64), LDS_BYTES, stream, a);
#else
    for (int p = 0; p < NPH; ++p) {
        if (!phase_applies(p)) continue;
        a.ph_lo = p; a.ph_hi = p + 1;
        const int nrep = probe_dup(p) ? 2 : 1;
        for (int r = 0; r < nrep; ++r) hipLaunchKernelGGL(mk_fwd, dim3(grid), dim3(NWAVES * 64), LDS_BYTES, stream, a);
    }
#endif
}
```

```cpp
#include <hip/hip_runtime.h>
#include <cstdio>
#include <cstdint>
#include <cmath>
#include <cstddef>

#ifndef MK_SINGLE
#define MK_SINGLE 1
#endif

#ifndef PHMASK
#define PHMASK 0xFFFFFFu
#endif
#define ON(n) (((PHMASK) >> (n)) & 1u)
#ifndef DELAYMASK
#define DELAYMASK 0u
#endif
#define DLY(n) (((DELAYMASK) >> (n)) & 1u)
#define GAS __attribute__((address_space(1)))
#define LAS __attribute__((address_space(3)))
typedef unsigned short bf16;
typedef short bf16x8 __attribute__((ext_vector_type(8)));
typedef short s16x4 __attribute__((ext_vector_type(4)));
typedef float f32x4 __attribute__((ext_vector_type(4)));
typedef float f32x2 __attribute__((ext_vector_type(2)));
typedef float f32x16 __attribute__((ext_vector_type(16)));
typedef unsigned u32x4 __attribute__((ext_vector_type(4)));
typedef unsigned u32x2 __attribute__((ext_vector_type(2)));
typedef __bf16 bf16x2_t __attribute__((ext_vector_type(2)));

constexpr int NB = 8, SEQ = 2048, DM = 1024, MTOK = NB * SEQ, MEML = 256;
constexpr int AB_IN = 2560, MOBA_DIMC = 768, C_IN = 2608, C_IN_PAD = 2816;
constexpr int DFF = 2816, DFFE = 3584, NEXP = 8;
constexpr int MOE_MAX_TILES = 136, MOE_MAX_ROWS = MOE_MAX_TILES * 256;
constexpr int CMP_SPLIT = 8;
constexpr float NORM_EPS = 1e-5f;
constexpr float C2 = 0.125f * 1.4426950408889634f;

constexpr size_t MiB = 1u << 20, KiB = 1024;
constexpr size_t WS_CTL = 0, CTL_ZERO_BYTES = 64 * KiB;
constexpr size_t WS_W_INAB = 1 * MiB, WS_W_OUTAB = 11 * MiB, WS_W_FFNGU = 15 * MiB, WS_W_FFND = 37 * MiB, WS_W_INC = 48 * MiB, WS_W_CW1 = 59 * MiB,
                 WS_W_OUTC = 63 * MiB, WS_W_XQ = 67 * MiB, WS_W_XKV = 69 * MiB, WS_W_XO = 73 * MiB, WS_W_MOEGU = 75 * MiB, WS_W_MOED = 187 * MiB;
constexpr size_t WS_XB = 243 * MiB, WS_SSQ = 275 * MiB, WS_MISC = 276 * MiB, WS_MEMB = 280 * MiB, WS_XK = 284 * MiB, WS_XV = 288 * MiB,
                 WS_YB = 292 * MiB, WS_XQ = 324 * MiB, WS_XO = 332 * MiB, WS_ROUTE = 340 * MiB, WS_REGA = 342 * MiB, WS_REGB = 538 * MiB, WS_END = 776 * MiB;
constexpr size_t MISC_CS = 0, MISC_KMEAN = 128 * KiB, MISC_KCMP = 512 * KiB, MISC_VCMP = 1024 * KiB;
constexpr size_t RT_TOKE = 0, RT_TOKPOS = 128 * KiB, RT_TOKW = 256 * KiB, RT_TOKRSTD = 384 * KiB, RT_ROWTOK = 512 * KiB, RT_ROWW = 704 * KiB, RT_ROWRSTD = 896 * KiB, RT_TILEE = 1088 * KiB, RT_LCNT = 1152 * KiB;
constexpr size_t RA_UPOOL = 0, RA_QB = 16 * MiB, RA_KB = 40 * MiB, RA_VB = 64 * MiB;
constexpr size_t RA_QRAW = 0, RA_QROT = 32 * MiB, RA_ACMPK = 64 * MiB, RA_ACMPV = 80 * MiB, RA_KS = 96 * MiB, RA_VS = 104 * MiB, RA_KW = 112 * MiB, RA_VW = 120 * MiB,
                 RA_GATES = 128 * MiB, RA_CPART = 132 * MiB;
constexpr size_t RA_YMOE = 0, RA_XPERM = 128 * MiB;
constexpr int CW_BAR = 4096, CW_CNT = 8192;

constexpr int RING_BYTES = 131072, LDS_BYTES = 147456, LDSCTL_OFF = LDS_BYTES - 512, MISC_OFF = LDSCTL_OFF + 320;
constexpr int CONV_JOBS_OFF = 8 * 64 * 65 * 4, CONV_META_OFF = CONV_JOBS_OFF + 64 * 48;
static_assert(CONV_META_OFF + 64 <= LDSCTL_OFF, "LDS map");
constexpr int NWAVES = 8;

__device__ __forceinline__ unsigned f2bf(float f) { unsigned u = __builtin_bit_cast(unsigned, f); return (u + 0x7fffu + ((u >> 16) & 1u)) >> 16; }
__device__ __forceinline__ unsigned pk2(float lo, float hi) { f32x2 v = {lo, hi}; bf16x2_t b = __builtin_convertvector(v, bf16x2_t); return __builtin_bit_cast(unsigned, b); }
__device__ __forceinline__ float bf2f(unsigned short b) { return __builtin_bit_cast(float, (unsigned)b << 16); }
__device__ __forceinline__ float wave_sum(float v) {
#pragma unroll
    for (int o = 1; o < 64; o <<= 1) v += __shfl_xor(v, o);
    return v;
}
__device__ __forceinline__ float fast_exp2(float x) { return __builtin_amdgcn_exp2f(x); }
__device__ __forceinline__ float fast_rcp(float x) { return __builtin_amdgcn_rcpf(x); }
__device__ __forceinline__ float silu_f(float x) { return x * fast_rcp(1.f + fast_exp2(-1.4426950408889634f * x)); }
__device__ __forceinline__ float sigmoid_f(float x) { return fast_rcp(1.f + fast_exp2(-1.4426950408889634f * x)); }
__device__ __forceinline__ float gelu_tanh_f(float x) {
    const float u = 0.7978845608028654f * (x + 0.044715f * x * x * x);
    const float t = 1.f - 2.f * fast_rcp(1.f + fast_exp2(2.f * 1.4426950408889634f * u));
    return 0.5f * x * (1.f + t);
}
#define LDS_WAIT() asm volatile("s_waitcnt lgkmcnt(0)" ::: "memory")
__device__ __forceinline__ unsigned pk4_fp8(float a, float b, float c, float d) {
    a = __builtin_amdgcn_fmed3f(a, -448.f, 448.f); b = __builtin_amdgcn_fmed3f(b, -448.f, 448.f); c = __builtin_amdgcn_fmed3f(c, -448.f, 448.f); d = __builtin_amdgcn_fmed3f(d, -448.f, 448.f);
    int r = 0; r = __builtin_amdgcn_cvt_pk_fp8_f32(a, b, r, false); r = __builtin_amdgcn_cvt_pk_fp8_f32(c, d, r, true); return (unsigned)r;
}
constexpr float FP8_SW_GU = 64.f, FP8_SW_D = 128.f, FP8_SX = 4.f, FP8_SH = 8.f;
constexpr int E8(int e) { return (127 - e) * 0x01010101; }

namespace pg8 {
#define PG8_LAS __attribute__((address_space(3)))
constexpr int BM = 256, BK = 64, HALF = 128, HTB = HALF * BK * 2, NXCD = 8, WGM = 8;
__host__ __device__ __forceinline__ int lds_byte(int r, int c) { const int st = (r >> 4) * 2 + (c >> 5), rr = r & 15, cc = c & 31, ob = rr * 64 + cc * 2; return st * 1024 + (ob ^ (((ob >> 9) & 1) << 5)); }
__host__ __device__ __forceinline__ void stage_rc(int b, int& R, int& C) { const int st = b / 1024, sb = b % 1024, swz = sb ^ (((sb >> 9) & 1) << 5); R = (st >> 1) * 16 + swz / 64; C = (st & 1) * 32 + (swz % 64) / 2; }
__host__ __device__ __forceinline__ int perm32(int rho) { const int n = rho >> 4, i = rho & 15; return 8 * (i >> 2) + 4 * n + (i & 3); }

typedef int v8i32 __attribute__((ext_vector_type(8)));
typedef int v4i32 __attribute__((ext_vector_type(4)));
__device__ __forceinline__ bf16x8 half8(const v8i32& v, int k) { return k ? __builtin_bit_cast(bf16x8, __builtin_shufflevector(v, v, 4, 5, 6, 7)) : __builtin_bit_cast(bf16x8, __builtin_shufflevector(v, v, 0, 1, 2, 3)); }
struct Unit { int pm, pn, aux; size_t oa, ob; };
struct Gemm { const bf16* A; const bf16* Bt; int lda, ldb, K; };

struct StaticOrder {
    int nM, nN, nwg, G, c, lda, ldb;
    __device__ void init(int M, int N, int G_, int c_, int lda_, int ldb_) { nM = M / BM; nN = N / BM; nwg = nM * nN; G = G_; c = c_; lda = lda_; ldb = ldb_; }
    __device__ bool next(int i, Unit& u) const {
        const long L = (long)i * G + c; if (L >= nwg) return false;
        int wgid = (int)L; { const int q = nwg / NXCD, r = nwg % NXCD, xcd = wgid % NXCD, off = wgid / NXCD; wgid = (xcd < r ? xcd * (q + 1) : r * (q + 1) + (xcd - r) * q) + off; }
        const int nig = WGM * nN, gid = wgid / nig, fm = gid * WGM, gsz = (nM - fm) < WGM ? (nM - fm) : WGM;
        u.pm = fm + ((wgid % nig) % gsz); u.pn = (wgid % nig) / gsz; u.aux = 0;
        u.oa = (size_t)u.pm * BM * lda * 2; u.ob = (size_t)u.pn * BM * ldb * 2; return true;
    }
};

template <class Epi, class Sched, bool FP8 = false, int SCA = 0x7F7F7F7F, int SCB = 0x7F7F7F7F>
__device__ __forceinline__ void gemm_phase(PG8_LAS unsigned char* lds, const Gemm g, const Sched& S, const Epi& E, const int tid) {
    const int wid = __builtin_amdgcn_readfirstlane(tid >> 6), lane = tid & 63, wr = wid >> 2, wc = wid & 3, fr = lane & 15, fq = lane >> 4;
    const int K = g.K, nt = K / BK;
    unsigned voffA[2], voffB[2];
#pragma unroll
    for (int i = 0; i < 2; ++i) { int R, C; stage_rc(tid * 16 + i * 8192, R, C); const int Rb = Epi::PERM ? ((R & ~31) + perm32(R & 31)) : R;
        voffA[i] = (unsigned)(R * g.lda + C) * 2u; voffB[i] = (unsigned)(Rb * g.ldb + C) * 2u; }
    const size_t kstep = (size_t)(BK * 2);
    const size_t hstepA = (size_t)HALF * g.lda * 2, hstepB = (size_t)HALF * g.ldb * 2;
    const unsigned ldsw = (unsigned)wid * 1024u;
    const int aoff = lds_byte(wr * 64 + fr, fq * 8), boff = lds_byte(wc * 32 + fr, fq * 8);
#define PG8_SA(b, h) (((b) * 2 + (h)) * HTB)
#define PG8_SB(b, h) ((4 + (b) * 2 + (h)) * HTB)
#define PG8_STAGE(bufoff, gbase, voff) do { _Pragma("unroll") for (int _i = 0; _i < 2; ++_i) \
        __builtin_amdgcn_global_load_lds((const unsigned*)((const char*)(gbase) + (voff)[_i]), (PG8_LAS unsigned*)(lds + (bufoff) + ldsw + _i * 8192), 16, 0, 0); } while (0)
#define PG8_LDA(dst, b, h) do { _Pragma("unroll") for (int m = 0; m < 4; ++m) { const v4i32 x_ = *(const PG8_LAS v4i32*)(lds + PG8_SA(b, h) + aoff + m * 2048), y_ = *(const PG8_LAS v4i32*)(lds + PG8_SA(b, h) + aoff + m * 2048 + 1024); dst[m] = __builtin_shufflevector(x_, y_, 0, 1, 2, 3, 4, 5, 6, 7); } } while (0)
#define PG8_LDB(dst, b, h) do { _Pragma("unroll") for (int n = 0; n < 2; ++n) { const v4i32 x_ = *(const PG8_LAS v4i32*)(lds + PG8_SB(b, h) + boff + n * 2048), y_ = *(const PG8_LAS v4i32*)(lds + PG8_SB(b, h) + boff + n * 2048 + 1024); dst[n] = __builtin_shufflevector(x_, y_, 0, 1, 2, 3, 4, 5, 6, 7); } } while (0)
#define PG8_MMA(ai, bj, At, Bt) do { __builtin_amdgcn_s_setprio(1); _Pragma("unroll") for (int m = 0; m < 4; ++m) _Pragma("unroll") for (int n = 0; n < 2; ++n) { \
        if constexpr (FP8) { asm volatile("v_mfma_scale_f32_16x16x128_f8f6f4 %0, %1, %2, %0, %3, %4 op_sel_hi:[0,0,0]" : "+v"(acc[ai][bj][m][n]) : "v"(Bt[n]), "v"(At[m]), "v"(sca_), "v"(scb_)); } \
        else { _Pragma("unroll") for (int k = 0; k < 2; ++k) acc[ai][bj][m][n] = __builtin_amdgcn_mfma_f32_16x16x32_bf16(half8(Bt[n], k), half8(At[m], k), acc[ai][bj][m][n], 0, 0, 0); } } \
        __builtin_amdgcn_s_setprio(0); } while (0)
#define PG8_WAIT_V(n) asm volatile("s_waitcnt vmcnt(" #n ")" ::: "memory")
#define PG8_WAIT_L(n) asm volatile("s_waitcnt lgkmcnt(" #n ")" ::: "memory")
#define PG8_BAR __builtin_amdgcn_s_barrier()
#define PG8_SCHED __builtin_amdgcn_sched_barrier(0)
    Unit cur, nxt; int ui = 0;
    if (!S.next(0, cur)) return;
    int sca_ = SCA, scb_ = SCB; if constexpr (FP8) asm volatile("" : "+v"(sca_), "+v"(scb_));
    f32x4 acc[2][2][4][2];
#pragma unroll
    for (int a = 0; a < 2; ++a)
#pragma unroll
        for (int b = 0; b < 2; ++b)
#pragma unroll
            for (int m = 0; m < 4; ++m)
#pragma unroll
                for (int n = 0; n < 2; ++n) acc[a][b][m][n] = (f32x4){0.f, 0.f, 0.f, 0.f};
    v8i32 At[4], B0[2], B1[2];
    const char* cA = (const char*)g.A + cur.oa; const char* cB = (const char*)g.Bt + cur.ob;
    PG8_STAGE(PG8_SB(0, 0), cB, voffB); PG8_STAGE(PG8_SB(0, 1), cB + hstepB, voffB); PG8_STAGE(PG8_SA(0, 0), cA, voffA); PG8_STAGE(PG8_SA(0, 1), cA + hstepA, voffA);
    if (wr == 1) PG8_BAR;
    PG8_WAIT_V(2); PG8_BAR;
    PG8_STAGE(PG8_SB(1, 0), cB + kstep, voffB); PG8_STAGE(PG8_SA(1, 0), cA + kstep, voffA); PG8_STAGE(PG8_SB(1, 1), cB + hstepB + kstep, voffB);
    PG8_WAIT_V(6); PG8_BAR;
    for (;;) {
        const bool has_next = S.next(ui + 1, nxt);
        const char* nA = has_next ? (const char*)g.A + nxt.oa : cA; const char* nB = has_next ? (const char*)g.Bt + nxt.ob : cB;
#pragma nounroll
        for (int t = 0; t < nt; t += 2) {
            const bool last = (t == nt - 2);
            const char* a1 = cA + (size_t)(t + 1) * kstep;
            const char* a2 = last ? nA : cA + (size_t)(t + 2) * kstep; const char* b2 = last ? nB : cB + (size_t)(t + 2) * kstep;
            const char* a3 = a2 + kstep; const char* b3 = b2 + kstep;
            PG8_LDB(B0, 0, 0); PG8_LDB(B1, 0, 1); PG8_SCHED; PG8_LDA(At, 0, 0); PG8_STAGE(PG8_SA(1, 1), a1 + hstepA, voffA);
            PG8_WAIT_V(8); PG8_WAIT_L(0); PG8_BAR; PG8_MMA(0, 0, At, B0); PG8_MMA(0, 1, At, B1); PG8_BAR; PG8_SCHED;
            PG8_LDA(At, 0, 1); PG8_STAGE(PG8_SB(0, 0), b2, voffB); PG8_STAGE(PG8_SB(0, 1), b2 + hstepB, voffB); PG8_STAGE(PG8_SA(0, 0), a2, voffA);
            PG8_WAIT_V(8); PG8_WAIT_L(0); PG8_BAR; PG8_MMA(1, 0, At, B0); PG8_MMA(1, 1, At, B1); PG8_BAR; PG8_SCHED;
            PG8_LDB(B0, 1, 0); PG8_LDB(B1, 1, 1); PG8_SCHED; PG8_LDA(At, 1, 0); PG8_STAGE(PG8_SA(0, 1), a2 + hstepA, voffA);
            PG8_WAIT_V(8); PG8_WAIT_L(0); PG8_BAR; PG8_MMA(0, 0, At, B0); PG8_MMA(0, 1, At, B1); PG8_BAR; PG8_SCHED;
            PG8_LDA(At, 1, 1); PG8_STAGE(PG8_SB(1, 0), b3, voffB); PG8_STAGE(PG8_SB(1, 1), b3 + hstepB, voffB); PG8_STAGE(PG8_SA(1, 0), a3, voffA);
            PG8_WAIT_V(8); PG8_WAIT_L(0); PG8_BAR; PG8_MMA(1, 0, At, B0); PG8_MMA(1, 1, At, B1); PG8_BAR; PG8_SCHED;
        }
        if (wr == 0) PG8_BAR;
        { int l_ = threadIdx.x; asm volatile("" : "+v"(l_)); const int fr_ = l_ & 15, fq_ = (l_ >> 4) & 3; E(acc, cur, wr, wc, fr_, fq_); }
        if (!has_next) break;
#pragma unroll
        for (int a = 0; a < 2; ++a)
#pragma unroll
            for (int b = 0; b < 2; ++b)
#pragma unroll
                for (int m = 0; m < 4; ++m)
#pragma unroll
                    for (int n = 0; n < 2; ++n) acc[a][b][m][n] = (f32x4){0.f, 0.f, 0.f, 0.f};
        cur = nxt; cA = nA; cB = nB; ++ui;
        if (wr == 1) PG8_BAR;
    }
    PG8_WAIT_V(0);
    PG8_BAR;
#undef PG8_SA
#undef PG8_SB
#undef PG8_STAGE
#undef PG8_LDA
#undef PG8_LDB
#undef PG8_MMA
#undef PG8_WAIT_V
#undef PG8_WAIT_L
#undef PG8_BAR
#undef PG8_SCHED
}

typedef f32x4 Acc[2][2][4][2];

__device__ __forceinline__ void load_rstd(const float* ssq, int row0, int fq, float (&rs)[2][4]) {
#pragma unroll
    for (int ai = 0; ai < 2; ++ai)
#pragma unroll
        for (int m = 0; m < 4; ++m) {
            const float* p = ssq + (size_t)(fq * 4) * MTOK + row0 + ai * HALF + m * 16;
            float s = (p[0] + p[MTOK]) + (p[2 * MTOK] + p[3 * MTOK]);
            s += __shfl_xor(s, 16); s += __shfl_xor(s, 32);
            rs[ai][m] = rsqrtf(s * (1.f / DM) + NORM_EPS);
        }
}
__device__ __forceinline__ float row_rstd(const float* ssq, int row, int fq) {
    const float* p = ssq + (size_t)(fq * 4) * MTOK + row;
    float s = (p[0] + p[MTOK]) + (p[2 * MTOK] + p[3 * MTOK]);
    s += __shfl_xor(s, 16); s += __shfl_xor(s, 32);
    return rsqrtf(s * (1.f / DM) + NORM_EPS);
}
__device__ __forceinline__ u32x4 pack8(const f32x4& a, const f32x4& b) { u32x4 w; w.x = pk2(a[0], a[1]); w.y = pk2(a[2], a[3]); w.z = pk2(b[0], b[1]); w.w = pk2(b[2], b[3]); return w; }
__device__ __forceinline__ void rope8(f32x4& v0, f32x4& v1, const float* cs, int fq) {
    const f32x4 c0 = *(const f32x4*)(cs), c1 = *(const f32x4*)(cs + 4), s0 = *(const f32x4*)(cs + 8), s1 = *(const f32x4*)(cs + 12);
    f32x4 p0, p1;
#pragma unroll
    for (int e = 0; e < 4; ++e) { p0[e] = __shfl_xor(v0[e], 16); p1[e] = __shfl_xor(v1[e], 16); }
    if (fq == 0) { v0 = v0 * c0 - p0 * s0; v1 = v1 * c1 - p1 * s1; }
    else if (fq == 1) { v0 = p0 * s0 + v0 * c0; v1 = p1 * s1 + v1 * c1; }
}

struct EpiInAB {
    static constexpr bool PERM = true;
    const float* ssq; const float* cs; unsigned char* ra; float* kpart;
    __device__ __forceinline__ void operator()(const Acc& acc, const Unit& u, int wr, int wc, int fr, int fq) const {
        const int row0 = u.pm * BM + wr * 64 + fr;
        float rs[2][4]; load_rstd(ssq, row0, fq, rs);
        if (u.pn == 0) {
#pragma unroll
            for (int ai = 0; ai < 2; ++ai)
#pragma unroll
                for (int m = 0; m < 4; ++m) { const int row = row0 + ai * HALF + m * 16; float* rp = (float*)(ra + RA_UPOOL) + (size_t)row * 256 + wc * 32 + fq * 8;
#pragma unroll
                    for (int bj = 0; bj < 2; ++bj) { *(f32x4*)(rp + bj * HALF) = acc[ai][bj][m][0] * rs[ai][m]; *(f32x4*)(rp + bj * HALF + 4) = acc[ai][bj][m][1] * rs[ai][m]; } }
        } else {
            const int t = (u.pn - 1) / 3, cb = ((u.pn - 1) % 3) * 256;
            bf16* dst = (bf16*)(ra + RA_QB + (size_t)t * (RA_KB - RA_QB));
            const bool rope = (t < 2) && ((wc & 1) == 0);
#pragma unroll
            for (int ai = 0; ai < 2; ++ai)
#pragma unroll
                for (int m = 0; m < 4; ++m) { const int row = row0 + ai * HALF + m * 16; bf16* rp = dst + (size_t)row * MOBA_DIMC + cb + wc * 32 + fq * 8;
                    const float* csr = cs + (size_t)(row & (SEQ - 1)) * 16;
#pragma unroll
                    for (int bj = 0; bj < 2; ++bj) { f32x4 v0 = acc[ai][bj][m][0] * rs[ai][m], v1 = acc[ai][bj][m][1] * rs[ai][m];
                        if (rope) rope8(v0, v1, csr, fq);
                        *(u32x4*)(rp + bj * HALF) = pack8(v0, v1); } }
            if (t == 1) {
                asm volatile("s_waitcnt vmcnt(0)" ::: "memory");
                const int lane_ = fq * 16 + fr, cl = cb + (lane_ >> 5) * HALF + wc * 32 + (lane_ & 31);
                const bf16* kp = dst + (size_t)(u.pm * BM + wr * 64) * MOBA_DIMC + cl; float sum = 0.f;
#pragma unroll 1
                for (int ai = 0; ai < 2; ++ai)
#pragma unroll 16
                    for (int rr = 0; rr < 64; ++rr) sum += bf2f(kp[(size_t)(ai * HALF + rr) * MOBA_DIMC]);
                kpart[(size_t)(u.pm * 2 + wr) * MOBA_DIMC + cl] = sum;
            }
        }
    }
};

struct EpiInC {
    static constexpr bool PERM = true;
    const float* ssq; const float* cs; unsigned char* ra; const float* pek; const float* pev;
    __device__ __forceinline__ void operator()(const Acc& acc, const Unit& u, int wr, int wc, int fr, int fq) const {
        const int row0 = u.pm * BM + wr * 64 + fr;
        const int pn = u.pn;
        const bool rope = ((wc & 1) == 0);
        if (pn < 4) {
#pragma unroll
            for (int ai = 0; ai < 2; ++ai)
#pragma unroll
                for (int m = 0; m < 4; ++m) { const int row = row0 + ai * HALF + m * 16; const float rsv = row_rstd(ssq, row, fq); const size_t off = (size_t)row * DM + pn * 256 + wc * 32 + fq * 8;
                    const float* csr = cs + (size_t)(row & (SEQ - 1)) * 16;
#pragma unroll
                    for (int bj = 0; bj < 2; ++bj) { f32x4 v0 = acc[ai][bj][m][0] * rsv, v1 = acc[ai][bj][m][1] * rsv;
                        *(u32x4*)((bf16*)(ra + RA_QRAW) + off + bj * HALF) = pack8(v0, v1);
                        if (rope) rope8(v0, v1, csr, fq);
                        *(u32x4*)((bf16*)(ra + RA_QROT) + off + bj * HALF) = pack8(v0, v1); } }
        } else if (pn < 6) {
            bf16* ac = (bf16*)(ra + RA_ACMPK + (size_t)(pn - 4) * (RA_ACMPV - RA_ACMPK)); const float* pe = pek + (ptrdiff_t)(pn - 4) * (pev - pek);
#pragma unroll
            for (int ai = 0; ai < 2; ++ai)
#pragma unroll
                for (int m = 0; m < 4; ++m) { const int row = row0 + ai * HALF + m * 16; const float rsv = row_rstd(ssq, row, fq); const int b = row >> 11, t = row & (SEQ - 1);
#pragma unroll
                    for (int bj = 0; bj < 2; ++bj) { const int c = bj * HALF + wc * 32 + fq * 8, gi = c >> 6, d = c & 63;
                        const f32x4 v0 = acc[ai][bj][m][0] * rsv, v1 = acc[ai][bj][m][1] * rsv;
                        const int n1 = t >> 4, l1 = t & 15;
                        if (n1 <= 126) { const float* pp = pe + l1 * 64 + d; const f32x4 a0 = v0 + *(const f32x4*)pp, a1 = v1 + *(const f32x4*)(pp + 4);
                            *(u32x4*)(ac + ((size_t)((b * 4 + gi) * 128 + n1)) * 2048 + l1 * 64 + d) = pack8(a0, a1); }
                        const int n2 = n1 - 1, l2 = l1 + 16;
                        if (n2 >= 0) { const float* pp = pe + l2 * 64 + d; const f32x4 a0 = v0 + *(const f32x4*)pp, a1 = v1 + *(const f32x4*)(pp + 4);
                            *(u32x4*)(ac + ((size_t)((b * 4 + gi) * 128 + n2)) * 2048 + l2 * 64 + d) = pack8(a0, a1); } } }
        } else if (pn < 10) {
            bf16* dst = (bf16*)(ra + RA_KS + (size_t)(pn - 6) * (RA_VS - RA_KS));
            const bool rp_ = rope && ((pn & 1) == 0);
#pragma unroll
            for (int ai = 0; ai < 2; ++ai)
#pragma unroll
                for (int m = 0; m < 4; ++m) { const int row = row0 + ai * HALF + m * 16; const float rsv = row_rstd(ssq, row, fq); bf16* rp = dst + (size_t)row * 256 + wc * 32 + fq * 8;
                    const float* csr = cs + (size_t)(row & (SEQ - 1)) * 16;
#pragma unroll
                    for (int bj = 0; bj < 2; ++bj) { f32x4 v0 = acc[ai][bj][m][0] * rsv, v1 = acc[ai][bj][m][1] * rsv;
                        if (rp_) rope8(v0, v1, csr, fq);
                        *(u32x4*)(rp + bj * HALF) = pack8(v0, v1); } }
        } else {
            const int c = wc * 32 + fq * 8;
#pragma unroll
            for (int ai = 0; ai < 2; ++ai)
#pragma unroll
                for (int m = 0; m < 4; ++m) { const int row = row0 + ai * HALF + m * 16; const float rsv = row_rstd(ssq, row, fq); float* gp = (float*)(ra + RA_GATES) + (size_t)row * 48 + c;
                    f32x4 v0 = acc[ai][0][m][0] * rsv, v1 = acc[ai][0][m][1] * rsv;
#pragma unroll
                    for (int e = 0; e < 4; ++e) { v0[e] = sigmoid_f(v0[e]); v1[e] = sigmoid_f(v1[e]); }
                    if (c < 48) { *(f32x4*)gp = v0; *(f32x4*)(gp + 4) = v1; } }
        }
    }
};

struct EpiRes {
    static constexpr bool PERM = true;
    bf16* xb; float* ssq;
    __device__ __forceinline__ void operator()(const Acc& acc, const Unit& u, int wr, int wc, int fr, int fq) const {
        const int row0 = u.pm * BM + wr * 64 + fr;
#pragma unroll
        for (int ai = 0; ai < 2; ++ai)
#pragma unroll
            for (int m = 0; m < 4; ++m) { const int row = row0 + ai * HALF + m * 16; const size_t off = (size_t)row * DM + u.pn * 256 + wc * 32 + fq * 8; float ss = 0.f;
#pragma unroll
                for (int bj = 0; bj < 2; ++bj) { bf16* xp = xb + off + bj * HALF; const u32x4 o = *(const u32x4*)xp;
                    const f32x4 x0 = {__builtin_bit_cast(float, o.x << 16), __builtin_bit_cast(float, o.x & 0xffff0000u), __builtin_bit_cast(float, o.y << 16), __builtin_bit_cast(float, o.y & 0xffff0000u)};
                    const f32x4 x1 = {__builtin_bit_cast(float, o.z << 16), __builtin_bit_cast(float, o.z & 0xffff0000u), __builtin_bit_cast(float, o.w << 16), __builtin_bit_cast(float, o.w & 0xffff0000u)};
                    const f32x4 v0 = x0 + acc[ai][bj][m][0], v1 = x1 + acc[ai][bj][m][1];
                    *(u32x4*)xp = pack8(v0, v1);
                    ss += (v0[0] * v0[0] + v0[1] * v0[1]) + (v0[2] * v0[2] + v0[3] * v0[3]) + (v1[0] * v1[0] + v1[1] * v1[1]) + (v1[2] * v1[2] + v1[3] * v1[3]); }
                ss += __shfl_xor(ss, 16); ss += __shfl_xor(ss, 32);
                if (fq == 0) ssq[(size_t)(u.pn * 4 + wc) * MTOK + row] = ss; }
    }
};

struct EpiXQ {
    static constexpr bool PERM = true;
    const float* ssq; bf16* o;
    __device__ __forceinline__ void operator()(const Acc& acc, const Unit& u, int wr, int wc, int fr, int fq) const {
        const int row0 = u.pm * BM + wr * 64 + fr;
        float rs[2][4]; load_rstd(ssq, row0, fq, rs);
#pragma unroll
        for (int ai = 0; ai < 2; ++ai)
#pragma unroll
            for (int m = 0; m < 4; ++m) { const int row = row0 + ai * HALF + m * 16; bf16* rp = o + (size_t)row * 256 + wc * 32 + fq * 8;
#pragma unroll
                for (int bj = 0; bj < 2; ++bj) *(u32x4*)(rp + bj * HALF) = pack8(acc[ai][bj][m][0] * rs[ai][m], acc[ai][bj][m][1] * rs[ai][m]); }
    }
};

struct EpiXKV {
    static constexpr bool PERM = true;
    bf16* xk; bf16* xv;
    __device__ __forceinline__ void operator()(const Acc& acc, const Unit& u, int wr, int wc, int fr, int fq) const {
        const int row0 = u.pm * BM + wr * 64 + fr;
        bf16* dst = xk + (size_t)(u.pn & 1) * (size_t)(xv - xk) + (size_t)(u.pn >> 1) * (NB * MEML * 256);
#pragma unroll
        for (int ai = 0; ai < 2; ++ai)
#pragma unroll
            for (int m = 0; m < 4; ++m) { const int row = row0 + ai * HALF + m * 16; bf16* rp = dst + (size_t)row * 256 + wc * 32 + fq * 8;
#pragma unroll
                for (int bj = 0; bj < 2; ++bj) *(u32x4*)(rp + bj * HALF) = pack8(acc[ai][bj][m][0], acc[ai][bj][m][1]); }
    }
};

template <bool MOE> struct EpiGateUp {
    static constexpr bool PERM = true;
    const float* ssq; bf16* h; int ldh;
    __device__ __forceinline__ void operator()(const Acc& acc, const Unit& u, int wr, int wc, int fr, int fq) const {
        const int row0 = u.pm * BM + wr * 64 + fr;
#pragma unroll
        for (int ai = 0; ai < 2; ++ai)
#pragma unroll
            for (int m = 0; m < 4; ++m) { const int row = row0 + ai * HALF + m * 16; float r = 1.f; if constexpr (!MOE) r = row_rstd(ssq, row, fq);
                f32x4 o0, o1;
#pragma unroll
                for (int e = 0; e < 4; ++e) { o0[e] = silu_f(acc[ai][0][m][0][e] * r) * (acc[ai][1][m][0][e] * r); o1[e] = silu_f(acc[ai][0][m][1][e] * r) * (acc[ai][1][m][1][e] * r); }
                if constexpr (MOE) { u32x2 w; w.x = pk4_fp8(o0[0] * FP8_SH, o0[1] * FP8_SH, o0[2] * FP8_SH, o0[3] * FP8_SH); w.y = pk4_fp8(o1[0] * FP8_SH, o1[1] * FP8_SH, o1[2] * FP8_SH, o1[3] * FP8_SH);
                    *(u32x2*)((unsigned char*)h + (size_t)row * ldh + u.pn * 128 + wc * 32 + fq * 8) = w; }
                else *(u32x4*)(h + (size_t)row * ldh + u.pn * 128 + wc * 32 + fq * 8) = pack8(o0, o1); }
    }
};

struct EpiMoeDown {
    static constexpr bool PERM = true;
    const int* rowtok; const float* roww; bf16* ymoe;
    __device__ __forceinline__ void operator()(const Acc& acc, const Unit& u, int wr, int wc, int fr, int fq) const {
        const int row0 = u.pm * BM + wr * 64 + fr;
#pragma unroll
        for (int ai = 0; ai < 2; ++ai)
#pragma unroll
            for (int m = 0; m < 4; ++m) { const int row = row0 + ai * HALF + m * 16; const int tk = rowtok[row];
                if (tk >= 0) { const float w = roww[row]; bf16* yp = ymoe + ((size_t)(tk & 1) * MTOK + (tk >> 1)) * DM + u.pn * 256 + wc * 32 + fq * 8;
#pragma unroll
                    for (int bj = 0; bj < 2; ++bj) *(u32x4*)(yp + bj * HALF) = pack8(acc[ai][bj][m][0] * w, acc[ai][bj][m][1] * w); } }
    }
};

struct EpiCmpPart {
    static constexpr bool PERM = true;
    float* cpart;
    __device__ __forceinline__ void operator()(const Acc& acc, const Unit& u, int wr, int wc, int fr, int fq) const {
        const int row0 = u.pm * BM + wr * 64 + fr;
        float* base = cpart + (size_t)u.aux * 4096 * 256;
#pragma unroll
        for (int ai = 0; ai < 2; ++ai)
#pragma unroll
            for (int m = 0; m < 4; ++m) { const int row = row0 + ai * HALF + m * 16; float* rp = base + (size_t)row * 256 + wc * 32 + fq * 8;
#pragma unroll
                for (int bj = 0; bj < 2; ++bj) { *(f32x4*)(rp + bj * HALF) = acc[ai][bj][m][0]; *(f32x4*)(rp + bj * HALF + 4) = acc[ai][bj][m][1]; } }
    }
};

struct CmpOrder {
    int G, c;
    __device__ bool next(int i, Unit& u) const {
        const long L = (long)i * G + c; if (L >= 2 * CMP_SPLIT * 16) return false;
        const int t = (int)L / (CMP_SPLIT * 16), s = ((int)L / 16) % CMP_SPLIT, pm = (int)L % 16;
        u.pm = pm; u.pn = 0; u.aux = t * CMP_SPLIT + s;
        u.oa = ((size_t)(t * 4096 + pm * 256) * 2048 + s * 256) * 2; u.ob = ((size_t)(t * 256) * 2048 + s * 256) * 2; return true;
    }
};
struct MoeOrder {
    const int* tile_e; int nN, G, c, lda, ldb, nper;
    __device__ bool next(int i, Unit& u) const {
        const int nt = __builtin_amdgcn_readfirstlane(tile_e[MOE_MAX_TILES]);
        const long L = (long)i * G + c; if (L >= (long)nt * nN) return false;
        const int pm = (int)(L / nN), pn = (int)(L % nN), e = __builtin_amdgcn_readfirstlane(tile_e[pm]);
        u.pm = pm; u.pn = pn; u.aux = e; u.oa = (size_t)pm * BM * lda * 2; u.ob = ((size_t)e * nper + (size_t)pn * BM) * ldb * 2; return true;
    }
};
}

namespace att {
constexpr int KP = 128, TILE_B = 64 * KP;
constexpr int NSLOT = 4;
constexpr int KV_BYTES = 2 * NSLOT * TILE_B;
#define MFMA32(a, b, c) __builtin_amdgcn_mfma_f32_32x32x16_bf16((a), (b), (c), 0, 0, 0)
typedef short v4i16_t __attribute__((ext_vector_type(4)));
__device__ __forceinline__ void glds16(const void* gsrc, unsigned lds_dst) { unsigned keep;
    asm volatile("s_mov_b32 %0, m0\n\ts_mov_b32 m0, %2\n\ts_nop 0\n\tglobal_load_lds_dwordx4 %1, off\n\ts_mov_b32 m0, %0" : "=&s"(keep) : "v"(gsrc), "s"(lds_dst) : "memory"); }
__device__ __forceinline__ s16x4 vtr(const LAS unsigned char* p) { return __builtin_bit_cast(s16x4, __builtin_amdgcn_ds_read_tr16_b64_v4i16((LAS v4i16_t*)p)); }
__device__ __forceinline__ bf16x8 packp(const f32x16& x, int s) {
    u32x4 p; p.x = pk2(x[8 * s], x[8 * s + 1]); p.y = pk2(x[8 * s + 2], x[8 * s + 3]); p.z = pk2(x[8 * s + 4], x[8 * s + 5]); p.w = pk2(x[8 * s + 6], x[8 * s + 7]);
    return __builtin_bit_cast(bf16x8, p);
}
__device__ __forceinline__ short ov_bits(int n, int j) {
    const int jn = n >> 2, q = n & 3;
    if (q < 3) return (jn == j) ? (short)0x3F80 : (short)0;
    return (jn == j || jn + 1 == j) ? (short)0x3F00 : (short)0;
}

struct State { f32x16 o0, o1, o2; float m, l; };
__device__ __forceinline__ void reset(State& s) {
#pragma unroll
    for (int i = 0; i < 16; ++i) { s.o0[i] = 0.f; s.o1[i] = 0.f; s.o2[i] = 0.f; }
    s.m = -1e30f; s.l = 0.f;
}

__device__ __forceinline__ int flash_prefetch(LAS unsigned char* kv, const bf16* Kg, const bf16* Vg, int ld, int jlo, int jhi, const int tid) {
    const int wv = __builtin_amdgcn_readfirstlane(tid >> 6);
    const int skey = tid >> 3, sch = (tid & 7) ^ (skey & 7);
    const size_t goff = ((size_t)skey * ld + sch * 8) * 2;
    const unsigned kvb = (unsigned)(__UINTPTR_TYPE__)kv + (unsigned)wv * 1024u;
    int n = 0;
#pragma unroll
    for (int k = 0; k < NSLOT - 1; ++k) if (jlo + k < jhi) { const size_t tb_ = (size_t)(64 * (jlo + k)) * ld * 2 + goff;
        glds16((const char*)Kg + tb_, (unsigned)__builtin_amdgcn_readfirstlane(kvb + (unsigned)k * TILE_B));
        glds16((const char*)Vg + tb_, (unsigned)__builtin_amdgcn_readfirstlane(kvb + (unsigned)(NSLOT + k) * TILE_B)); ++n; }
    return n;
}

template <class MK, bool OV>
__device__ __forceinline__ void flash_run(LAS unsigned char* kv, const bf16* Kg, const bf16* Vg, int ld, int jlo, int jhi, const bf16x8 (&qf)[4], State& st, const MK& mk, const int tid, const int pre = 0) {
    const int lane = tid & 63, r = lane & 31, h = lane >> 5, blk16 = (lane >> 4) & 1, q4 = (lane & 15) >> 2, p4 = lane & 3;
    const int wv = __builtin_amdgcn_readfirstlane(tid >> 6);
    const int skey = tid >> 3, sch = (tid & 7) ^ (skey & 7);
    const size_t goff = ((size_t)skey * ld + sch * 8) * 2;
    const unsigned kvb = (unsigned)(__UINTPTR_TYPE__)kv + (unsigned)wv * 1024u;
#define FL_DMA(jt, slot) do { const size_t tb_ = (size_t)(64 * (jt)) * ld * 2 + goff; \
        glds16((const char*)Kg + tb_, (unsigned)__builtin_amdgcn_readfirstlane(kvb + (unsigned)(slot) * TILE_B)); \
        glds16((const char*)Vg + tb_, (unsigned)__builtin_amdgcn_readfirstlane(kvb + (unsigned)(NSLOT + (slot)) * TILE_B)); } while (0)
#define FL_NEXT(x) do { ++(x); while ((x) < jhi && !mk.active(x)) ++(x); } while (0)
    int j = jlo; while (j < jhi && !mk.active(j)) ++j;
    if (j >= jhi) return;
    int jp = j, np = 0, nc = 0;
    if (pre > 0) { np = pre; jp = j + pre; }
    else {
#pragma unroll
        for (int k = 0; k < NSLOT - 1; ++k) if (jp < jhi) { FL_DMA(jp, np & (NSLOT - 1)); ++np; FL_NEXT(jp); }
    }
    bf16x8 q0 = qf[0], q1 = qf[1], q2 = qf[2], q3 = qf[3]; asm volatile("" : "+v"(q0), "+v"(q1), "+v"(q2), "+v"(q3));
    const int sw = r & 7;
    unsigned kro[4];
#pragma unroll
    for (int ks = 0; ks < 4; ++ks) kro[ks] = (unsigned)(r * KP + (((2 * ks + h) ^ sw) << 4));
    const int vsw = 4 * h + q4;
    const unsigned vro0 = (unsigned)(vsw * KP + (((2 * blk16 + (p4 >> 1)) ^ vsw) << 4) + 8 * (p4 & 1));
    const unsigned vro1 = (unsigned)(vsw * KP + (((4 + 2 * blk16 + (p4 >> 1)) ^ vsw) << 4) + 8 * (p4 & 1));
#pragma nounroll
    for (;;) {
        { const int younger = np - nc - 1;
          if (younger >= 2) asm volatile("s_waitcnt vmcnt(4)" ::: "memory"); else if (younger == 1) asm volatile("s_waitcnt vmcnt(2)" ::: "memory"); else asm volatile("s_waitcnt vmcnt(0)" ::: "memory"); }
        __syncthreads();
        if (jp < jhi) { FL_DMA(jp, np & (NSLOT - 1)); ++np; FL_NEXT(jp); }
        const int cur = nc & (NSLOT - 1);
        const int kind = mk.kind(j);
        if (kind != 0) {
            const LAS unsigned char* Kb = kv + cur * TILE_B; const LAS unsigned char* Vb = kv + (NSLOT + cur) * TILE_B;
            f32x16 s0, s1;
#pragma unroll
            for (int i = 0; i < 16; ++i) { s0[i] = 0.f; s1[i] = 0.f; }
#pragma unroll
            for (int ks = 0; ks < 4; ++ks) {
                const bf16x8 k0 = *(const LAS bf16x8*)(Kb + kro[ks]), k1 = *(const LAS bf16x8*)(Kb + kro[ks] + 32 * KP);
                const bf16x8 qk = ks == 0 ? q0 : (ks == 1 ? q1 : (ks == 2 ? q2 : q3));
                s0 = MFMA32(k0, qk, s0); s1 = MFMA32(k1, qk, s1);
            }
            if (kind == 2) {
#pragma unroll
                for (int i = 0; i < 16; ++i) { const int kk = (i & 3) + 8 * (i >> 2) + 4 * h; if (!mk.ok(j, kk)) s0[i] = -INFINITY; if (!mk.ok(j, kk + 32)) s1[i] = -INFINITY; }
            }
            float mx = fmaxf(s0[0], s1[0]);
#pragma unroll
            for (int i = 1; i < 16; ++i) mx = fmaxf(mx, fmaxf(s0[i], s1[i]));
            const bool lok = (kind != 3) || mk.lane_ok(j);
            if (!lok) mx = -INFINITY;
            mx = fmaxf(mx, __shfl_xor(mx, 32));
            const float mn = fmaxf(st.m, mx * C2);
            if (!__all(mn - st.m <= 8.f)) {
                const float alpha = fast_exp2(st.m - mn); st.m = mn;
                st.l = st.l * alpha; st.o0 = st.o0 * alpha; st.o1 = st.o1 * alpha; if (OV) st.o2 = st.o2 * alpha;
            }
            const float nm = lok ? -st.m : -INFINITY;
            float ps = 0.f;
#pragma unroll
            for (int i = 0; i < 16; ++i) { s0[i] = fast_exp2(__builtin_fmaf(s0[i], C2, nm)); s1[i] = fast_exp2(__builtin_fmaf(s1[i], C2, nm)); ps += s0[i] + s1[i]; }
            ps += __shfl_xor(ps, 32);
            st.l += ps;
#pragma unroll
            for (int hf = 0; hf < 2; ++hf)
#pragma unroll
                for (int s = 0; s < 2; ++s) {
                    const bf16x8 pf = packp(hf ? s1 : s0, s);
                    const LAS unsigned char* vb = Vb + (32 * hf + 16 * s) * KP;
                    const s16x4 l0 = vtr(vb + vro0), h0 = vtr(vb + vro0 + 8 * KP), l1 = vtr(vb + vro1), h1 = vtr(vb + vro1 + 8 * KP);
                    st.o0 = MFMA32(__builtin_shufflevector(l0, h0, 0, 1, 2, 3, 4, 5, 6, 7), pf, st.o0);
                    st.o1 = MFMA32(__builtin_shufflevector(l1, h1, 0, 1, 2, 3, 4, 5, 6, 7), pf, st.o1);
                    if (OV) {
                        int r_ = r; asm volatile("" : "+v"(r_));
                        const int jnA = 16 * j + 8 * hf + 4 * s + h - r_, jnB = jnA + 2;
                        u32x4 a;
                        a.x = (jnA == 0) ? 0x3F803F80u : 0u; a.y = ((jnA == 0) ? 0x00003F80u : 0u) | ((jnA == 0 || jnA == -1) ? 0x3F000000u : 0u);
                        a.z = (jnB == 0) ? 0x3F803F80u : 0u; a.w = ((jnB == 0) ? 0x00003F80u : 0u) | ((jnB == 0 || jnB == -1) ? 0x3F000000u : 0u);
                        st.o2 = MFMA32(__builtin_bit_cast(bf16x8, a), pf, st.o2); }
                }
        }
        ++nc; FL_NEXT(j);
        if (j >= jhi) break;
    }
    __syncthreads();
#undef FL_NEXT
#undef FL_DMA
}

__device__ __forceinline__ void load_q(bf16x8 (&qf)[4], const bf16* qrow, int h) {
#pragma unroll
    for (int ks = 0; ks < 4; ++ks) qf[ks] = *(const bf16x8*)(qrow + ks * 16 + h * 8);
}
__device__ __forceinline__ void store_o(bf16* orow, const f32x16& o0, const f32x16& o1, float sc, int h) {
#pragma unroll
    for (int g = 0; g < 4; ++g) {
        u32x2 a, b; a.x = pk2(o0[4 * g] * sc, o0[4 * g + 1] * sc); a.y = pk2(o0[4 * g + 2] * sc, o0[4 * g + 3] * sc);
        b.x = pk2(o1[4 * g] * sc, o1[4 * g + 1] * sc); b.y = pk2(o1[4 * g + 2] * sc, o1[4 * g + 3] * sc);
        *(u32x2*)(orow + 8 * g + 4 * h) = a; *(u32x2*)(orow + 32 + 8 * g + 4 * h) = b;
    }
}

struct NoMask { __device__ __forceinline__ bool active(int) const { return true; } __device__ __forceinline__ int kind(int) const { return 1; } __device__ __forceinline__ bool ok(int, int) const { return true; } __device__ __forceinline__ bool lane_ok(int) const { return true; } };
struct MobaMask {
    int qb, wq0, tq; unsigned sel, uni;
    __device__ __forceinline__ bool active(int jt) const { const int jb = jt >> 2; return jb >= qb || ((uni >> jb) & 1u); }
    __device__ __forceinline__ int kind(int jt) const { const int jb = jt >> 2; if (jb < qb) { const bool s_ = (sel >> jb) & 1u; return __all(s_) ? 1 : (__any(s_) ? 3 : 0); } const int k0 = (jt & 3) * 64; if (k0 > wq0 + 31) return 0; if (k0 + 63 <= wq0) return 1; return 2; }
    __device__ __forceinline__ bool ok(int jt, int kk) const { return (jt & 3) * 64 + kk <= tq; }
    __device__ __forceinline__ bool lane_ok(int jt) const { return (sel >> (jt >> 2)) & 1u; }
};
struct CmpMask {
    int nmax, nlo, nhi;
    __device__ __forceinline__ bool active(int) const { return true; }
    __device__ __forceinline__ int kind(int j) const { if (64 * j > nhi) return 0; if (64 * j + 63 <= nlo) return 1; return 2; }
    __device__ __forceinline__ bool ok(int j, int kk) const { return 64 * j + kk <= nmax; }
    __device__ __forceinline__ bool lane_ok(int) const { return true; }
};
struct SelMask {
    int tb, tq, wq0; unsigned sel, uni;
    __device__ __forceinline__ bool active(int j) const { return (uni >> j) & 1u; }
    __device__ __forceinline__ int kind(int j) const { if (j == tb) return 2; const bool s_ = (sel >> j) & 1u; return __all(s_) ? 1 : (__any(s_) ? 3 : 0); }
    __device__ __forceinline__ bool ok(int j, int kk) const { return kk <= tq; }
    __device__ __forceinline__ bool lane_ok(int j) const { return (sel >> j) & 1u; }
};
struct WinMask {
    int tb, tq;
    __device__ __forceinline__ bool active(int) const { return true; }
    __device__ __forceinline__ int kind(int j) const { return (j == tb || j == tb - 8) ? 2 : 1; }
    __device__ __forceinline__ bool ok(int j, int kk) const { const int d = 64 * (tb - j) + tq - kk; return d >= 0 && d < 512; }
    __device__ __forceinline__ bool lane_ok(int) const { return true; }
};
}

#define XB_TMO      128
#define XB_XCNT(j)  (256  + 64 * (j))
#define XB_XSUB(j)  (1280 + 64 * (j))
#define XB_XGEN(j)  (2304 + 64 * (j))
#define XB_TOP      3328
#define XB_TOPGEN   3392
#define XCD_BAR_WORDS 3456
#define XB_SPIN_CAP (1u << 18)
__device__ __forceinline__ unsigned xb_ld(unsigned* p)              { return __hip_atomic_load(p, __ATOMIC_RELAXED, __HIP_MEMORY_SCOPE_AGENT); }
__device__ __forceinline__ unsigned xb_add(unsigned* p, unsigned v) { return __hip_atomic_fetch_add(p, v, __ATOMIC_RELAXED, __HIP_MEMORY_SCOPE_AGENT); }
__device__ __forceinline__ unsigned xb_xcc_id() { return (unsigned)__builtin_amdgcn_s_getreg((3 << 11) | 20) & 0xFu; }
#define XB_SPIN(cond, bar) do { unsigned _sp = 0; while (cond) { __builtin_amdgcn_s_sleep(1); \
    if ((++_sp & 255u) == 0u) { if (xb_ld(&(bar)[XB_TMO])) break; if (_sp > XB_SPIN_CAP) { atomicAdd(&(bar)[XB_TMO], 1u); break; } } } } while (0)
struct XcdBarrier { unsigned* bar; unsigned x; volatile LAS unsigned* st; };
__device__ __forceinline__ XcdBarrier xcd_barrier_post(unsigned* bar, volatile LAS unsigned* st) {
    XcdBarrier b; b.bar = bar; b.x = xb_xcc_id(); b.st = st;
    if (threadIdx.x == 0) (void)xb_add(&bar[XB_XCNT(b.x)], 1u);
    return b;
}
__device__ __forceinline__ void xcd_barrier_complete(unsigned* bar, unsigned x, unsigned& nloc, unsigned& nx) {
    const unsigned G = gridDim.x * gridDim.y * gridDim.z;
    unsigned sum, cnt, mine, sp = 0u;
    for (;;) {
        sum = 0u; cnt = 0u; mine = 0u;
#pragma unroll
        for (unsigned j = 0; j < 16; ++j) { const unsigned c = xb_ld(&bar[XB_XCNT(j)]); sum += c; cnt += (c > 0u) ? 1u : 0u; mine = (j == x) ? c : mine; }
        if (sum == G) break;
        __builtin_amdgcn_s_sleep(1);
        if ((++sp & 255u) == 0u) { if (xb_ld(&bar[XB_TMO])) break; if (sp > XB_SPIN_CAP) { atomicAdd(&bar[XB_TMO], 1u); break; } }
    }
    nloc = mine > 0u ? mine : 1u; nx = cnt > 0u ? cnt : 1u;
}
__device__ __forceinline__ void xcd_barrier(const XcdBarrier& b) {
    asm volatile("s_waitcnt vmcnt(0)" ::: "memory");
    __syncthreads();
    if (threadIdx.x == 0) {
        unsigned* bar = b.bar;
        __builtin_amdgcn_s_waitcnt(0);
        unsigned nloc = b.st[0], nx = b.st[1];
        if (nloc == 0u) { xcd_barrier_complete(bar, b.x, nloc, nx); b.st[0] = nloc; b.st[1] = nx; }
        const unsigned old = xb_add(&bar[XB_XSUB(b.x)], 1u);
        const unsigned gen = old / nloc;
        if (old + 1u == (gen + 1u) * nloc) {
            __builtin_amdgcn_fence(__ATOMIC_RELEASE, "agent");
            asm volatile("s_waitcnt vmcnt(0)" ::: "memory");
            const unsigned og = xb_add(&bar[XB_TOP], 1u);
            const unsigned tg = og / nx;
            if (og + 1u == (tg + 1u) * nx) xb_add(&bar[XB_TOPGEN], 1u);
            else XB_SPIN(xb_ld(&bar[XB_TOPGEN]) == tg, bar);
            __builtin_amdgcn_fence(__ATOMIC_ACQUIRE, "agent");
            xb_add(&bar[XB_XGEN(b.x)], 1u);
            asm volatile("s_waitcnt vmcnt(0)" ::: "memory");
        } else {
            XB_SPIN(xb_ld(&bar[XB_XGEN(b.x)]) == gen, bar);
            __builtin_amdgcn_fence(__ATOMIC_ACQUIRE, "agent");
            asm volatile("s_waitcnt vmcnt(0)" ::: "memory");
        }
    }
    __syncthreads();
}

struct ConvJob { const float* src; bf16* dst; const float* g; int K, N, nblk, mode, start; float scale; };

__device__ __forceinline__ void conv_load(const float* src, int N, int nblk, int item, int lane, float (&v)[64]) {
    const int kb = item / nblk, nb = item - kb * nblk, k0 = 64 * kb, n = 64 * nb + lane;
    const float* p = src + (size_t)k0 * N + n;
    if (n < N) {
#pragma unroll
        for (int i = 0; i < 64; ++i) v[i] = p[(size_t)i * N];
    } else {
#pragma unroll
        for (int i = 0; i < 64; ++i) v[i] = 0.f;
    }
}
__device__ __forceinline__ void conv_store(bf16* dst, const float* g, int K, int N, int nblk, int mode, float scale, LAS float* scr, int item, int lane, const float (&v)[64]) {
    const int kb = item / nblk, nb = item - kb * nblk, k0 = 64 * kb, n0 = 64 * nb;
    if (g) {
#pragma unroll
        for (int i = 0; i < 64; ++i) scr[i * 65 + lane] = v[i] * g[k0 + i];
    } else {
#pragma unroll
        for (int i = 0; i < 64; ++i) scr[i * 65 + lane] = v[i];
    }
    LDS_WAIT(); asm volatile("" ::: "memory");
    const int rm = mode & 3;
    if (mode & 4) {
        const int c = lane & 3;
#pragma unroll
        for (int j = 0; j < 4; ++j) { const int nn = (lane >> 2) + 16 * j, nc = n0 + nn; const LAS float* s = scr + (16 * c) * 65 + nn;
            u32x4 o; o.x = pk4_fp8(s[0 * 65] * scale, s[1 * 65] * scale, s[2 * 65] * scale, s[3 * 65] * scale); o.y = pk4_fp8(s[4 * 65] * scale, s[5 * 65] * scale, s[6 * 65] * scale, s[7 * 65] * scale);
            o.z = pk4_fp8(s[8 * 65] * scale, s[9 * 65] * scale, s[10 * 65] * scale, s[11 * 65] * scale); o.w = pk4_fp8(s[12 * 65] * scale, s[13 * 65] * scale, s[14 * 65] * scale, s[15 * 65] * scale);
            if (nc < N) { const int orow = rm == 0 ? nc : (256 * (nc >> 7) + (nc & 127) + (rm == 2 ? 128 : 0)); *(u32x4*)((unsigned char*)dst + (size_t)orow * K + k0 + 16 * c) = o; } }
    } else {
    const int c = lane & 7;
#pragma unroll
    for (int j = 0; j < 8; ++j) { const int nn = (lane >> 3) + 8 * j, nc = n0 + nn; const LAS float* s = scr + (8 * c) * 65 + nn;
        u32x4 o; o.x = pk2(s[0 * 65], s[1 * 65]); o.y = pk2(s[2 * 65], s[3 * 65]); o.z = pk2(s[4 * 65], s[5 * 65]); o.w = pk2(s[6 * 65], s[7 * 65]);
        if (nc < N) { const int orow = rm == 0 ? nc : (256 * (nc >> 7) + (nc & 127) + (rm == 2 ? 128 : 0)); *(u32x4*)(dst + (size_t)orow * K + k0 + 8 * c) = o; } }
    }
    LDS_WAIT(); asm volatile("" ::: "memory");
}
struct ConvCur { const float* src; bf16* dst; const float* g; int K, N, nblk, mode, item; float scale; };
__device__ __forceinline__ void conv_lookup(const LAS ConvJob* jobs, int njobs, int it, ConvCur& c) {
    int ji = 0; while (ji + 1 < njobs && jobs[ji + 1].start <= it) ++ji;
    c.src = jobs[ji].src; c.dst = jobs[ji].dst; c.g = jobs[ji].g; c.K = jobs[ji].K; c.N = jobs[ji].N; c.nblk = jobs[ji].nblk; c.mode = jobs[ji].mode; c.item = it - jobs[ji].start; c.scale = jobs[ji].scale;
}
__device__ __forceinline__ void run_conv_jobs(LAS unsigned char* lds, int njobs, int item_lo, int item_hi, int w0, int nw, int wave, int lane) {
    const LAS ConvJob* jobs = (const LAS ConvJob*)(lds + CONV_JOBS_OFF);
    LAS float* scr = (LAS float*)(lds + wave * (64 * 65 * 4));
    int it = item_lo + w0; if (it >= item_hi) return;
    ConvCur cur, nxt; float v[64], w[64];
    conv_lookup(jobs, njobs, it, cur); conv_load(cur.src, cur.N, cur.nblk, cur.item, lane, v);
#pragma nounroll
    for (;;) {
        const int itn = it + nw; const bool has = itn < item_hi;
        if (has) { conv_lookup(jobs, njobs, itn, nxt); conv_load(nxt.src, nxt.N, nxt.nblk, nxt.item, lane, w); }
        conv_store(cur.dst, cur.g, cur.K, cur.N, cur.nblk, cur.mode, cur.scale, scr, cur.item, lane, v);
        if (!has) break;
#pragma unroll
        for (int i = 0; i < 64; ++i) v[i] = w[i];
        cur = nxt; it = itn;
    }
}
#define ADD_JOB(SRC, DST, GP, KK, NN, MODE) do { LAS ConvJob* _j = jobsw + nj; int kk_ = (KK), nn_ = (NN), md_ = (MODE); asm volatile("" : "+s"(kk_), "+s"(nn_), "+s"(md_));     \
    _j->src = (SRC); _j->dst = (DST); _j->g = (GP); _j->K = kk_; _j->N = nn_; _j->nblk = (nn_ + 63) / 64; \
    _j->mode = md_; _j->start = tot; _j->scale = (md_ & 4) ? ((md_ & 3) ? FP8_SW_GU : FP8_SW_D) : 1.f; tot += (kk_ / 64) * ((nn_ + 63) / 64); ++nj; } while (0)

constexpr int MOE_ITEMS = 24 * 896;
constexpr size_t MOEGU_SET = (size_t)NEXP * 2 * DFFE * DM, MOED_SET = (size_t)NEXP * DM * DFFE;
#define BUILD_MOE_JOBS(I) do { _Pragma("nounroll") for (int e = 0; e < NEXP; ++e) { \
        ADD_JOB((const float*)INP(22) + (size_t)((I) * NEXP + e) * DM * DFFE, (bf16*)(ws + WS_W_MOEGU + (I) * MOEGU_SET + (size_t)e * 2 * DFFE * DM), norm_g + ((2 * (I) + 1) * 3 + 2) * DM, DM, DFFE, 5); \
        ADD_JOB((const float*)INP(23) + (size_t)((I) * NEXP + e) * DM * DFFE, (bf16*)(ws + WS_W_MOEGU + (I) * MOEGU_SET + (size_t)e * 2 * DFFE * DM), norm_g + ((2 * (I) + 1) * 3 + 2) * DM, DM, DFFE, 6); \
        ADD_JOB((const float*)INP(24) + (size_t)((I) * NEXP + e) * DFFE * DM, (bf16*)(ws + WS_W_MOED + (I) * MOED_SET + (size_t)e * DM * DFFE), (const float*)nullptr, DFFE, DM, 4); } } while (0)
#define MOE_CONV_SLICE(I, LO, HI, RANK, NRANK) do { LAS ConvJob* jobsw = (LAS ConvJob*)(lds + CONV_JOBS_OFF); \
        __syncthreads(); if (tid == 0) { int nj = 0, tot = 0; BUILD_MOE_JOBS(I); } __syncthreads(); \
        run_conv_jobs(lds, 24, (LO), (HI), (RANK) * NWAVES + wave, (NRANK) * NWAVES, wave, lane); __syncthreads(); } while (0)
constexpr int MS_E1 = 2048, MS_XQA = 3072, MS_F1 = 2048, MS_XQB = 4608;
constexpr int MS0_A0 = MS_E1, MS0_A1 = MS0_A0 + MS_XQA, MS0_A2 = MS0_A1 + MS_F1, MS0_A3 = MS0_A2 + MS_XQB;
constexpr int MS1_B0 = MS_E1, MS1_B1 = MS1_B0 + MS_XQB, MS1_B2 = MS1_B1 + MS_F1, MS1_B3 = MS1_B2 + MS_XQB;

__device__ __forceinline__ float load_row4(const float* row, int lane, f32x4 (&v)[4]) {
    float s = 0.f;
#pragma unroll
    for (int j = 0; j < 4; ++j) { v[j] = *(const f32x4*)(row + 4 * lane + 256 * j); s += (v[j][0] * v[j][0] + v[j][1] * v[j][1]) + (v[j][2] * v[j][2] + v[j][3] * v[j][3]); }
    return wave_sum(s);
}
__device__ __forceinline__ float load_row4_bf16(const bf16* row, int lane, f32x4 (&v)[4]) {
    float s = 0.f;
#pragma unroll
    for (int j = 0; j < 4; ++j) { const u32x2 o = *(const u32x2*)(row + 4 * lane + 256 * j);
        v[j] = (f32x4){__builtin_bit_cast(float, o.x << 16), __builtin_bit_cast(float, o.x & 0xffff0000u), __builtin_bit_cast(float, o.y << 16), __builtin_bit_cast(float, o.y & 0xffff0000u)};
        s += (v[j][0] * v[j][0] + v[j][1] * v[j][1]) + (v[j][2] * v[j][2] + v[j][3] * v[j][3]); }
    return wave_sum(s);
}
__device__ __forceinline__ void store_ssq_full(float* ssq, int row, float s, int lane) { if (lane < 16) ssq[(size_t)lane * MTOK + row] = (lane == 0) ? s : 0.f; }
__device__ __forceinline__ void store_row_bf16(bf16* orow, int lane, const f32x4 (&v)[4]) {
#pragma unroll
    for (int j = 0; j < 4; ++j) { u32x2 o; o.x = pk2(v[j][0], v[j][1]); o.y = pk2(v[j][2], v[j][3]); *(u32x2*)(orow + 4 * lane + 256 * j) = o; }
}

struct Args { const void* in[28]; float* out; unsigned char* ws; double invf[8]; int ph_lo, ph_hi; };
constexpr int NPH = 2 + 4 * 13;

#define CAS __attribute__((address_space(4)))
__device__ __forceinline__ const CAS char* karg() { const CAS char* kp = (const CAS char*)__builtin_amdgcn_kernarg_segment_ptr(); asm volatile("" : "+s"(kp)); return kp; }
#define INP(k) ((const void*)(*(const GAS void* const CAS*)(karg() + 8 * (k))))
#define ARG_OUT ((float*)(*(GAS float* const CAS*)(karg() + 224)))
#define ARG_WS (*(GAS unsigned char* const CAS*)(karg() + 232))
#define ARG_INVF(j) (*(const CAS double*)(karg() + 240 + 8 * (j)))
static_assert(offsetof(Args, out) == 224 && offsetof(Args, ws) == 232 && offsetof(Args, invf) == 240 && offsetof(Args, ph_lo) == 304 && sizeof(Args) == 312, "kernarg layout");
#define PHASE_IDS int tid = threadIdx.x; asm volatile("" : "+v"(tid)); const int lane = tid & 63, wave = __builtin_amdgcn_readfirstlane(tid >> 6); \
    int bx = blockIdx.x, G = gridDim.x; asm volatile("" : "+s"(bx), "+s"(G)); const int gw = bx * NWAVES + wave, NGW = G * NWAVES; (void)lane; (void)gw; (void)NGW;
#define ws (ARG_WS)
#define ctl ((unsigned*)(ws + WS_CTL))
#define PH_LO (*(const CAS int*)(karg() + 304))
#define PH_HI (*(const CAS int*)(karg() + 308))
#define IN(p) (PH_LO <= (p) && (p) < PH_HI)
#define T_START unsigned long long t0_ = 0; if (DELAYMASK) t0_ = __builtin_amdgcn_s_memrealtime();
#define T_DELAY(c) do { if (DELAYMASK && (c)) { const unsigned long long t1_ = __builtin_amdgcn_s_memrealtime(); while (__builtin_amdgcn_s_memrealtime() - t1_ < t1_ - t0_) __builtin_amdgcn_s_sleep(8); } } while (0)
#define BAR_AFTER(p) do { if (MK_SINGLE && (p) + 1 < PH_HI) { XcdBarrier bar_; bar_.bar = ctl + CW_BAR; bar_.x = xb_xcc_id(); bar_.st = (volatile LAS unsigned*)(lds + MISC_OFF) + 8; xcd_barrier(bar_); } } while (0)
#define in_x ((const float*)INP(0))
#define in_mem ((const float*)INP(1))
#define in_pos ((const int*)INP(2))
#define norm_g ((const float*)INP(3))
#define mem_g ((const float*)INP(4))
#define final_g ((const float*)INP(5))
#define X (ARG_OUT)
#define XB ((bf16*)(ws + WS_XB))
#define SSQ ((float*)(ws + WS_SSQ))
#define CS ((float*)(ws + WS_MISC + MISC_CS))
#define KMEAN ((float*)(ws + WS_MISC + MISC_KMEAN))
#define KCMP ((bf16*)(ws + WS_MISC + MISC_KCMP))
#define VCMP ((bf16*)(ws + WS_MISC + MISC_VCMP))
#define MEMB ((bf16*)(ws + WS_MEMB))
#define XK ((bf16*)(ws + WS_XK))
#define XV ((bf16*)(ws + WS_XV))
#define YB ((bf16*)(ws + WS_YB))
#define XQ ((bf16*)(ws + WS_XQ))
#define XO ((bf16*)(ws + WS_XO))
#define TOKE ((int*)(ws + WS_ROUTE + RT_TOKE))
#define TOKPOS ((int*)(ws + WS_ROUTE + RT_TOKPOS))
#define TOKW ((float*)(ws + WS_ROUTE + RT_TOKW))
#define TOKRSTD ((float*)(ws + WS_ROUTE + RT_TOKRSTD))
#define ROWTOK ((int*)(ws + WS_ROUTE + RT_ROWTOK))
#define ROWW ((float*)(ws + WS_ROUTE + RT_ROWW))
#define ROWRSTD ((float*)(ws + WS_ROUTE + RT_ROWRSTD))
#define TILEE ((int*)(ws + WS_ROUTE + RT_TILEE))
#define LCNT ((int*)(ws + WS_ROUTE + RT_LCNT))
#define RA ((unsigned char*)(ws + WS_REGA))
#define UPOOL ((float*)(RA + RA_UPOOL))
#define QB ((bf16*)(RA + RA_QB))
#define KB ((bf16*)(RA + RA_KB))
#define VB ((bf16*)(RA + RA_VB))
#define QRAW ((bf16*)(RA + RA_QRAW))
#define QROT ((bf16*)(RA + RA_QROT))
#define ACMPK ((bf16*)(RA + RA_ACMPK))
#define KSB ((bf16*)(RA + RA_KS))
#define VSB ((bf16*)(RA + RA_VS))
#define KWB ((bf16*)(RA + RA_KW))
#define VWB ((bf16*)(RA + RA_VW))
#define GATES ((float*)(RA + RA_GATES))
#define CPART ((float*)(RA + RA_CPART))
#define YMOE ((bf16*)(RA + RA_YMOE))
#define XPERM ((bf16*)(RA + RA_XPERM))
#define HB ((bf16*)(ws + WS_REGB))
template <int l> __device__ __forceinline__ void run_layer(LAS unsigned char* lds) {
        constexpr int pb = 2 + 13 * l, i2 = l >> 1;
        constexpr bool even = (l & 1) == 0;
        if (IN(pb + 0)) {
            PHASE_IDS T_START
            if (ON(2) && even) {
                pg8::Gemm g{XB, (const bf16*)(ws + WS_W_INAB) + (size_t)i2 * AB_IN * DM, DM, DM, DM}; pg8::StaticOrder S; S.init(MTOK, AB_IN, G, bx, DM, DM);
                pg8::EpiInAB E{SSQ, CS, RA, KMEAN};
                pg8::gemm_phase<pg8::EpiInAB, pg8::StaticOrder>(lds, g, S, E, tid);
                if (G == 256 && bx >= 128) { if (l == 0) MOE_CONV_SLICE(0, 0, MS0_A0, bx - 128, 128); else MOE_CONV_SLICE(1, 0, MS1_B0, bx - 128, 128); }
            } else if (ON(3) && !even) {
                pg8::Gemm g{XB, (const bf16*)(ws + WS_W_INC) + (size_t)i2 * C_IN_PAD * DM, DM, DM, DM}; pg8::StaticOrder S; S.init(MTOK, C_IN_PAD, G, bx, DM, DM);
                pg8::EpiInC E{SSQ, CS, RA, (const float*)INP(14) + (size_t)i2 * 32 * 64, (const float*)INP(15) + (size_t)i2 * 32 * 64};
                pg8::gemm_phase<pg8::EpiInC, pg8::StaticOrder>(lds, g, S, E, tid);
            }
            BAR_AFTER(pb + 0); T_DELAY((even ? DLY(2) : DLY(3)));
        }
        if (IN(pb + 1) && !even) {
            PHASE_IDS T_START
            if (ON(5)) {
                pg8::Gemm g{ACMPK, (const bf16*)(ws + WS_W_CW1) + (size_t)i2 * 2 * 256 * 2048, 2048, 2048, 2048 / CMP_SPLIT}; pg8::CmpOrder S{G, bx};
                pg8::EpiCmpPart E{CPART};
                pg8::gemm_phase<pg8::EpiCmpPart, pg8::CmpOrder>(lds, g, S, E, tid);
            }
            BAR_AFTER(pb + 1); T_DELAY((even ? DLY(4) : DLY(5)));
        }
        if (ON(6) && IN(pb + 2) && !even) {
            PHASE_IDS T_START
            LAS float* wl = (LAS float*)lds;
            LAS float* hl = (LAS float*)(lds + 65536);
            for (int u = bx; u < 256; u += G) {
                const int t = u >> 7, R0 = (u & 127) * 32;
                const float* w2 = (const float*)INP(t ? 19 : 17) + (size_t)i2 * 256 * 64;
#pragma unroll
                for (int q = 0; q < 8; ++q) *(LAS f32x4*)(wl + (tid + 512 * q) * 4) = *(const f32x4*)(w2 + (tid + 512 * q) * 4);
#pragma unroll
                for (int q = 0; q < 4; ++q) { const int idx4 = tid + 512 * q, rr = idx4 >> 6, c4 = (idx4 & 63) * 4; f32x4 sacc = {0.f, 0.f, 0.f, 0.f};
#pragma unroll
                    for (int sp = 0; sp < CMP_SPLIT; ++sp) sacc = sacc + *(const f32x4*)(CPART + ((size_t)(t * CMP_SPLIT + sp) * 4096 + R0 + rr) * 256 + c4);
#pragma unroll
                    for (int e = 0; e < 4; ++e) sacc[e] = gelu_tanh_f(sacc[e]);
                    *(LAS f32x4*)(hl + rr * 256 + c4) = sacc; }
                __syncthreads();
                const int rr = tid >> 4, d4 = (tid & 15) * 4; f32x4 a = {0.f, 0.f, 0.f, 0.f};
#pragma unroll 8
                for (int k = 0; k < 256; ++k) a = a + *(const LAS f32x4*)(wl + k * 64 + d4) * hl[rr * 256 + k];
                const int row = R0 + rr; if ((row & 127) == 127) a = (f32x4){0.f, 0.f, 0.f, 0.f};
                u32x2 o; o.x = pk2(a[0], a[1]); o.y = pk2(a[2], a[3]);
                *(u32x2*)((t ? VCMP : KCMP) + (size_t)row * 64 + d4) = o;
                __syncthreads();
            }
            BAR_AFTER(pb + 2); T_DELAY(DLY(6));
        }
        if (IN(pb + 3)) {
            PHASE_IDS T_START
            if (ON(7) && even) {
                for (int u0 = bx, rnd = 0; u0 < 768 + 512; u0 += G, ++rnd) {
                    const int u = ((rnd & 1) && (u0 - bx) + G <= 768) ? (u0 - bx) + (G - 1 - bx) : u0;
                    if (u < 768) {
                        const int qb = 7 - u / 96, bh = u % 96, b = bh / 12, h = bh % 12;
                        LAS float* km = (LAS float*)(lds + att::KV_BYTES);
                        LAS unsigned* uni = (LAS unsigned*)(lds + att::KV_BYTES + 2048);
                        const int r = lane & 31, hh = lane >> 5, tq = 32 * wave + r;
                        const size_t tok = (size_t)b * SEQ + 256 * qb + tq;
                        bf16x8 qf[4]; att::load_q(qf, QB + tok * MOBA_DIMC + h * 64, hh);
                        if (tid < qb * 64) { const int j = tid >> 6, d = tid & 63; const float* kp = KMEAN + (size_t)((b * 8 + j) * 2) * MOBA_DIMC + h * 64 + d; km[tid] = (kp[0] + kp[MOBA_DIMC]) * (1.f / 256.f); }
                        if (tid == 0) *uni = 0u;
                        __syncthreads();
                        float gt[7];
#pragma unroll
                        for (int j = 0; j < 7; ++j) { float p = -INFINITY;
                            if (j < qb) { p = 0.f;
#pragma unroll
                                for (int ks = 0; ks < 4; ++ks)
#pragma unroll
                                    for (int jj = 0; jj < 8; ++jj) p += bf2f((unsigned short)qf[ks][jj]) * km[j * 64 + ks * 16 + hh * 8 + jj];
                                p += __shfl_xor(p, 32); }
                            gt[j] = p; }
                        unsigned sel = 0u;
#pragma unroll
                        for (int j = 0; j < 7; ++j) { int c = 0;
#pragma unroll
                            for (int j2 = 0; j2 < 7; ++j2) c += (gt[j2] > gt[j] || (gt[j2] == gt[j] && j2 < j)) ? 1 : 0;
                            if (j < qb && c < 3) sel |= 1u << j; }
                        { unsigned o = sel;
#pragma unroll
                          for (int s = 1; s < 64; s <<= 1) o |= __shfl_xor(o, s);
                          if (lane == 0 && o) atomicOr((unsigned*)uni, o); }
                        __syncthreads();
                        att::MobaMask mk; mk.qb = qb; mk.wq0 = 32 * wave; mk.tq = tq; mk.sel = sel; mk.uni = __builtin_amdgcn_readfirstlane(*uni);
                        att::State st; att::reset(st);
                        att::flash_run<att::MobaMask, false>(lds, KB + (size_t)b * SEQ * MOBA_DIMC + h * 64, VB + (size_t)b * SEQ * MOBA_DIMC + h * 64, MOBA_DIMC, 0, 4 * (qb + 1), qf, st, mk, tid);
                        att::store_o(YB + tok * DM + 256 + h * 64, st.o0, st.o1, st.l > 0.f ? 1.f / st.l : 0.f, hh);
                        __syncthreads();
                    } else {
                        const int pu = u - 768, tok0 = pu * 32, t0 = tok0 & (SEQ - 1);
                        LAS float* ub = (LAS float*)lds;
                        LAS float* pl = (LAS float*)(lds + 47 * 1024);
                        for (int idx = tid; idx < 47 * 64; idx += 512) { const int rr = idx >> 6, c4 = (idx & 63) * 4; const int t = t0 - 15 + rr;
                            f32x4 v = {0.f, 0.f, 0.f, 0.f}; if (t >= 0) v = *(const f32x4*)(UPOOL + (size_t)(tok0 - 15 + rr) * 256 + c4);
                            *(LAS f32x4*)(ub + rr * 256 + c4) = v; }
                        __syncthreads();
                        for (int idx = tid; idx < 32 * 256; idx += 512) { const int tt = idx >> 8, c = idx & 255, w = 2 << (c >> 6), t = t0 + tt;
                            const int cnt = (t + 1 < w) ? t + 1 : w; float s = 0.f;
                            for (int q = 0; q < cnt; ++q) s += ub[(15 + tt - q) * 256 + c];
                            pl[idx] = s / (float)cnt - ub[(15 + tt) * 256 + c]; }
                        __syncthreads();
                        { const int c = tid & 255, hf = tid >> 8, gi = c >> 6, d = c & 63;
                          const float* pw = (const float*)INP(7) + ((size_t)(i2 * 4 + gi) * 64) * 64 + d; const float sc = ((const float*)INP(8))[i2 * 256 + c];
                          float a[16];
#pragma unroll
                          for (int q = 0; q < 16; ++q) a[q] = 0.f;
                          for (int k = 0; k < 64; ++k) { const float wv = pw[k * 64];
#pragma unroll
                              for (int q = 0; q < 16; ++q) a[q] += pl[(hf * 16 + q) * 256 + gi * 64 + k] * wv; }
#pragma unroll
                          for (int q = 0; q < 16; ++q) YB[(size_t)(tok0 + hf * 16 + q) * DM + c] = (bf16)f2bf(a[q] * sc); }
                        __syncthreads();
                    }
                }
            } else if (ON(8) && !even) {
                for (int u0 = bx, rnd = 0; u0 < 1024; u0 += G, ++rnd) {
                    const int u = ((rnd & 1) && (u0 - bx) + G <= 1024) ? (u0 - bx) + (G - 1 - bx) : u0;
                    const int tb = 31 - u / 32, bg = u % 32, b = bg >> 2, g = bg & 3;
                    LAS float* pslc = (LAS float*)(lds + att::KV_BYTES);
                    LAS float* sc = (LAS float*)(lds + att::KV_BYTES + 32768);
                    LAS unsigned* selm = (LAS unsigned*)(lds + att::KV_BYTES + 65536);
                    LAS float* yst = (LAS float*)(lds + att::KV_BYTES) + (size_t)wave * 32 * 64 + lane;
                    const int r = lane & 31, hh = lane >> 5, hd = wave & 3, th = wave >> 2, tq = 32 * th + r, t = 64 * tb + tq;
                    const size_t tok = (size_t)b * SEQ + t; const int head = g * 4 + hd;
                    f32x16 y0, y1;
                    bf16x8 qf[4];
                    att::State st;
                    {
                        att::load_q(qf, QRAW + tok * DM + head * 64, hh);
                        att::CmpMask mk; mk.nmax = (t >= 31) ? ((t - 31) >> 4) : -1;
                        const int tlo = 64 * tb + 32 * th, thi = tlo + 31; mk.nlo = (tlo >= 31) ? ((tlo - 31) >> 4) : -1; mk.nhi = (thi >= 31) ? ((thi - 31) >> 4) : -1;
                        att::reset(st);
                        att::flash_run<att::CmpMask, true>(lds, KCMP + (size_t)bg * 128 * 64, VCMP + (size_t)bg * 128 * 64, 64, 0, tb <= 15 ? 1 : 2, qf, st, mk, tid);
                        const float inv = st.l > 0.f ? 1.f / st.l : 0.f, sg = inv * GATES[tok * 48 + head * 3 + 0];
                        y0 = st.o0 * sg; y1 = st.o1 * sg;
#pragma unroll
                        for (int i = 0; i < 16; ++i) pslc[(hd * 64 + tq) * 32 + (i & 3) + 8 * (i >> 2) + 4 * hh] = st.o2[i] * inv;
                    }
                    const int jlo_w = tb >= 8 ? tb - 8 : 0;
                    const int npre = att::flash_prefetch(lds, KWB + (size_t)b * SEQ * 256 + g * 64, VWB + (size_t)b * SEQ * 256 + g * 64, 256, jlo_w, tb + 1, tid);
                    __syncthreads();
#pragma nounroll
                    for (int p = 0; p < 4; ++p) { const int tt = p * 16 + (tid >> 5), j = tid & 31;
                        float v = -1.f;
                        if (j <= tb) v = (j == 0 || j == tb || j == tb - 1) ? 1e4f : ((pslc[(0 * 64 + tt) * 32 + j] + pslc[(1 * 64 + tt) * 32 + j]) + (pslc[(2 * 64 + tt) * 32 + j] + pslc[(3 * 64 + tt) * 32 + j]));
                        sc[tt * 32 + j] = v; }
                    __syncthreads();
#pragma nounroll
                    for (int p = 0; p < 4; ++p) { const int tt = p * 16 + (tid >> 5), j = tid & 31; const float my = sc[tt * 32 + j]; int c = 0;
#pragma unroll 8
                        for (int j2 = 0; j2 < 32; ++j2) { const float o = sc[tt * 32 + j2]; c += (o > my || (o == my && j2 < j)) ? 1 : 0; }
                        const unsigned long long bm = __ballot(c < 16 && j <= tb);
                        if ((lane & 31) == 0) selm[tt] = (unsigned)(bm >> (lane & 32)); }
                    __syncthreads();
                    unsigned uni;
                    { unsigned o = selm[lane];
#pragma unroll
                      for (int s = 1; s < 64; s <<= 1) o |= __shfl_xor(o, s);
                      uni = __builtin_amdgcn_readfirstlane(o); }
                    const unsigned sel = selm[tq];
                    __syncthreads();
#pragma unroll
                    for (int i = 0; i < 16; ++i) { yst[i * 64] = y0[i]; yst[(16 + i) * 64] = y1[i]; }
                    att::load_q(qf, QROT + tok * DM + head * 64, hh);
                    {
                        att::WinMask mk; mk.tb = tb; mk.tq = tq;
                        att::reset(st);
                        att::flash_run<att::WinMask, false>(lds, KWB + (size_t)b * SEQ * 256 + g * 64, VWB + (size_t)b * SEQ * 256 + g * 64, 256, jlo_w, tb + 1, qf, st, mk, tid, npre);
                        const float sg = (st.l > 0.f ? 1.f / st.l : 0.f) * GATES[tok * 48 + head * 3 + 2];
#pragma unroll
                        for (int i = 0; i < 16; ++i) { yst[i * 64] += st.o0[i] * sg; yst[(16 + i) * 64] += st.o1[i] * sg; }
                    }
                    {
                        att::SelMask mk; mk.tb = tb; mk.tq = tq; mk.wq0 = 32 * th; mk.sel = sel; mk.uni = uni;
                        att::reset(st);
                        att::flash_run<att::SelMask, false>(lds, KSB + (size_t)b * SEQ * 256 + g * 64, VSB + (size_t)b * SEQ * 256 + g * 64, 256, 0, tb + 1, qf, st, mk, tid);
                        const float sg = (st.l > 0.f ? 1.f / st.l : 0.f) * GATES[tok * 48 + head * 3 + 1];
#pragma unroll
                        for (int i = 0; i < 16; ++i) { y0[i] = yst[i * 64] + st.o0[i] * sg; y1[i] = yst[(16 + i) * 64] + st.o1[i] * sg; }
                    }
                    att::store_o(YB + tok * DM + head * 64, y0, y1, 1.f, hh);
                    __syncthreads();
                }
            }
            BAR_AFTER(pb + 3); T_DELAY((even ? DLY(7) : DLY(8)));
        }
        if (ON(9) && IN(pb + 4)) {
            PHASE_IDS T_START
            const bf16* W = even ? (const bf16*)(ws + WS_W_OUTAB) + (size_t)i2 * DM * DM : (const bf16*)(ws + WS_W_OUTC) + (size_t)i2 * DM * DM;
            pg8::Gemm g{YB, W, DM, DM, DM}; pg8::StaticOrder S; S.init(MTOK, DM, G, bx, DM, DM);
            pg8::EpiRes E{XB, SSQ};
            pg8::gemm_phase<pg8::EpiRes, pg8::StaticOrder>(lds, g, S, E, tid);
            BAR_AFTER(pb + 4); T_DELAY(DLY(9));
        }
        if (ON(10) && IN(pb + 5)) {
            PHASE_IDS T_START
            if (l == 0 && ON(1) && bx >= 64 && bx < 128) {
                pg8::Gemm g{MEMB, (const bf16*)(ws + WS_W_XKV), DM, DM, DM}; pg8::StaticOrder S; S.init(NB * MEML, 4 * 512, G, bx - 64, DM, DM);
                pg8::EpiXKV E{XK, XV};
                pg8::gemm_phase<pg8::EpiXKV, pg8::StaticOrder>(lds, g, S, E, tid);
            } else {
                pg8::Gemm g{XB, (const bf16*)(ws + WS_W_XQ) + (size_t)l * 256 * DM, DM, DM, DM}; pg8::StaticOrder S; S.init(MTOK, 256, G, bx, DM, DM);
                pg8::EpiXQ E{SSQ, XQ};
                pg8::gemm_phase<pg8::EpiXQ, pg8::StaticOrder>(lds, g, S, E, tid);
            }
            if (G == 256) {
                if (l == 0) { if (bx >= 128) MOE_CONV_SLICE(0, MS0_A0, MS0_A1, bx - 128, 128); }
                else if (l == 1) { if (bx >= 64) MOE_CONV_SLICE(0, MS0_A2, MS0_A3, bx - 64, 192); }
                else if (l == 2) { if (bx >= 64) MOE_CONV_SLICE(1, MS1_B0, MS1_B1, bx - 64, 192); }
                else { if (bx >= 64) MOE_CONV_SLICE(1, MS1_B2, MS1_B3, bx - 64, 192); }
            }
            BAR_AFTER(pb + 5); T_DELAY(DLY(10));
        }
        if (ON(11) && IN(pb + 6)) {
            PHASE_IDS T_START
            for (int u = bx; u < 256; u += G) {
                const int b = u >> 5, h = (u >> 3) & 3, qt = u & 7;
                const int r = lane & 31, hh = lane >> 5;
                const size_t tok = (size_t)b * SEQ + 256 * qt + 32 * wave + r;
                bf16x8 qf[4]; att::load_q(qf, XQ + tok * 256 + h * 64, hh);
                att::NoMask mk; att::State st; att::reset(st);
                att::flash_run<att::NoMask, false>(lds, XK + ((size_t)l * NB * MEML + (size_t)b * MEML) * 256 + h * 64, XV + ((size_t)l * NB * MEML + (size_t)b * MEML) * 256 + h * 64, 256, 0, 4, qf, st, mk, tid);
                att::store_o(XO + tok * 256 + h * 64, st.o0, st.o1, 1.f / st.l, hh);
            }
            BAR_AFTER(pb + 6); T_DELAY(DLY(11));
        }
        if (ON(12) && IN(pb + 7)) {
            PHASE_IDS T_START
            pg8::Gemm g{XO, (const bf16*)(ws + WS_W_XO) + (size_t)l * DM * 256, 256, 256, 256}; pg8::StaticOrder S; S.init(MTOK, DM, G, bx, 256, 256);
            pg8::EpiRes E{XB, SSQ};
            pg8::gemm_phase<pg8::EpiRes, pg8::StaticOrder>(lds, g, S, E, tid);
            BAR_AFTER(pb + 7); T_DELAY(DLY(12));
        }
        if (IN(pb + 8)) {
            PHASE_IDS T_START
            if (ON(13) && even) {
                pg8::Gemm g{XB, (const bf16*)(ws + WS_W_FFNGU) + (size_t)i2 * 2 * DFF * DM, DM, DM, DM}; pg8::StaticOrder S; S.init(MTOK, 2 * DFF, G, bx, DM, DM);
                pg8::EpiGateUp<false> E{SSQ, HB, DFF};
                pg8::gemm_phase<pg8::EpiGateUp<false>, pg8::StaticOrder>(lds, g, S, E, tid);
                if (G == 256 && bx >= 128) { if (l == 0) MOE_CONV_SLICE(0, MS0_A1, MS0_A2, bx - 128, 128); else MOE_CONV_SLICE(1, MS1_B1, MS1_B2, bx - 128, 128); }
            } else if (ON(14) && !even) {
                for (int idx = bx * 512 + tid; idx < MOE_MAX_ROWS; idx += G * 512) ROWTOK[idx] = -1;
                const float* gn = norm_g + (l * 3 + 2) * DM; const float* rw = (const float*)INP(21) + (size_t)i2 * DM * NEXP;
                LAS float* wg = (LAS float*)(lds + 4096);
                for (int idx = tid; idx < DM * NEXP / 4; idx += 512) { const int k = idx >> 1; *(LAS f32x4*)(wg + idx * 4) = *(const f32x4*)(rw + idx * 4) * gn[k]; }
                LAS int* lcnt = (LAS int*)lds;
                LAS int* lte = (LAS int*)(lds + 64);
                LAS int* ltp = (LAS int*)(lds + 64 + 512);
                LAS float* ltw = (LAS float*)(lds + 64 + 1024);
                LAS float* ltr = (LAS float*)(lds + 64 + 1536);
                for (int tb0 = bx * 64; tb0 < MTOK; tb0 += G * 64) {
                    if (tid < 16) lcnt[tid] = 0;
                    __syncthreads();
#pragma nounroll
                    for (int q = 0; q < 8; ++q) {
                        const int tl = wave * 8 + q, m = tb0 + tl;
                        f32x4 v[4]; const float s = load_row4_bf16(XB + (size_t)m * DM, lane, v); const float rstd = rsqrtf(s * (1.f / DM) + NORM_EPS);
                        float lg[NEXP];
#pragma unroll
                        for (int e = 0; e < NEXP; ++e) lg[e] = 0.f;
#pragma unroll
                        for (int j = 0; j < 4; ++j) {
#pragma unroll
                            for (int qq = 0; qq < 4; ++qq) { const float hv = v[j][qq]; const LAS float* wr_ = wg + (4 * lane + 256 * j + qq) * NEXP; const f32x4 w0 = *(const LAS f32x4*)wr_, w1 = *(const LAS f32x4*)(wr_ + 4);
                                lg[0] += hv * w0[0]; lg[1] += hv * w0[1]; lg[2] += hv * w0[2]; lg[3] += hv * w0[3]; lg[4] += hv * w1[0]; lg[5] += hv * w1[1]; lg[6] += hv * w1[2]; lg[7] += hv * w1[3]; } }
#pragma unroll
                        for (int e = 0; e < NEXP; ++e) lg[e] = wave_sum(lg[e]) * rstd;
                        int e0 = 0; float v0 = lg[0];
#pragma unroll
                        for (int e = 1; e < NEXP; ++e) if (lg[e] > v0) { v0 = lg[e]; e0 = e; }
                        int e1 = -1; float v1 = -INFINITY;
#pragma unroll
                        for (int e = 0; e < NEXP; ++e) if (e != e0 && lg[e] > v1) { v1 = lg[e]; e1 = e; }
                        if (lane == 0) {
                            const float w1 = 1.f / (1.f + expf(v0 - v1)), w0 = 1.f - w1;
                            lte[2 * tl] = e0; lte[2 * tl + 1] = e1; ltw[2 * tl] = w0; ltw[2 * tl + 1] = w1; ltr[tl] = rstd;
                            ltp[2 * tl] = atomicAdd((int*)(lcnt + e0), 1); ltp[2 * tl + 1] = atomicAdd((int*)(lcnt + e1), 1);
                        }
                    }
                    __syncthreads();
                    if (tid < NEXP) LCNT[(tb0 >> 6) * NEXP + tid] = lcnt[tid];
                    if (tid < 128) { const int tl = tid >> 1, m = tb0 + tl;
                        TOKE[2 * m + (tid & 1)] = lte[tid]; TOKPOS[2 * m + (tid & 1)] = ltp[tid]; TOKW[2 * m + (tid & 1)] = ltw[tid];
                        if ((tid & 1) == 0) TOKRSTD[m] = ltr[tl]; }
                    __syncthreads();
                }
            }
            BAR_AFTER(pb + 8); T_DELAY((even ? DLY(13) : DLY(14)));
        }
        if (IN(pb + 9)) {
            PHASE_IDS T_START
            if (ON(15) && even) {
                pg8::Gemm g{HB, (const bf16*)(ws + WS_W_FFND) + (size_t)i2 * DM * DFF, DFF, DFF, DFF}; pg8::StaticOrder S; S.init(MTOK, DM, G, bx, DFF, DFF);
                pg8::EpiRes E{XB, SSQ};
                pg8::gemm_phase<pg8::EpiRes, pg8::StaticOrder>(lds, g, S, E, tid);
            } else if (ON(16) && !even) {
                LAS int* pre = (LAS int*)lds;
                LAS int* ebase = (LAS int*)(lds + 256 * NEXP * 4);
                for (int idx = tid; idx < (MTOK / 64) * NEXP; idx += 512) pre[idx] = LCNT[idx];
                __syncthreads();
                if (tid < NEXP) { int run = 0; for (int tb = 0; tb < MTOK / 64; ++tb) { const int c = pre[tb * NEXP + tid]; pre[tb * NEXP + tid] = run; run += c; } ebase[tid] = run; }
                __syncthreads();
                if (tid == 0) { int acc_t = 0;
                    for (int e = 0; e < NEXP; ++e) { const int c = ebase[e]; ebase[e] = acc_t * 256; const int nt_ = (c + 255) >> 8;
                        if (bx == 0) for (int q = 0; q < nt_; ++q) TILEE[acc_t + q] = e;
                        acc_t += nt_; }
                    if (bx == 0) TILEE[MOE_MAX_TILES] = acc_t; }
                __syncthreads();
                for (int m = gw; m < MTOK; m += NGW) {
                    const int e0 = TOKE[2 * m], e1 = TOKE[2 * m + 1];
                    const int r0 = ebase[e0] + pre[(m >> 6) * NEXP + e0] + TOKPOS[2 * m], r1 = ebase[e1] + pre[(m >> 6) * NEXP + e1] + TOKPOS[2 * m + 1];
                    const float rq = TOKRSTD[m] * FP8_SX;
                    const u32x4 a = *(const u32x4*)(XB + (size_t)m * DM + 16 * lane), c = *(const u32x4*)(XB + (size_t)m * DM + 16 * lane + 8);
                    u32x4 o;
                    o.x = pk4_fp8(__builtin_bit_cast(float, a.x << 16) * rq, __builtin_bit_cast(float, a.x & 0xffff0000u) * rq, __builtin_bit_cast(float, a.y << 16) * rq, __builtin_bit_cast(float, a.y & 0xffff0000u) * rq);
                    o.y = pk4_fp8(__builtin_bit_cast(float, a.z << 16) * rq, __builtin_bit_cast(float, a.z & 0xffff0000u) * rq, __builtin_bit_cast(float, a.w << 16) * rq, __builtin_bit_cast(float, a.w & 0xffff0000u) * rq);
                    o.z = pk4_fp8(__builtin_bit_cast(float, c.x << 16) * rq, __builtin_bit_cast(float, c.x & 0xffff0000u) * rq, __builtin_bit_cast(float, c.y << 16) * rq, __builtin_bit_cast(float, c.y & 0xffff0000u) * rq);
                    o.w = pk4_fp8(__builtin_bit_cast(float, c.z << 16) * rq, __builtin_bit_cast(float, c.z & 0xffff0000u) * rq, __builtin_bit_cast(float, c.w << 16) * rq, __builtin_bit_cast(float, c.w & 0xffff0000u) * rq);
                    *(u32x4*)((unsigned char*)XPERM + (size_t)r0 * DM + 16 * lane) = o; *(u32x4*)((unsigned char*)XPERM + (size_t)r1 * DM + 16 * lane) = o;
                    if (lane == 0) { const float rs_ = TOKRSTD[m]; ROWTOK[r0] = 2 * m; ROWTOK[r1] = 2 * m + 1; ROWW[r0] = TOKW[2 * m]; ROWW[r1] = TOKW[2 * m + 1]; ROWRSTD[r0] = rs_; ROWRSTD[r1] = rs_; }
                }
            }
            BAR_AFTER(pb + 9); T_DELAY((even ? DLY(15) : DLY(16)));
        }
        if (ON(17) && IN(pb + 10) && !even) {
            PHASE_IDS T_START
            pg8::Gemm g{XPERM, (const bf16*)(ws + WS_W_MOEGU + i2 * MOEGU_SET), DM / 2, DM / 2, DM / 2}; pg8::MoeOrder S{TILEE, 2 * DFFE / 256, G, bx, DM / 2, DM / 2, 2 * DFFE};
            pg8::EpiGateUp<true> E{nullptr, HB, DFFE};
            pg8::gemm_phase<pg8::EpiGateUp<true>, pg8::MoeOrder, true, E8(6), E8(2)>(lds, g, S, E, tid);
            BAR_AFTER(pb + 10); T_DELAY(DLY(17));
        }
        if (ON(18) && IN(pb + 11) && !even) {
            PHASE_IDS T_START
            pg8::Gemm g{HB, (const bf16*)(ws + WS_W_MOED + i2 * MOED_SET), DFFE / 2, DFFE / 2, DFFE / 2}; pg8::MoeOrder S{TILEE, DM / 256, G, bx, DFFE / 2, DFFE / 2, DM};
            pg8::EpiMoeDown E{ROWTOK, ROWW, YMOE};
            pg8::gemm_phase<pg8::EpiMoeDown, pg8::MoeOrder, true, E8(7), E8(3)>(lds, g, S, E, tid);
            BAR_AFTER(pb + 11); T_DELAY(DLY(18));
        }
        if (ON(19) && IN(pb + 12) && !even) {
            PHASE_IDS T_START
            if (l == 1) {
                LAS ConvJob* jobsw = (LAS ConvJob*)(lds + CONV_JOBS_OFF);
                if (tid == 0) { int nj = 0, tot = 0; BUILD_MOE_JOBS(1); }
                __syncthreads();
                run_conv_jobs(lds, 24, G == 256 ? MS1_B3 : 0, MOE_ITEMS, gw, NGW, wave, lane);
            }
            for (int m = gw; m < MTOK; m += NGW) {
                f32x4 v[4]; float s = 0.f;
#pragma unroll
                for (int j = 0; j < 4; ++j) { const size_t o = (size_t)m * DM + 4 * lane + 256 * j;
                    const u32x2 y0 = *(const u32x2*)(YMOE + o), y1 = *(const u32x2*)(YMOE + (size_t)MTOK * DM + o);
                    const f32x4 a0 = {__builtin_bit_cast(float, y0.x << 16), __builtin_bit_cast(float, y0.x & 0xffff0000u), __builtin_bit_cast(float, y0.y << 16), __builtin_bit_cast(float, y0.y & 0xffff0000u)};
                    const f32x4 a1 = {__builtin_bit_cast(float, y1.x << 16), __builtin_bit_cast(float, y1.x & 0xffff0000u), __builtin_bit_cast(float, y1.y << 16), __builtin_bit_cast(float, y1.y & 0xffff0000u)};
                    const u32x2 xo = *(const u32x2*)(XB + o);
                    const f32x4 xv = {__builtin_bit_cast(float, xo.x << 16), __builtin_bit_cast(float, xo.x & 0xffff0000u), __builtin_bit_cast(float, xo.y << 16), __builtin_bit_cast(float, xo.y & 0xffff0000u)};
                    v[j] = (xv + a0) + a1;
                    s += (v[j][0] * v[j][0] + v[j][1] * v[j][1]) + (v[j][2] * v[j][2] + v[j][3] * v[j][3]); }
                s = wave_sum(s);
                if (l == 3) { const float r = rsqrtf(s * (1.f / DM) + NORM_EPS);
#pragma unroll
                    for (int j = 0; j < 4; ++j) *(f32x4*)(X + (size_t)m * DM + 4 * lane + 256 * j) = v[j] * r * *(const f32x4*)(final_g + 4 * lane + 256 * j);
                } else {
                    store_row_bf16(XB + (size_t)m * DM, lane, v); store_ssq_full(SSQ, m, s, lane);
                }
            }
            BAR_AFTER(pb + 12); T_DELAY(DLY(19));
        }
}
__global__ void __launch_bounds__(NWAVES * 64, 2) mk_fwd(Args args) {
    extern __shared__ __attribute__((aligned(16))) unsigned char lds_raw[];
    LAS unsigned char* lds = (LAS unsigned char*)lds_raw;
    volatile LAS unsigned* MISC = (volatile LAS unsigned*)(lds + MISC_OFF);
    for (int u = threadIdx.x; u < (LDS_BYTES - LDSCTL_OFF) / 4; u += NWAVES * 64) ((LAS unsigned*)(lds + LDSCTL_OFF))[u] = 0u;
    __syncthreads();
    if (MK_SINGLE) (void)xcd_barrier_post(ctl + CW_BAR, MISC + 8);


    if (ON(0) && IN(0)) {
            PHASE_IDS T_START
        LAS ConvJob* jobsw = (LAS ConvJob*)(lds + CONV_JOBS_OFF);
        LAS int* jmeta = (LAS int*)(lds + CONV_META_OFF);
        if (tid == 0) {
            int nj = 0, tot = 0;
#pragma nounroll
            for (int i = 0; i < 2; ++i) {
                ADD_JOB((const float*)INP(6) + (size_t)i * DM * AB_IN, (bf16*)(ws + WS_W_INAB) + (size_t)i * AB_IN * DM, norm_g + (2 * i * 3 + 0) * DM, DM, AB_IN, 0);
                ADD_JOB((const float*)INP(9) + (size_t)i * DM * DM, (bf16*)(ws + WS_W_OUTAB) + (size_t)i * DM * DM, (const float*)nullptr, DM, DM, 0);
                ADD_JOB((const float*)INP(10) + (size_t)i * DM * DFF, (bf16*)(ws + WS_W_FFNGU) + (size_t)i * 2 * DFF * DM, norm_g + (2 * i * 3 + 2) * DM, DM, DFF, 1);
                ADD_JOB((const float*)INP(11) + (size_t)i * DM * DFF, (bf16*)(ws + WS_W_FFNGU) + (size_t)i * 2 * DFF * DM, norm_g + (2 * i * 3 + 2) * DM, DM, DFF, 2);
                ADD_JOB((const float*)INP(12) + (size_t)i * DFF * DM, (bf16*)(ws + WS_W_FFND) + (size_t)i * DM * DFF, (const float*)nullptr, DFF, DM, 0);
                ADD_JOB((const float*)INP(13) + (size_t)i * DM * C_IN, (bf16*)(ws + WS_W_INC) + (size_t)i * C_IN_PAD * DM, norm_g + ((2 * i + 1) * 3 + 0) * DM, DM, C_IN, 0);
                ADD_JOB((const float*)INP(16) + (size_t)i * 2048 * 256, (bf16*)(ws + WS_W_CW1) + (size_t)(i * 2 + 0) * 256 * 2048, (const float*)nullptr, 2048, 256, 0);
                ADD_JOB((const float*)INP(18) + (size_t)i * 2048 * 256, (bf16*)(ws + WS_W_CW1) + (size_t)(i * 2 + 1) * 256 * 2048, (const float*)nullptr, 2048, 256, 0);
                ADD_JOB((const float*)INP(20) + (size_t)i * DM * DM, (bf16*)(ws + WS_W_OUTC) + (size_t)i * DM * DM, (const float*)nullptr, DM, DM, 0);
            }
#pragma nounroll
            for (int l = 0; l < 4; ++l) {
                ADD_JOB((const float*)INP(25) + (size_t)l * DM * 256, (bf16*)(ws + WS_W_XQ) + (size_t)l * 256 * DM, norm_g + (l * 3 + 1) * DM, DM, 256, 0);
                ADD_JOB((const float*)INP(26) + (size_t)l * DM * 512, (bf16*)(ws + WS_W_XKV) + (size_t)l * 512 * DM, (const float*)nullptr, DM, 512, 0);
                ADD_JOB((const float*)INP(27) + (size_t)l * 256 * DM, (bf16*)(ws + WS_W_XO) + (size_t)l * DM * 256, (const float*)nullptr, 256, DM, 0);
            }
            jmeta[0] = nj; jmeta[1] = tot;
        }
        __syncthreads();
        run_conv_jobs(lds, jmeta[0], 0, jmeta[1], gw, NGW, wave, lane);
        __syncthreads();
        if (tid == 0) { int nj = 0, tot = 0; BUILD_MOE_JOBS(0); }
        __syncthreads();
        run_conv_jobs(lds, 24, G == 256 ? MS0_A3 : 0, MOE_ITEMS, gw, NGW, wave, lane);
        for (int idx = bx * 512 + tid; idx < 2 * (C_IN_PAD - C_IN) * (DM / 8); idx += G * 512) {
            const int i = idx / ((C_IN_PAD - C_IN) * (DM / 8)), rem = idx % ((C_IN_PAD - C_IN) * (DM / 8));
            *(u32x4*)((bf16*)(ws + WS_W_INC) + ((size_t)i * C_IN_PAD + C_IN) * DM + (size_t)rem * 8) = (u32x4){0u, 0u, 0u, 0u};
        }
        for (int m = gw; m < MTOK; m += NGW) {
            f32x4 v[4]; const float s = load_row4(in_x + (size_t)m * DM, lane, v);
            store_row_bf16(XB + (size_t)m * DM, lane, v); store_ssq_full(SSQ, m, s, lane);
        }
        for (int m = gw; m < NB * MEML; m += NGW) {
            f32x4 v[4]; const float s = load_row4(in_mem + (size_t)m * DM, lane, v); const float r = rsqrtf(s * (1.f / DM) + NORM_EPS);
#pragma unroll
            for (int j = 0; j < 4; ++j) v[j] = v[j] * r * *(const f32x4*)(mem_g + 4 * lane + 256 * j);
            store_row_bf16(MEMB + (size_t)m * DM, lane, v);
        }
        for (int idx = bx * 512 + tid; idx < SEQ * 8; idx += G * 512) {
            const int t = idx >> 3, j = idx & 7; const double a = (double)in_pos[t] * ARG_INVF(j) * 0.15915494309189535;
            const float fr_ = (float)(a - __builtin_rint(a));
            CS[t * 16 + j] = __builtin_amdgcn_cosf(fr_); CS[t * 16 + 8 + j] = __builtin_amdgcn_sinf(fr_);
        }
        BAR_AFTER(0); T_DELAY(DLY(0));
    }


    run_layer<0>(lds); run_layer<1>(lds); run_layer<2>(lds); run_layer<3>(lds);
#undef IN
#undef BAR_AFTER
}
#undef ws
#undef ctl
#undef X

static bool phase_applies(int p) {
    if (p == 0) return true;
    if (p == 1) return false;
    const int l = (p - 2) / 13, k = (p - 2) % 13; const bool even = (l & 1) == 0;
    if (even) return k != 1 && k != 2 && k < 10;
    return true;
}
#ifndef DUP_EVEN
#define DUP_EVEN 0u
#endif
#ifndef DUP_ODD
#define DUP_ODD 0u
#endif
static bool probe_dup(int p) {
    if (p == 0) return (DUP_EVEN >> 13) & 1u;
    if (p == 1) return (DUP_EVEN >> 14) & 1u;
    const int l = (p - 2) / 13, k = (p - 2) % 13;
    return (((l & 1) ? DUP_ODD : DUP_EVEN) >> k) & 1u;
}
extern "C" void kernel_launch(void* const* d_in, const int* in_sizes, int n_in, void* d_out, int out_size, void* d_ws, size_t ws_size, hipStream_t stream) {
    static int grid = 0;
    if (grid == 0) {
        if (n_in != 28 || out_size != MTOK * DM || ws_size < WS_END) { fprintf(stderr, "kernel_launch: unexpected shapes (n_in %d out %d ws %zu need %zu)\n", n_in, out_size, ws_size, (size_t)WS_END); grid = -1; return; }
        int dev = 0, cus = 0;
        if (hipGetDevice(&dev) != hipSuccess || hipDeviceGetAttribute(&cus, hipDeviceAttributeMultiprocessorCount, dev) != hipSuccess) { grid = -1; return; }
        if (hipFuncSetAttribute((const void*)mk_fwd, hipFuncAttributeMaxDynamicSharedMemorySize, LDS_BYTES) != hipSuccess) { fprintf(stderr, "kernel_launch: hipFuncSetAttribute failed\n"); grid = -1; return; }
        int per_cu = 0;
        if (hipOccupancyMaxActiveBlocksPerMultiprocessor(&per_cu, (const void*)mk_fwd, NWAVES * 64, LDS_BYTES) != hipSuccess || per_cu < 1) fprintf(stderr, "kernel_launch: occupancy query reports %d\n", per_cu);
        (void)hipGetLastError();
        grid = cus;
    }
    if (grid < 0) return;
    (void)hipMemsetAsync((char*)d_ws + WS_CTL, 0, CTL_ZERO_BYTES, stream);
    Args a{};
    for (int i = 0; i < 28; ++i) a.in[i] = d_in[i];
    a.out = (float*)d_out; a.ws = (unsigned char*)d_ws;
    for (int j = 0; j < 8; ++j) a.invf[j] = pow(500000.0, -(double)(2 * j) / 16.0);
#if MK_SINGLE
    a.ph_lo = 0; a.ph_hi = NPH;
    hipLaunchKernelGGL(mk_fwd, dim3(grid), dim3(NWAVES * 64), LDS_BYTES, stream, a);
#else
    for (int p = 0; p < NPH; ++p) {
        if (!phase_applies(p)) continue;
        a.ph_lo = p; a.ph_hi = p + 1;
        const int nrep = probe_dup(p) ? 2 : 1;
        for (int r = 0; r < nrep; ++r) hipLaunchKernelGGL(mk_fwd, dim3(grid), dim3(NWAVES * 64), LDS_BYTES, stream, a);
    }
#endif
}
```

```cpp
#include <hip/hip_runtime.h>
#include <cstdio>
#include <cstdint>
#include <cmath>
#include <cstddef>

#ifndef MK_SINGLE
#define MK_SINGLE 1
#endif

#ifndef PHMASK
#define PHMASK 0xFFFFFFu
#endif
#define ON(n) (((PHMASK) >> (n)) & 1u)
#ifndef DELAYMASK
#define DELAYMASK 0u
#endif
#define DLY(n) (((DELAYMASK) >> (n)) & 1u)
#define GAS __attribute__((address_space(1)))
#define LAS __attribute__((address_space(3)))
typedef unsigned short bf16;
typedef short bf16x8 __attribute__((ext_vector_type(8)));
typedef short s16x4 __attribute__((ext_vector_type(4)));
typedef float f32x4 __attribute__((ext_vector_type(4)));
typedef float f32x2 __attribute__((ext_vector_type(2)));
typedef float f32x16 __attribute__((ext_vector_type(16)));
typedef unsigned u32x4 __attribute__((ext_vector_type(4)));
typedef unsigned u32x2 __attribute__((ext_vector_type(2)));
typedef __bf16 bf16x2_t __attribute__((ext_vector_type(2)));

constexpr int NB = 8, SEQ = 2048, DM = 1024, MTOK = NB * SEQ, MEML = 256;
constexpr int AB_IN = 2560, MOBA_DIMC = 768, C_IN = 2608, C_IN_PAD = 2816;
constexpr int DFF = 2816, DFFE = 3584, NEXP = 8;
constexpr int MOE_MAX_TILES = 136, MOE_MAX_ROWS = MOE_MAX_TILES * 256;
constexpr int CMP_SPLIT = 8;
constexpr float NORM_EPS = 1e-5f;
constexpr float C2 = 0.125f * 1.4426950408889634f;

constexpr size_t MiB = 1u << 20, KiB = 1024;
constexpr size_t WS_CTL = 0, CTL_ZERO_BYTES = 64 * KiB;
constexpr size_t WS_W_INAB = 1 * MiB, WS_W_OUTAB = 11 * MiB, WS_W_FFNGU = 15 * MiB, WS_W_FFND = 37 * MiB, WS_W_INC = 48 * MiB, WS_W_CW1 = 59 * MiB,
                 WS_W_OUTC = 63 * MiB, WS_W_XQ = 67 * MiB, WS_W_XKV = 69 * MiB, WS_W_XO = 73 * MiB, WS_W_MOEGU = 75 * MiB, WS_W_MOED = 187 * MiB;
constexpr size_t WS_XB = 243 * MiB, WS_SSQ = 275 * MiB, WS_MISC = 276 * MiB, WS_MEMB = 280 * MiB, WS_XK = 284 * MiB, WS_XV = 288 * MiB,
                 WS_YB = 292 * MiB, WS_XQ = 324 * MiB, WS_XO = 332 * MiB, WS_ROUTE = 340 * MiB, WS_REGA = 342 * MiB, WS_REGB = 538 * MiB, WS_END = 776 * MiB;
constexpr size_t MISC_CS = 0, MISC_KMEAN = 128 * KiB, MISC_KCMP = 512 * KiB, MISC_VCMP = 1024 * KiB;
constexpr size_t RT_TOKE = 0, RT_TOKPOS = 128 * KiB, RT_TOKW = 256 * KiB, RT_TOKRSTD = 384 * KiB, RT_ROWTOK = 512 * KiB, RT_ROWW = 704 * KiB, RT_ROWRSTD = 896 * KiB, RT_TILEE = 1088 * KiB, RT_LCNT = 1152 * KiB;
constexpr size_t RA_UPOOL = 0, RA_QB = 16 * MiB, RA_KB = 40 * MiB, RA_VB = 64 * MiB;
constexpr size_t RA_QRAW = 0, RA_QROT = 32 * MiB, RA_ACMPK = 64 * MiB, RA_ACMPV = 80 * MiB, RA_KS = 96 * MiB, RA_VS = 104 * MiB, RA_KW = 112 * MiB, RA_VW = 120 * MiB,
                 RA_GATES = 128 * MiB, RA_CPART = 132 * MiB;
constexpr size_t RA_YMOE = 0, RA_XPERM = 128 * MiB;
constexpr int CW_BAR = 4096, CW_CNT = 8192;

constexpr int RING_BYTES = 131072, LDS_BYTES = 147456, LDSCTL_OFF = LDS_BYTES - 512, MISC_OFF = LDSCTL_OFF + 320;
constexpr int CONV_JOBS_OFF = 8 * 64 * 65 * 4, CONV_META_OFF = CONV_JOBS_OFF + 64 * 48;
static_assert(CONV_META_OFF + 64 <= LDSCTL_OFF, "LDS map");
constexpr int NWAVES = 8;

__device__ __forceinline__ unsigned f2bf(float f) { unsigned u = __builtin_bit_cast(unsigned, f); return (u + 0x7fffu + ((u >> 16) & 1u)) >> 16; }
__device__ __forceinline__ unsigned pk2(float lo, float hi) { f32x2 v = {lo, hi}; bf16x2_t b = __builtin_convertvector(v, bf16x2_t); return __builtin_bit_cast(unsigned, b); }
__device__ __forceinline__ float bf2f(unsigned short b) { return __builtin_bit_cast(float, (unsigned)b << 16); }
__device__ __forceinline__ float wave_sum(float v) {
#pragma unroll
    for (int o = 1; o < 64; o <<= 1) v += __shfl_xor(v, o);
    return v;
}
__device__ __forceinline__ float fast_exp2(float x) { return __builtin_amdgcn_exp2f(x); }
__device__ __forceinline__ float fast_rcp(float x) { return __builtin_amdgcn_rcpf(x); }
__device__ __forceinline__ float silu_f(float x) { return x * fast_rcp(1.f + fast_exp2(-1.4426950408889634f * x)); }
__device__ __forceinline__ float sigmoid_f(float x) { return fast_rcp(1.f + fast_exp2(-1.4426950408889634f * x)); }
__device__ __forceinline__ float gelu_tanh_f(float x) {
    const float u = 0.7978845608028654f * (x + 0.044715f * x * x * x);
    const float t = 1.f - 2.f * fast_rcp(1.f + fast_exp2(2.f * 1.4426950408889634f * u));
    return 0.5f * x * (1.f + t);
}
#define LDS_WAIT() asm volatile("s_waitcnt lgkmcnt(0)" ::: "memory")
__device__ __forceinline__ unsigned pk4_fp8(float a, float b, float c, float d) {
    a = __builtin_amdgcn_fmed3f(a, -448.f, 448.f); b = __builtin_amdgcn_fmed3f(b, -448.f, 448.f); c = __builtin_amdgcn_fmed3f(c, -448.f, 448.f); d = __builtin_amdgcn_fmed3f(d, -448.f, 448.f);
    int r = 0; r = __builtin_amdgcn_cvt_pk_fp8_f32(a, b, r, false); r = __builtin_amdgcn_cvt_pk_fp8_f32(c, d, r, true); return (unsigned)r;
}
constexpr float FP8_SW_GU = 64.f, FP8_SW_D = 128.f, FP8_SX = 4.f, FP8_SH = 8.f;
constexpr int E8(int e) { return (127 - e) * 0x01010101; }

namespace pg8 {
#define PG8_LAS __attribute__((address_space(3)))
constexpr int BM = 256, BK = 64, HALF = 128, HTB = HALF * BK * 2, NXCD = 8, WGM = 8;
__host__ __device__ __forceinline__ int lds_byte(int r, int c) { const int st = (r >> 4) * 2 + (c >> 5), rr = r & 15, cc = c & 31, ob = rr * 64 + cc * 2; return st * 1024 + (ob ^ (((ob >> 9) & 1) << 5)); }
__host__ __device__ __forceinline__ void stage_rc(int b, int& R, int& C) { const int st = b / 1024, sb = b % 1024, swz = sb ^ (((sb >> 9) & 1) << 5); R = (st >> 1) * 16 + swz / 64; C = (st & 1) * 32 + (swz % 64) / 2; }
__host__ __device__ __forceinline__ int perm32(int rho) { const int n = rho >> 4, i = rho & 15; return 8 * (i >> 2) + 4 * n + (i & 3); }

typedef int v8i32 __attribute__((ext_vector_type(8)));
typedef int v4i32 __attribute__((ext_vector_type(4)));
__device__ __forceinline__ bf16x8 half8(const v8i32& v, int k) { return k ? __builtin_bit_cast(bf16x8, __builtin_shufflevector(v, v, 4, 5, 6, 7)) : __builtin_bit_cast(bf16x8, __builtin_shufflevector(v, v, 0, 1, 2, 3)); }
struct Unit { int pm, pn, aux; size_t oa, ob; };
struct Gemm { const bf16* A; const bf16* Bt; int lda, ldb, K; };

struct StaticOrder {
    int nM, nN, nwg, G, c, lda, ldb;
    __device__ void init(int M, int N, int G_, int c_, int lda_, int ldb_) { nM = M / BM; nN = N / BM; nwg = nM * nN; G = G_; c = c_; lda = lda_; ldb = ldb_; }
    __device__ bool next(int i, Unit& u) const {
        const long L = (long)i * G + c; if (L >= nwg) return false;
        int wgid = (int)L; { const int q = nwg / NXCD, r = nwg % NXCD, xcd = wgid % NXCD, off = wgid / NXCD; wgid = (xcd < r ? xcd * (q + 1) : r * (q + 1) + (xcd - r) * q) + off; }
        const int nig = WGM * nN, gid = wgid / nig, fm = gid * WGM, gsz = (nM - fm) < WGM ? (nM - fm) : WGM;
        u.pm = fm + ((wgid % nig) % gsz); u.pn = (wgid % nig) / gsz; u.aux = 0;
        u.oa = (size_t)u.pm * BM * lda * 2; u.ob = (size_t)u.pn * BM * ldb * 2; return true;
    }
};

template <class Epi, class Sched, bool FP8 = false, int SCA = 0x7F7F7F7F, int SCB = 0x7F7F7F7F>
__device__ __forceinline__ void gemm_phase(PG8_LAS unsigned char* lds, const Gemm g, const Sched& S, const Epi& E, const int tid) {
    const int wid = __builtin_amdgcn_readfirstlane(tid >> 6), lane = tid & 63, wr = wid >> 2, wc = wid & 3, fr = lane & 15, fq = lane >> 4;
    const int K = g.K, nt = K / BK;
    unsigned voffA[2], voffB[2];
#pragma unroll
    for (int i = 0; i < 2; ++i) { int R, C; stage_rc(tid * 16 + i * 8192, R, C); const int Rb = Epi::PERM ? ((R & ~31) + perm32(R & 31)) : R;
        voffA[i] = (unsigned)(R * g.lda + C) * 2u; voffB[i] = (unsigned)(Rb * g.ldb + C) * 2u; }
    const size_t kstep = (size_t)(BK * 2);
    const size_t hstepA = (size_t)HALF * g.lda * 2, hstepB = (size_t)HALF * g.ldb * 2;
    const unsigned ldsw = (unsigned)wid * 1024u;
    const int aoff = lds_byte(wr * 64 + fr, fq * 8), boff = lds_byte(wc * 32 + fr, fq * 8);
#define PG8_SA(b, h) (((b) * 2 + (h)) * HTB)
#define PG8_SB(b, h) ((4 + (b) * 2 + (h)) * HTB)
#define PG8_STAGE(bufoff, gbase, voff) do { _Pragma("unroll") for (int _i = 0; _i < 2; ++_i) \
        __builtin_amdgcn_global_load_lds((const unsigned*)((const char*)(gbase) + (voff)[_i]), (PG8_LAS unsigned*)(lds + (bufoff) + ldsw + _i * 8192), 16, 0, 0); } while (0)
#define PG8_LDA(dst, b, h) do { _Pragma("unroll") for (int m = 0; m < 4; ++m) { const v4i32 x_ = *(const PG8_LAS v4i32*)(lds + PG8_SA(b, h) + aoff + m * 2048), y_ = *(const PG8_LAS v4i32*)(lds + PG8_SA(b, h) + aoff + m * 2048 + 1024); dst[m] = __builtin_shufflevector(x_, y_, 0, 1, 2, 3, 4, 5, 6, 7); } } while (0)
#define PG8_LDB(dst, b, h) do { _Pragma("unroll") for (int n = 0; n < 2; ++n) { const v4i32 x_ = *(const PG8_LAS v4i32*)(lds + PG8_SB(b, h) + boff + n * 2048), y_ = *(const PG8_LAS v4i32*)(lds + PG8_SB(b, h) + boff + n * 2048 + 1024); dst[n] = __builtin_shufflevector(x_, y_, 0, 1, 2, 3, 4, 5, 6, 7); } } while (0)
#define PG8_MMA(ai, bj, At, Bt) do { __builtin_amdgcn_s_setprio(1); _Pragma("unroll") for (int m = 0; m < 4; ++m) _Pragma("unroll") for (int n = 0; n < 2; ++n) { \
        if constexpr (FP8) { asm volatile("v_mfma_scale_f32_16x16x128_f8f6f4 %0, %1, %2, %0, %3, %4 op_sel_hi:[0,0,0]" : "+v"(acc[ai][bj][m][n]) : "v"(Bt[n]), "v"(At[m]), "v"(sca_), "v"(scb_)); } \
        else { _Pragma("unroll") for (int k = 0; k < 2; ++k) acc[ai][bj][m][n] = __builtin_amdgcn_mfma_f32_16x16x32_bf16(half8(Bt[n], k), half8(At[m], k), acc[ai][bj][m][n], 0, 0, 0); } } \
        __builtin_amdgcn_s_setprio(0); } while (0)
#define PG8_WAIT_V(n) asm volatile("s_waitcnt vmcnt(" #n ")" ::: "memory")
#define PG8_WAIT_L(n) asm volatile("s_waitcnt lgkmcnt(" #n ")" ::: "memory")
#define PG8_BAR __builtin_amdgcn_s_barrier()
#define PG8_SCHED __builtin_amdgcn_sched_barrier(0)
    Unit cur, nxt; int ui = 0;
    if (!S.next(0, cur)) return;
    int sca_ = SCA, scb_ = SCB; if constexpr (FP8) asm volatile("" : "+v"(sca_), "+v"(scb_));
    f32x4 acc[2][2][4][2];
#pragma unroll
    for (int a = 0; a < 2; ++a)
#pragma unroll
        for (int b = 0; b < 2; ++b)
#pragma unroll
            for (int m = 0; m < 4; ++m)
#pragma unroll
                for (int n = 0; n < 2; ++n) acc[a][b][m][n] = (f32x4){0.f, 0.f, 0.f, 0.f};
    v8i32 At[4], B0[2], B1[2];
    const char* cA = (const char*)g.A + cur.oa; const char* cB = (const char*)g.Bt + cur.ob;
    PG8_STAGE(PG8_SB(0, 0), cB, voffB); PG8_STAGE(PG8_SB(0, 1), cB + hstepB, voffB); PG8_STAGE(PG8_SA(0, 0), cA, voffA); PG8_STAGE(PG8_SA(0, 1), cA + hstepA, voffA);
    if (wr == 1) PG8_BAR;
    PG8_WAIT_V(2); PG8_BAR;
    PG8_STAGE(PG8_SB(1, 0), cB + kstep, voffB); PG8_STAGE(PG8_SA(1, 0), cA + kstep, voffA); PG8_STAGE(PG8_SB(1, 1), cB + hstepB + kstep, voffB);
    PG8_WAIT_V(6); PG8_BAR;
    for (;;) {
        const bool has_next = S.next(ui + 1, nxt);
        const char* nA = has_next ? (const char*)g.A + nxt.oa : cA; const char* nB = has_next ? (const char*)g.Bt + nxt.ob : cB;
#pragma nounroll
        for (int t = 0; t < nt; t += 2) {
            const bool last = (t == nt - 2);
            const char* a1 = cA + (size_t)(t + 1) * kstep;
            const char* a2 = last ? nA : cA + (size_t)(t + 2) * kstep; const char* b2 = last ? nB : cB + (size_t)(t + 2) * kstep;
            const char* a3 = a2 + kstep; const char* b3 = b2 + kstep;
            PG8_LDB(B0, 0, 0); PG8_LDB(B1, 0, 1); PG8_SCHED; PG8_LDA(At, 0, 0); PG8_STAGE(PG8_SA(1, 1), a1 + hstepA, voffA);
            PG8_WAIT_V(8); PG8_WAIT_L(0); PG8_BAR; PG8_MMA(0, 0, At, B0); PG8_MMA(0, 1, At, B1); PG8_BAR; PG8_SCHED;
            PG8_LDA(At, 0, 1); PG8_STAGE(PG8_SB(0, 0), b2, voffB); PG8_STAGE(PG8_SB(0, 1), b2 + hstepB, voffB); PG8_STAGE(PG8_SA(0, 0), a2, voffA);
            PG8_WAIT_V(8); PG8_WAIT_L(0); PG8_BAR; PG8_MMA(1, 0, At, B0); PG8_MMA(1, 1, At, B1); PG8_BAR; PG8_SCHED;
            PG8_LDB(B0, 1, 0); PG8_LDB(B1, 1, 1); PG8_SCHED; PG8_LDA(At, 1, 0); PG8_STAGE(PG8_SA(0, 1), a2 + hstepA, voffA);
            PG8_WAIT_V(8); PG8_WAIT_L(0); PG8_BAR; PG8_MMA(0, 0, At, B0); PG8_MMA(0, 1, At, B1); PG8_BAR; PG8_SCHED;
            PG8_LDA(At, 1, 1); PG8_STAGE(PG8_SB(1, 0), b3, voffB); PG8_STAGE(PG8_SB(1, 1), b3 + hstepB, voffB); PG8_STAGE(PG8_SA(1, 0), a3, voffA);
            PG8_WAIT_V(8); PG8_WAIT_L(0); PG8_BAR; PG8_MMA(1, 0, At, B0); PG8_MMA(1, 1, At, B1); PG8_BAR; PG8_SCHED;
        }
        if (wr == 0) PG8_BAR;
        { int l_ = threadIdx.x; asm volatile("" : "+v"(l_)); const int fr_ = l_ & 15, fq_ = (l_ >> 4) & 3; E(acc, cur, wr, wc, fr_, fq_); }
        if (!has_next) break;
#pragma unroll
        for (int a = 0; a < 2; ++a)
#pragma unroll
            for (int b = 0; b < 2; ++b)
#pragma unroll
                for (int m = 0; m < 4; ++m)
#pragma unroll
                    for (int n = 0; n < 2; ++n) acc[a][b][m][n] = (f32x4){0.f, 0.f, 0.f, 0.f};
        cur = nxt; cA = nA; cB = nB; ++ui;
        if (wr == 1) PG8_BAR;
    }
    PG8_WAIT_V(0);
    PG8_BAR;
#undef PG8_SA
#undef PG8_SB
#undef PG8_STAGE
#undef PG8_LDA
#undef PG8_LDB
#undef PG8_MMA
#undef PG8_WAIT_V
#undef PG8_WAIT_L
#undef PG8_BAR
#undef PG8_SCHED
}

typedef f32x4 Acc[2][2][4][2];

__device__ __forceinline__ void load_rstd(const float* ssq, int row0, int fq, float (&rs)[2][4]) {
#pragma unroll
    for (int ai = 0; ai < 2; ++ai)
#pragma unroll
        for (int m = 0; m < 4; ++m) {
            const float* p = ssq + (size_t)(fq * 4) * MTOK + row0 + ai * HALF + m * 16;
            float s = (p[0] + p[MTOK]) + (p[2 * MTOK] + p[3 * MTOK]);
            s += __shfl_xor(s, 16); s += __shfl_xor(s, 32);
            rs[ai][m] = rsqrtf(s * (1.f / DM) + NORM_EPS);
        }
}
__device__ __forceinline__ float row_rstd(const float* ssq, int row, int fq) {
    const float* p = ssq + (size_t)(fq * 4) * MTOK + row;
    float s = (p[0] + p[MTOK]) + (p[2 * MTOK] + p[3 * MTOK]);
    s += __shfl_xor(s, 16); s += __shfl_xor(s, 32);
    return rsqrtf(s * (1.f / DM) + NORM_EPS);
}
__device__ __forceinline__ u32x4 pack8(const f32x4& a, const f32x4& b) { u32x4 w; w.x = pk2(a[0], a[1]); w.y = pk2(a[2], a[3]); w.z = pk2(b[0], b[1]); w.w = pk2(b[2], b[3]); return w; }
__device__ __forceinline__ void rope8(f32x4& v0, f32x4& v1, const float* cs, int fq) {
    const f32x4 c0 = *(const f32x4*)(cs), c1 = *(const f32x4*)(cs + 4), s0 = *(const f32x4*)(cs + 8), s1 = *(const f32x4*)(cs + 12);
    f32x4 p0, p1;
#pragma unroll
    for (int e = 0; e < 4; ++e) { p0[e] = __shfl_xor(v0[e], 16); p1[e] = __shfl_xor(v1[e], 16); }
    if (fq == 0) { v0 = v0 * c0 - p0 * s0; v1 = v1 * c1 - p1 * s1; }
    else if (fq == 1) { v0 = p0 * s0 + v0 * c0; v1 = p1 * s1 + v1 * c1; }
}

struct EpiInAB {
    static constexpr bool PERM = true;
    const float* ssq; const float* cs; unsigned char* ra; float* kpart;
    __device__ __forceinline__ void operator()(const Acc& acc, const Unit& u, int wr, int wc, int fr, int fq) const {
        const int row0 = u.pm * BM + wr * 64 + fr;
        float rs[2][4]; load_rstd(ssq, row0, fq, rs);
        if (u.pn == 0) {
#pragma unroll
            for (int ai = 0; ai < 2; ++ai)
#pragma unroll
                for (int m = 0; m < 4; ++m) { const int row = row0 + ai * HALF + m * 16; float* rp = (float*)(ra + RA_UPOOL) + (size_t)row * 256 + wc * 32 + fq * 8;
#pragma unroll
                    for (int bj = 0; bj < 2; ++bj) { *(f32x4*)(rp + bj * HALF) = acc[ai][bj][m][0] * rs[ai][m]; *(f32x4*)(rp + bj * HALF + 4) = acc[ai][bj][m][1] * rs[ai][m]; } }
        } else {
            const int t = (u.pn - 1) / 3, cb = ((u.pn - 1) % 3) * 256;
            bf16* dst = (bf16*)(ra + RA_QB + (size_t)t * (RA_KB - RA_QB));
            const bool rope = (t < 2) && ((wc & 1) == 0);
#pragma unroll
            for (int ai = 0; ai < 2; ++ai)
#pragma unroll
                for (int m = 0; m < 4; ++m) { const int row = row0 + ai * HALF + m * 16; bf16* rp = dst + (size_t)row * MOBA_DIMC + cb + wc * 32 + fq * 8;
                    const float* csr = cs + (size_t)(row & (SEQ - 1)) * 16;
#pragma unroll
                    for (int bj = 0; bj < 2; ++bj) { f32x4 v0 = acc[ai][bj][m][0] * rs[ai][m], v1 = acc[ai][bj][m][1] * rs[ai][m];
                        if (rope) rope8(v0, v1, csr, fq);
                        *(u32x4*)(rp + bj * HALF) = pack8(v0, v1); } }
            if (t == 1) {
                asm volatile("s_waitcnt vmcnt(0)" ::: "memory");
                const int lane_ = fq * 16 + fr, cl = cb + (lane_ >> 5) * HALF + wc * 32 + (lane_ & 31);
                const bf16* kp = dst + (size_t)(u.pm * BM + wr * 64) * MOBA_DIMC + cl; float sum = 0.f;
#pragma unroll 1
                for (int ai = 0; ai < 2; ++ai)
#pragma unroll 16
                    for (int rr = 0; rr < 64; ++rr) sum += bf2f(kp[(size_t)(ai * HALF + rr) * MOBA_DIMC]);
                kpart[(size_t)(u.pm * 2 + wr) * MOBA_DIMC + cl] = sum;
            }
        }
    }
};

struct EpiInC {
    static constexpr bool PERM = true;
    const float* ssq; const float* cs; unsigned char* ra; const float* pek; const float* pev;
    __device__ __forceinline__ void operator()(const Acc& acc, const Unit& u, int wr, int wc, int fr, int fq) const {
        const int row0 = u.pm * BM + wr * 64 + fr;
        const int pn = u.pn;
        const bool rope = ((wc & 1) == 0);
        if (pn < 4) {
#pragma unroll
            for (int ai = 0; ai < 2; ++ai)
#pragma unroll
                for (int m = 0; m < 4; ++m) { const int row = row0 + ai * HALF + m * 16; const float rsv = row_rstd(ssq, row, fq); const size_t off = (size_t)row * DM + pn * 256 + wc * 32 + fq * 8;
                    const float* csr = cs + (size_t)(row & (SEQ - 1)) * 16;
#pragma unroll
                    for (int bj = 0; bj < 2; ++bj) { f32x4 v0 = acc[ai][bj][m][0] * rsv, v1 = acc[ai][bj][m][1] * rsv;
                        *(u32x4*)((bf16*)(ra + RA_QRAW) + off + bj * HALF) = pack8(v0, v1);
                        if (rope) rope8(v0, v1, csr, fq);
                        *(u32x4*)((bf16*)(ra + RA_QROT) + off + bj * HALF) = pack8(v0, v1); } }
        } else if (pn < 6) {
            bf16* ac = (bf16*)(ra + RA_ACMPK + (size_t)(pn - 4) * (RA_ACMPV - RA_ACMPK)); const float* pe = pek + (ptrdiff_t)(pn - 4) * (pev - pek);
#pragma unroll
            for (int ai = 0; ai < 2; ++ai)
#pragma unroll
                for (int m = 0; m < 4; ++m) { const int row = row0 + ai * HALF + m * 16; const float rsv = row_rstd(ssq, row, fq); const int b = row >> 11, t = row & (SEQ - 1);
#pragma unroll
                    for (int bj = 0; bj < 2; ++bj) { const int c = bj * HALF + wc * 32 + fq * 8, gi = c >> 6, d = c & 63;
                        const f32x4 v0 = acc[ai][bj][m][0] * rsv, v1 = acc[ai][bj][m][1] * rsv;
                        const int n1 = t >> 4, l1 = t & 15;
                        if (n1 <= 126) { const float* pp = pe + l1 * 64 + d; const f32x4 a0 = v0 + *(const f32x4*)pp, a1 = v1 + *(const f32x4*)(pp + 4);
                            *(u32x4*)(ac + ((size_t)((b * 4 + gi) * 128 + n1)) * 2048 + l1 * 64 + d) = pack8(a0, a1); }
                        const int n2 = n1 - 1, l2 = l1 + 16;
                        if (n2 >= 0) { const float* pp = pe + l2 * 64 + d; const f32x4 a0 = v0 + *(const f32x4*)pp, a1 = v1 + *(const f32x4*)(pp + 4);
                            *(u32x4*)(ac + ((size_t)((b * 4 + gi) * 128 + n2)) * 2048 + l2 * 64 + d) = pack8(a0, a1); } } }
        } else if (pn < 10) {
            bf16* dst = (bf16*)(ra + RA_KS + (size_t)(pn - 6) * (RA_VS - RA_KS));
            const bool rp_ = rope && ((pn & 1) == 0);
#pragma unroll
            for (int ai = 0; ai < 2; ++ai)
#pragma unroll
                for (int m = 0; m < 4; ++m) { const int row = row0 + ai * HALF + m * 16; const float rsv = row_rstd(ssq, row, fq); bf16* rp = dst + (size_t)row * 256 + wc * 32 + fq * 8;
                    const float* csr = cs + (size_t)(row & (SEQ - 1)) * 16;
#pragma unroll
                    for (int bj = 0; bj < 2; ++bj) { f32x4 v0 = acc[ai][bj][m][0] * rsv, v1 = acc[ai][bj][m][1] * rsv;
                        if (rp_) rope8(v0, v1, csr, fq);
                        *(u32x4*)(rp + bj * HALF) = pack8(v0, v1); } }
        } else {
            const int c = wc * 32 + fq * 8;
#pragma unroll
            for (int ai = 0; ai < 2; ++ai)
#pragma unroll
                for (int m = 0; m < 4; ++m) { const int row = row0 + ai * HALF + m * 16; const float rsv = row_rstd(ssq, row, fq); float* gp = (float*)(ra + RA_GATES) + (size_t)row * 48 + c;
                    f32x4 v0 = acc[ai][0][m][0] * rsv, v1 = acc[ai][0][m][1] * rsv;
#pragma unroll
                    for (int e = 0; e < 4; ++e) { v0[e] = sigmoid_f(v0[e]); v1[e] = sigmoid_f(v1[e]); }
                    if (c < 48) { *(f32x4*)gp = v0; *(f32x4*)(gp + 4) = v1; } }
        }
    }
};

struct EpiRes {
    static constexpr bool PERM = true;
    bf16* xb; float* ssq;
    __device__ __forceinline__ void operator()(const Acc& acc, const Unit& u, int wr, int wc, int fr, int fq) const {
        const int row0 = u.pm * BM + wr * 64 + fr;
#pragma unroll
        for (int ai = 0; ai < 2; ++ai)
#pragma unroll
            for (int m = 0; m < 4; ++m) { const int row = row0 + ai * HALF + m * 16; const size_t off = (size_t)row * DM + u.pn * 256 + wc * 32 + fq * 8; float ss = 0.f;
#pragma unroll
                for (int bj = 0; bj < 2; ++bj) { bf16* xp = xb + off + bj * HALF; const u32x4 o = *(const u32x4*)xp;
                    const f32x4 x0 = {__builtin_bit_cast(float, o.x << 16), __builtin_bit_cast(float, o.x & 0xffff0000u), __builtin_bit_cast(float, o.y << 16), __builtin_bit_cast(float, o.y & 0xffff0000u)};
                    const f32x4 x1 = {__builtin_bit_cast(float, o.z << 16), __builtin_bit_cast(float, o.z & 0xffff0000u), __builtin_bit_cast(float, o.w << 16), __builtin_bit_cast(float, o.w & 0xffff0000u)};
                    const f32x4 v0 = x0 + acc[ai][bj][m][0], v1 = x1 + acc[ai][bj][m][1];
                    *(u32x4*)xp = pack8(v0, v1);
                    ss += (v0[0] * v0[0] + v0[1] * v0[1]) + (v0[2] * v0[2] + v0[3] * v0[3]) + (v1[0] * v1[0] + v1[1] * v1[1]) + (v1[2] * v1[2] + v1[3] * v1[3]); }
                ss += __shfl_xor(ss, 16); ss += __shfl_xor(ss, 32);
                if (fq == 0) ssq[(size_t)(u.pn * 4 + wc) * MTOK + row] = ss; }
    }
};

struct EpiXQ {
    static constexpr bool PERM = true;
    const float* ssq; bf16* o;
    __device__ __forceinline__ void operator()(const Acc& acc, const Unit& u, int wr, int wc, int fr, int fq) const {
        const int row0 = u.pm * BM + wr * 64 + fr;
        float rs[2][4]; load_rstd(ssq, row0, fq, rs);
#pragma unroll
        for (int ai = 0; ai < 2; ++ai)
#pragma unroll
            for (int m = 0; m < 4; ++m) { const int row = row0 + ai * HALF + m * 16; bf16* rp = o + (size_t)row * 256 + wc * 32 + fq * 8;
#pragma unroll
                for (int bj = 0; bj < 2; ++bj) *(u32x4*)(rp + bj * HALF) = pack8(acc[ai][bj][m][0] * rs[ai][m], acc[ai][bj][m][1] * rs[ai][m]); }
    }
};

struct EpiXKV {
    static constexpr bool PERM = true;
    bf16* xk; bf16* xv;
    __device__ __forceinline__ void operator()(const Acc& acc, const Unit& u, int wr, int wc, int fr, int fq) const {
        const int row0 = u.pm * BM + wr * 64 + fr;
        bf16* dst = xk + (size_t)(u.pn & 1) * (size_t)(xv - xk) + (size_t)(u.pn >> 1) * (NB * MEML * 256);
#pragma unroll
        for (int ai = 0; ai < 2; ++ai)
#pragma unroll
            for (int m = 0; m < 4; ++m) { const int row = row0 + ai * HALF + m * 16; bf16* rp = dst + (size_t)row * 256 + wc * 32 + fq * 8;
#pragma unroll
                for (int bj = 0; bj < 2; ++bj) *(u32x4*)(rp + bj * HALF) = pack8(acc[ai][bj][m][0], acc[ai][bj][m][1]); }
    }
};

template <bool MOE> struct EpiGateUp {
    static constexpr bool PERM = true;
    const float* ssq; bf16* h; int ldh;
    __device__ __forceinline__ void operator()(const Acc& acc, const Unit& u, int wr, int wc, int fr, int fq) const {
        const int row0 = u.pm * BM + wr * 64 + fr;
#pragma unroll
        for (int ai = 0; ai < 2; ++ai)
#pragma unroll
            for (int m = 0; m < 4; ++m) { const int row = row0 + ai * HALF + m * 16; float r = 1.f; if constexpr (!MOE) r = row_rstd(ssq, row, fq);
                f32x4 o0, o1;
#pragma unroll
                for (int e = 0; e < 4; ++e) { o0[e] = silu_f(acc[ai][0][m][0][e] * r) * (acc[ai][1][m][0][e] * r); o1[e] = silu_f(acc[ai][0][m][1][e] * r) * (acc[ai][1][m][1][e] * r); }
                if constexpr (MOE) { u32x2 w; w.x = pk4_fp8(o0[0] * FP8_SH, o0[1] * FP8_SH, o0[2] * FP8_SH, o0[3] * FP8_SH); w.y = pk4_fp8(o1[0] * FP8_SH, o1[1] * FP8_SH, o1[2] * FP8_SH, o1[3] * FP8_SH);
                    *(u32x2*)((unsigned char*)h + (size_t)row * ldh + u.pn * 128 + wc * 32 + fq * 8) = w; }
                else *(u32x4*)(h + (size_t)row * ldh + u.pn * 128 + wc * 32 + fq * 8) = pack8(o0, o1); }
    }
};

struct EpiMoeDown {
    static constexpr bool PERM = true;
    const int* rowtok; const float* roww; bf16* ymoe;
    __device__ __forceinline__ void operator()(const Acc& acc, const Unit& u, int wr, int wc, int fr, int fq) const {
        const int row0 = u.pm * BM + wr * 64 + fr;
#pragma unroll
        for (int ai = 0; ai < 2; ++ai)
#pragma unroll
            for (int m = 0; m < 4; ++m) { const int row = row0 + ai * HALF + m * 16; const int tk = rowtok[row];
                if (tk >= 0) { const float w = roww[row]; bf16* yp = ymoe + ((size_t)(tk & 1) * MTOK + (tk >> 1)) * DM + u.pn * 256 + wc * 32 + fq * 8;
#pragma unroll
                    for (int bj = 0; bj < 2; ++bj) *(u32x4*)(yp + bj * HALF) = pack8(acc[ai][bj][m][0] * w, acc[ai][bj][m][1] * w); } }
    }
};

struct EpiCmpPart {
    static constexpr bool PERM = true;
    float* cpart;
    __device__ __forceinline__ void operator()(const Acc& acc, const Unit& u, int wr, int wc, int fr, int fq) const {
        const int row0 = u.pm * BM + wr * 64 + fr;
        float* base = cpart + (size_t)u.aux * 4096 * 256;
#pragma unroll
        for (int ai = 0; ai < 2; ++ai)
#pragma unroll
            for (int m = 0; m < 4; ++m) { const int row = row0 + ai * HALF + m * 16; float* rp = base + (size_t)row * 256 + wc * 32 + fq * 8;
#pragma unroll
                for (int bj = 0; bj < 2; ++bj) { *(f32x4*)(rp + bj * HALF) = acc[ai][bj][m][0]; *(f32x4*)(rp + bj * HALF + 4) = acc[ai][bj][m][1]; } }
    }
};

struct CmpOrder {
    int G, c;
    __device__ bool next(int i, Unit& u) const {
        const long L = (long)i * G + c; if (L >= 2 * CMP_SPLIT * 16) return false;
        const int t = (int)L / (CMP_SPLIT * 16), s = ((int)L / 16) % CMP_SPLIT, pm = (int)L % 16;
        u.pm = pm; u.pn = 0; u.aux = t * CMP_SPLIT + s;
        u.oa = ((size_t)(t * 4096 + pm * 256) * 2048 + s * 256) * 2; u.ob = ((size_t)(t * 256) * 2048 + s * 256) * 2; return true;
    }
};
struct MoeOrder {
    const int* tile_e; int nN, G, c, lda, ldb, nper;
    __device__ bool next(int i, Unit& u) const {
        const int nt = __builtin_amdgcn_readfirstlane(tile_e[MOE_MAX_TILES]);
        const long L = (long)i * G + c; if (L >= (long)nt * nN) return false;
        const int pm = (int)(L / nN), pn = (int)(L % nN), e = __builtin_amdgcn_readfirstlane(tile_e[pm]);
        u.pm = pm; u.pn = pn; u.aux = e; u.oa = (size_t)pm * BM * lda * 2; u.ob = ((size_t)e * nper + (size_t)pn * BM) * ldb * 2; return true;
    }
};
}

namespace att {
constexpr int KP = 128, TILE_B = 64 * KP;
constexpr int NSLOT = 4;
constexpr int KV_BYTES = 2 * NSLOT * TILE_B;
#define MFMA32(a, b, c) __builtin_amdgcn_mfma_f32_32x32x16_bf16((a), (b), (c), 0, 0, 0)
typedef short v4i16_t __attribute__((ext_vector_type(4)));
__device__ __forceinline__ void glds16(const void* gsrc, unsigned lds_dst) { unsigned keep;
    asm volatile("s_mov_b32 %0, m0\n\ts_mov_b32 m0, %2\n\ts_nop 0\n\tglobal_load_lds_dwordx4 %1, off\n\ts_mov_b32 m0, %0" : "=&s"(keep) : "v"(gsrc), "s"(lds_dst) : "memory"); }
__device__ __forceinline__ s16x4 vtr(const LAS unsigned char* p) { return __builtin_bit_cast(s16x4, __builtin_amdgcn_ds_read_tr16_b64_v4i16((LAS v4i16_t*)p)); }
__device__ __forceinline__ bf16x8 packp(const f32x16& x, int s) {
    u32x4 p; p.x = pk2(x[8 * s], x[8 * s + 1]); p.y = pk2(x[8 * s + 2], x[8 * s + 3]); p.z = pk2(x[8 * s + 4], x[8 * s + 5]); p.w = pk2(x[8 * s + 6], x[8 * s + 7]);
    return __builtin_bit_cast(bf16x8, p);
}
__device__ __forceinline__ short ov_bits(int n, int j) {
    const int jn = n >> 2, q = n & 3;
    if (q < 3) return (jn == j) ? (short)0x3F80 : (short)0;
    return (jn == j || jn + 1 == j) ? (short)0x3F00 : (short)0;
}

__device__ __forceinline__ float max3f(float a, float b, float c) { float r; asm("v_max3_f32 %0, %1, %2, %3" : "=v"(r) : "v"(a), "v"(b), "v"(c)); return r; }
__device__ __forceinline__ float max2f(float a, float b) { float r; asm("v_max_f32_e32 %0, %1, %2" : "=v"(r) : "v"(a), "v"(b)); return r; }
__device__ __forceinline__ float max2f_after_mfma(float a, float b) { float r; asm volatile("s_nop 15\n\ts_nop 7\n\tv_max_f32_e32 %0, %1, %2" : "=v"(r) : "v"(a), "v"(b)); return r; }
struct State { f32x16 o0, o1, o2; float m, l; };
__device__ __forceinline__ void reset(State& s) {
#pragma unroll
    for (int i = 0; i < 16; ++i) { s.o0[i] = 0.f; s.o1[i] = 0.f; s.o2[i] = 0.f; }
    s.m = -1e30f; s.l = 0.f;
}

template <class MK, bool OV>
__device__ __forceinline__ void flash_run(LAS unsigned char* kv, const bf16* Kg, const bf16* Vg, int ld, int jlo, int jhi, const bf16x8 (&qf)[4], State& st, const MK& mk, const int tid) {
    const int lane = tid & 63, r = lane & 31, h = lane >> 5, blk16 = (lane >> 4) & 1, q4 = (lane & 15) >> 2, p4 = lane & 3;
    const int wv = __builtin_amdgcn_readfirstlane(tid >> 6);
    const int skey = tid >> 3, sch = (tid & 7) ^ (skey & 7);
    const size_t goff = ((size_t)skey * ld + sch * 8) * 2;
    const unsigned kvb = (unsigned)(__UINTPTR_TYPE__)kv + (unsigned)wv * 1024u;
#define FL_DMA(jt, slot) do { const size_t tb_ = (size_t)(64 * (jt)) * ld * 2 + goff; \
        glds16((const char*)Kg + tb_, (unsigned)__builtin_amdgcn_readfirstlane(kvb + (unsigned)(slot) * TILE_B)); \
        glds16((const char*)Vg + tb_, (unsigned)__builtin_amdgcn_readfirstlane(kvb + (unsigned)(NSLOT + (slot)) * TILE_B)); } while (0)
#define FL_NEXT(x) do { ++(x); while ((x) < jhi && !mk.active(x)) ++(x); } while (0)
    int j = jlo; while (j < jhi && !mk.active(j)) ++j;
    if (j >= jhi) return;
    int jp = j, np = 0, nc = 0;
#pragma unroll
    for (int k = 0; k < NSLOT - 1; ++k) if (jp < jhi) { FL_DMA(jp, np & (NSLOT - 1)); ++np; FL_NEXT(jp); }
    bf16x8 q0 = qf[0], q1 = qf[1], q2 = qf[2], q3 = qf[3]; asm volatile("" : "+v"(q0), "+v"(q1), "+v"(q2), "+v"(q3));
    const int sw = r & 7;
    unsigned kro[4];
#pragma unroll
    for (int ks = 0; ks < 4; ++ks) kro[ks] = (unsigned)(r * KP + (((2 * ks + h) ^ sw) << 4));
    const int vsw = 4 * h + q4;
    const unsigned vro0 = (unsigned)(vsw * KP + (((2 * blk16 + (p4 >> 1)) ^ vsw) << 4) + 8 * (p4 & 1));
    const unsigned vro1 = (unsigned)(vsw * KP + (((4 + 2 * blk16 + (p4 >> 1)) ^ vsw) << 4) + 8 * (p4 & 1));
#pragma nounroll
    for (;;) {
        { const int younger = np - nc - 1;
          if (younger >= 2) asm volatile("s_waitcnt vmcnt(4)" ::: "memory"); else if (younger == 1) asm volatile("s_waitcnt vmcnt(2)" ::: "memory"); else asm volatile("s_waitcnt vmcnt(0)" ::: "memory"); }
        __syncthreads();
        if (jp < jhi) { FL_DMA(jp, np & (NSLOT - 1)); ++np; FL_NEXT(jp); }
        const int cur = nc & (NSLOT - 1);
        const int kind = mk.kind(j);
        if (kind != 0) {
            const LAS unsigned char* Kb = kv + cur * TILE_B; const LAS unsigned char* Vb = kv + (NSLOT + cur) * TILE_B;
            f32x16 s0, s1;
#pragma unroll
            for (int i = 0; i < 16; ++i) { s0[i] = 0.f; s1[i] = 0.f; }
#pragma unroll
            for (int ks = 0; ks < 4; ++ks) {
                const bf16x8 k0 = *(const LAS bf16x8*)(Kb + kro[ks]), k1 = *(const LAS bf16x8*)(Kb + kro[ks] + 32 * KP);
                const bf16x8 qk = ks == 0 ? q0 : (ks == 1 ? q1 : (ks == 2 ? q2 : q3));
                s0 = MFMA32(k0, qk, s0); s1 = MFMA32(k1, qk, s1);
            }
            if (kind == 2) {
#pragma unroll
                for (int i = 0; i < 16; ++i) { const int kk = (i & 3) + 8 * (i >> 2) + 4 * h; if (!mk.ok(j, kk)) s0[i] = -INFINITY; if (!mk.ok(j, kk + 32)) s1[i] = -INFINITY; }
            }
            float mx = max2f_after_mfma(s0[0], s1[0]);
#pragma unroll
            for (int i = 1; i < 16; ++i) mx = max3f(mx, s0[i], s1[i]);
            const bool lok = (kind != 3) || mk.lane_ok(j);
            if (!lok) mx = -INFINITY;
            mx = fmaxf(mx, __shfl_xor(mx, 32));
            const float mn = fmaxf(st.m, mx * C2);
            if (!__all(mn - st.m <= 8.f)) {
                const float alpha = fast_exp2(st.m - mn); st.m = mn;
                st.l = st.l * alpha; st.o0 = st.o0 * alpha; st.o1 = st.o1 * alpha; if (OV) st.o2 = st.o2 * alpha;
            }
            const float nm = lok ? -st.m : -INFINITY;
            float ps = 0.f;
#pragma unroll
            for (int i = 0; i < 16; ++i) { s0[i] = fast_exp2(__builtin_fmaf(s0[i], C2, nm)); s1[i] = fast_exp2(__builtin_fmaf(s1[i], C2, nm)); ps += s0[i] + s1[i]; }
            ps += __shfl_xor(ps, 32);
            st.l += ps;
#pragma unroll
            for (int hf = 0; hf < 2; ++hf)
#pragma unroll
                for (int s = 0; s < 2; ++s) {
                    const bf16x8 pf = packp(hf ? s1 : s0, s);
                    const LAS unsigned char* vb = Vb + (32 * hf + 16 * s) * KP;
                    const s16x4 l0 = vtr(vb + vro0), h0 = vtr(vb + vro0 + 8 * KP), l1 = vtr(vb + vro1), h1 = vtr(vb + vro1 + 8 * KP);
                    st.o0 = MFMA32(__builtin_shufflevector(l0, h0, 0, 1, 2, 3, 4, 5, 6, 7), pf, st.o0);
                    st.o1 = MFMA32(__builtin_shufflevector(l1, h1, 0, 1, 2, 3, 4, 5, 6, 7), pf, st.o1);
                    if (OV) {
                        int r_ = r; asm volatile("" : "+v"(r_));
                        const int jnA = 16 * j + 8 * hf + 4 * s + h - r_, jnB = jnA + 2;
                        u32x4 a;
                        a.x = (jnA == 0) ? 0x3F803F80u : 0u; a.y = ((jnA == 0) ? 0x00003F80u : 0u) | ((jnA == 0 || jnA == -1) ? 0x3F000000u : 0u);
                        a.z = (jnB == 0) ? 0x3F803F80u : 0u; a.w = ((jnB == 0) ? 0x00003F80u : 0u) | ((jnB == 0 || jnB == -1) ? 0x3F000000u : 0u);
                        st.o2 = MFMA32(__builtin_bit_cast(bf16x8, a), pf, st.o2); }
                }
        }
        ++nc; FL_NEXT(j);
        if (j >= jhi) break;
    }
    __syncthreads();
#undef FL_NEXT
#undef FL_DMA
}

__device__ __forceinline__ void load_q(bf16x8 (&qf)[4], const bf16* qrow, int h) {
#pragma unroll
    for (int ks = 0; ks < 4; ++ks) qf[ks] = *(const bf16x8*)(qrow + ks * 16 + h * 8);
}
__device__ __forceinline__ void store_o(bf16* orow, const f32x16& o0, const f32x16& o1, float sc, int h) {
#pragma unroll
    for (int g = 0; g < 4; ++g) {
        u32x2 a, b; a.x = pk2(o0[4 * g] * sc, o0[4 * g + 1] * sc); a.y = pk2(o0[4 * g + 2] * sc, o0[4 * g + 3] * sc);
        b.x = pk2(o1[4 * g] * sc, o1[4 * g + 1] * sc); b.y = pk2(o1[4 * g + 2] * sc, o1[4 * g + 3] * sc);
        *(u32x2*)(orow + 8 * g + 4 * h) = a; *(u32x2*)(orow + 32 + 8 * g + 4 * h) = b;
    }
}

struct NoMask { __device__ __forceinline__ bool active(int) const { return true; } __device__ __forceinline__ int kind(int) const { return 1; } __device__ __forceinline__ bool ok(int, int) const { return true; } __device__ __forceinline__ bool lane_ok(int) const { return true; } };
struct MobaMask {
    int qb, wq0, tq; unsigned sel, uni;
    __device__ __forceinline__ bool active(int jt) const { const int jb = jt >> 2; return jb >= qb || ((uni >> jb) & 1u); }
    __device__ __forceinline__ int kind(int jt) const { const int jb = jt >> 2; if (jb < qb) { const bool s_ = (sel >> jb) & 1u; return __all(s_) ? 1 : (__any(s_) ? 3 : 0); } const int k0 = (jt & 3) * 64; if (k0 > wq0 + 31) return 0; if (k0 + 63 <= wq0) return 1; return 2; }
    __device__ __forceinline__ bool ok(int jt, int kk) const { return (jt & 3) * 64 + kk <= tq; }
    __device__ __forceinline__ bool lane_ok(int jt) const { return (sel >> (jt >> 2)) & 1u; }
};
struct CmpMask {
    int nmax, nlo, nhi;
    __device__ __forceinline__ bool active(int) const { return true; }
    __device__ __forceinline__ int kind(int j) const { if (64 * j > nhi) return 0; if (64 * j + 63 <= nlo) return 1; return 2; }
    __device__ __forceinline__ bool ok(int j, int kk) const { return 64 * j + kk <= nmax; }
    __device__ __forceinline__ bool lane_ok(int) const { return true; }
};
struct SelMask {
    int tb, tq, wq0; unsigned sel, uni;
    __device__ __forceinline__ bool active(int j) const { return (uni >> j) & 1u; }
    __device__ __forceinline__ int kind(int j) const { if (j == tb) return 2; const bool s_ = (sel >> j) & 1u; return __all(s_) ? 1 : (__any(s_) ? 3 : 0); }
    __device__ __forceinline__ bool ok(int j, int kk) const { return kk <= tq; }
    __device__ __forceinline__ bool lane_ok(int j) const { return (sel >> j) & 1u; }
};
struct WinMask {
    int tb, tq;
    __device__ __forceinline__ bool active(int) const { return true; }
    __device__ __forceinline__ int kind(int j) const { return (j == tb || j == tb - 8) ? 2 : 1; }
    __device__ __forceinline__ bool ok(int j, int kk) const { const int d = 64 * (tb - j) + tq - kk; return d >= 0 && d < 512; }
    __device__ __forceinline__ bool lane_ok(int) const { return true; }
};
}

#define XB_TMO      128
#define XB_XCNT(j)  (256  + 64 * (j))
#define XB_XSUB(j)  (1280 + 64 * (j))
#define XB_XGEN(j)  (2304 + 64 * (j))
#define XB_TOP      3328
#define XB_TOPGEN   3392
#define XCD_BAR_WORDS 3456
#define XB_SPIN_CAP (1u << 18)
__device__ __forceinline__ unsigned xb_ld(unsigned* p)              { return __hip_atomic_load(p, __ATOMIC_RELAXED, __HIP_MEMORY_SCOPE_AGENT); }
__device__ __forceinline__ unsigned xb_add(unsigned* p, unsigned v) { return __hip_atomic_fetch_add(p, v, __ATOMIC_RELAXED, __HIP_MEMORY_SCOPE_AGENT); }
__device__ __forceinline__ unsigned xb_xcc_id() { return (unsigned)__builtin_amdgcn_s_getreg((3 << 11) | 20) & 0xFu; }
#define XB_SPIN(cond, bar) do { unsigned _sp = 0; while (cond) { __builtin_amdgcn_s_sleep(1); \
    if ((++_sp & 255u) == 0u) { if (xb_ld(&(bar)[XB_TMO])) break; if (_sp > XB_SPIN_CAP) { atomicAdd(&(bar)[XB_TMO], 1u); break; } } } } while (0)
struct XcdBarrier { unsigned* bar; unsigned x; volatile LAS unsigned* st; };
__device__ __forceinline__ XcdBarrier xcd_barrier_post(unsigned* bar, volatile LAS unsigned* st) {
    XcdBarrier b; b.bar = bar; b.x = xb_xcc_id(); b.st = st;
    if (threadIdx.x == 0) (void)xb_add(&bar[XB_XCNT(b.x)], 1u);
    return b;
}
__device__ __forceinline__ void xcd_barrier_complete(unsigned* bar, unsigned x, unsigned& nloc, unsigned& nx) {
    const unsigned G = gridDim.x * gridDim.y * gridDim.z;
    unsigned sum, cnt, mine, sp = 0u;
    for (;;) {
        sum = 0u; cnt = 0u; mine = 0u;
#pragma unroll
        for (unsigned j = 0; j < 16; ++j) { const unsigned c = xb_ld(&bar[XB_XCNT(j)]); sum += c; cnt += (c > 0u) ? 1u : 0u; mine = (j == x) ? c : mine; }
        if (sum == G) break;
        __builtin_amdgcn_s_sleep(1);
        if ((++sp & 255u) == 0u) { if (xb_ld(&bar[XB_TMO])) break; if (sp > XB_SPIN_CAP) { atomicAdd(&bar[XB_TMO], 1u); break; } }
    }
    nloc = mine > 0u ? mine : 1u; nx = cnt > 0u ? cnt : 1u;
}
__device__ __forceinline__ void xcd_barrier(const XcdBarrier& b) {
    asm volatile("s_waitcnt vmcnt(0)" ::: "memory");
    __syncthreads();
    if (threadIdx.x == 0) {
        unsigned* bar = b.bar;
        __builtin_amdgcn_s_waitcnt(0);
        unsigned nloc = b.st[0], nx = b.st[1];
        if (nloc == 0u) { xcd_barrier_complete(bar, b.x, nloc, nx); b.st[0] = nloc; b.st[1] = nx; }
        const unsigned old = xb_add(&bar[XB_XSUB(b.x)], 1u);
        const unsigned gen = old / nloc;
        if (old + 1u == (gen + 1u) * nloc) {
            __builtin_amdgcn_fence(__ATOMIC_RELEASE, "agent");
            asm volatile("s_waitcnt vmcnt(0)" ::: "memory");
            const unsigned og = xb_add(&bar[XB_TOP], 1u);
            const unsigned tg = og / nx;
            if (og + 1u == (tg + 1u) * nx) xb_add(&bar[XB_TOPGEN], 1u);
            else XB_SPIN(xb_ld(&bar[XB_TOPGEN]) == tg, bar);
            __builtin_amdgcn_fence(__ATOMIC_ACQUIRE, "agent");
            xb_add(&bar[XB_XGEN(b.x)], 1u);
            asm volatile("s_waitcnt vmcnt(0)" ::: "memory");
        } else {
            XB_SPIN(xb_ld(&bar[XB_XGEN(b.x)]) == gen, bar);
            __builtin_amdgcn_fence(__ATOMIC_ACQUIRE, "agent");
            asm volatile("s_waitcnt vmcnt(0)" ::: "memory");
        }
    }
    __syncthreads();
}

struct ConvJob { const float* src; bf16* dst; const float* g; int K, N, nblk, mode, start; float scale; };

__device__ __forceinline__ void conv_load(const float* src, int N, int nblk, int item, int lane, float (&v)[64]) {
    const int kb = item / nblk, nb = item - kb * nblk, k0 = 64 * kb, n = 64 * nb + lane;
    const float* p = src + (size_t)k0 * N + n;
    if (n < N) {
#pragma unroll
        for (int i = 0; i < 64; ++i) v[i] = p[(size_t)i * N];
    } else {
#pragma unroll
        for (int i = 0; i < 64; ++i) v[i] = 0.f;
    }
}
__device__ __forceinline__ void conv_store(bf16* dst, const float* g, int K, int N, int nblk, int mode, float scale, LAS float* scr, int item, int lane, const float (&v)[64]) {
    const int kb = item / nblk, nb = item - kb * nblk, k0 = 64 * kb, n0 = 64 * nb;
    if (g) {
#pragma unroll
        for (int i = 0; i < 64; ++i) scr[i * 65 + lane] = v[i] * g[k0 + i];
    } else {
#pragma unroll
        for (int i = 0; i < 64; ++i) scr[i * 65 + lane] = v[i];
    }
    LDS_WAIT(); asm volatile("" ::: "memory");
    const int rm = mode & 3;
    if (mode & 4) {
        const int c = lane & 3;
#pragma unroll
        for (int j = 0; j < 4; ++j) { const int nn = (lane >> 2) + 16 * j, nc = n0 + nn; const LAS float* s = scr + (16 * c) * 65 + nn;
            u32x4 o; o.x = pk4_fp8(s[0 * 65] * scale, s[1 * 65] * scale, s[2 * 65] * scale, s[3 * 65] * scale); o.y = pk4_fp8(s[4 * 65] * scale, s[5 * 65] * scale, s[6 * 65] * scale, s[7 * 65] * scale);
            o.z = pk4_fp8(s[8 * 65] * scale, s[9 * 65] * scale, s[10 * 65] * scale, s[11 * 65] * scale); o.w = pk4_fp8(s[12 * 65] * scale, s[13 * 65] * scale, s[14 * 65] * scale, s[15 * 65] * scale);
            if (nc < N) { const int orow = rm == 0 ? nc : (256 * (nc >> 7) + (nc & 127) + (rm == 2 ? 128 : 0)); *(u32x4*)((unsigned char*)dst + (size_t)orow * K + k0 + 16 * c) = o; } }
    } else {
    const int c = lane & 7;
#pragma unroll
    for (int j = 0; j < 8; ++j) { const int nn = (lane >> 3) + 8 * j, nc = n0 + nn; const LAS float* s = scr + (8 * c) * 65 + nn;
        u32x4 o; o.x = pk2(s[0 * 65], s[1 * 65]); o.y = pk2(s[2 * 65], s[3 * 65]); o.z = pk2(s[4 * 65], s[5 * 65]); o.w = pk2(s[6 * 65], s[7 * 65]);
        if (nc < N) { const int orow = rm == 0 ? nc : (256 * (nc >> 7) + (nc & 127) + (rm == 2 ? 128 : 0)); *(u32x4*)(dst + (size_t)orow * K + k0 + 8 * c) = o; } }
    }
    LDS_WAIT(); asm volatile("" ::: "memory");
}
struct ConvCur { const float* src; bf16* dst; const float* g; int K, N, nblk, mode, item; float scale; };
__device__ __forceinline__ void conv_lookup(const LAS ConvJob* jobs, int njobs, int it, ConvCur& c) {
    int ji = 0; while (ji + 1 < njobs && jobs[ji + 1].start <= it) ++ji;
    c.src = jobs[ji].src; c.dst = jobs[ji].dst; c.g = jobs[ji].g; c.K = jobs[ji].K; c.N = jobs[ji].N; c.nblk = jobs[ji].nblk; c.mode = jobs[ji].mode; c.item = it - jobs[ji].start; c.scale = jobs[ji].scale;
}
__device__ __forceinline__ void run_conv_jobs(LAS unsigned char* lds, int njobs, int item_lo, int item_hi, int w0, int nw, int wave, int lane) {
    const LAS ConvJob* jobs = (const LAS ConvJob*)(lds + CONV_JOBS_OFF);
    LAS float* scr = (LAS float*)(lds + wave * (64 * 65 * 4));
    int it = item_lo + w0; if (it >= item_hi) return;
    ConvCur cur, nxt; float v[64], w[64];
    conv_lookup(jobs, njobs, it, cur); conv_load(cur.src, cur.N, cur.nblk, cur.item, lane, v);
#pragma nounroll
    for (;;) {
        const int itn = it + nw; const bool has = itn < item_hi;
        if (has) { conv_lookup(jobs, njobs, itn, nxt); conv_load(nxt.src, nxt.N, nxt.nblk, nxt.item, lane, w); }
        conv_store(cur.dst, cur.g, cur.K, cur.N, cur.nblk, cur.mode, cur.scale, scr, cur.item, lane, v);
        if (!has) break;
#pragma unroll
        for (int i = 0; i < 64; ++i) v[i] = w[i];
        cur = nxt; it = itn;
    }
}
#define ADD_JOB(SRC, DST, GP, KK, NN, MODE) do { LAS ConvJob* _j = jobsw + nj; int kk_ = (KK), nn_ = (NN), md_ = (MODE); asm volatile("" : "+s"(kk_), "+s"(nn_), "+s"(md_));     \
    _j->src = (SRC); _j->dst = (DST); _j->g = (GP); _j->K = kk_; _j->N = nn_; _j->nblk = (nn_ + 63) / 64; \
    _j->mode = md_; _j->start = tot; _j->scale = (md_ & 4) ? ((md_ & 3) ? FP8_SW_GU : FP8_SW_D) : 1.f; tot += (kk_ / 64) * ((nn_ + 63) / 64); ++nj; } while (0)

constexpr int MOE_ITEMS = 24 * 896;
constexpr size_t MOEGU_SET = (size_t)NEXP * 2 * DFFE * DM, MOED_SET = (size_t)NEXP * DM * DFFE;
#define BUILD_MOE_JOBS(I) do { _Pragma("nounroll") for (int e = 0; e < NEXP; ++e) { \
        ADD_JOB((const float*)INP(22) + (size_t)((I) * NEXP + e) * DM * DFFE, (bf16*)(ws + WS_W_MOEGU + (I) * MOEGU_SET + (size_t)e * 2 * DFFE * DM), norm_g + ((2 * (I) + 1) * 3 + 2) * DM, DM, DFFE, 5); \
        ADD_JOB((const float*)INP(23) + (size_t)((I) * NEXP + e) * DM * DFFE, (bf16*)(ws + WS_W_MOEGU + (I) * MOEGU_SET + (size_t)e * 2 * DFFE * DM), norm_g + ((2 * (I) + 1) * 3 + 2) * DM, DM, DFFE, 6); \
        ADD_JOB((const float*)INP(24) + (size_t)((I) * NEXP + e) * DFFE * DM, (bf16*)(ws + WS_W_MOED + (I) * MOED_SET + (size_t)e * DM * DFFE), (const float*)nullptr, DFFE, DM, 4); } } while (0)
#define MOE_CONV_SLICE(I, LO, HI, RANK, NRANK) do { LAS ConvJob* jobsw = (LAS ConvJob*)(lds + CONV_JOBS_OFF); \
        __syncthreads(); if (tid == 0) { int nj = 0, tot = 0; BUILD_MOE_JOBS(I); } __syncthreads(); \
        run_conv_jobs(lds, 24, (LO), (HI), (RANK) * NWAVES + wave, (NRANK) * NWAVES, wave, lane); __syncthreads(); } while (0)
constexpr int MS_E1 = 2048, MS_XQA = 3072, MS_F1 = 2048, MS_XQB = 4608;
constexpr int MS0_A0 = MS_E1, MS0_A1 = MS0_A0 + MS_XQA, MS0_A2 = MS0_A1 + MS_F1, MS0_A3 = MS0_A2 + MS_XQB;
constexpr int MS1_B0 = MS_E1, MS1_B1 = MS1_B0 + MS_XQB, MS1_B2 = MS1_B1 + MS_F1, MS1_B3 = MS1_B2 + MS_XQB;

__device__ __forceinline__ float load_row4(const float* row, int lane, f32x4 (&v)[4]) {
    float s = 0.f;
#pragma unroll
    for (int j = 0; j < 4; ++j) { v[j] = *(const f32x4*)(row + 4 * lane + 256 * j); s += (v[j][0] * v[j][0] + v[j][1] * v[j][1]) + (v[j][2] * v[j][2] + v[j][3] * v[j][3]); }
    return wave_sum(s);
}
__device__ __forceinline__ float load_row4_bf16(const bf16* row, int lane, f32x4 (&v)[4]) {
    float s = 0.f;
#pragma unroll
    for (int j = 0; j < 4; ++j) { const u32x2 o = *(const u32x2*)(row + 4 * lane + 256 * j);
        v[j] = (f32x4){__builtin_bit_cast(float, o.x << 16), __builtin_bit_cast(float, o.x & 0xffff0000u), __builtin_bit_cast(float, o.y << 16), __builtin_bit_cast(float, o.y & 0xffff0000u)};
        s += (v[j][0] * v[j][0] + v[j][1] * v[j][1]) + (v[j][2] * v[j][2] + v[j][3] * v[j][3]); }
    return wave_sum(s);
}
__device__ __forceinline__ void store_ssq_full(float* ssq, int row, float s, int lane) { if (lane < 16) ssq[(size_t)lane * MTOK + row] = (lane == 0) ? s : 0.f; }
__device__ __forceinline__ void store_row_bf16(bf16* orow, int lane, const f32x4 (&v)[4]) {
#pragma unroll
    for (int j = 0; j < 4; ++j) { u32x2 o; o.x = pk2(v[j][0], v[j][1]); o.y = pk2(v[j][2], v[j][3]); *(u32x2*)(orow + 4 * lane + 256 * j) = o; }
}

struct Args { const void* in[28]; float* out; unsigned char* ws; double invf[8]; int ph_lo, ph_hi; };
constexpr int NPH = 2 + 4 * 13;

#define CAS __attribute__((address_space(4)))
__device__ __forceinline__ const CAS char* karg() { const CAS char* kp = (const CAS char*)__builtin_amdgcn_kernarg_segment_ptr(); asm volatile("" : "+s"(kp)); return kp; }
#define INP(k) ((const void*)(*(const GAS void* const CAS*)(karg() + 8 * (k))))
#define ARG_OUT ((float*)(*(GAS float* const CAS*)(karg() + 224)))
#define ARG_WS (*(GAS unsigned char* const CAS*)(karg() + 232))
#define ARG_INVF(j) (*(const CAS double*)(karg() + 240 + 8 * (j)))
static_assert(offsetof(Args, out) == 224 && offsetof(Args, ws) == 232 && offsetof(Args, invf) == 240 && offsetof(Args, ph_lo) == 304 && sizeof(Args) == 312, "kernarg layout");
#define PHASE_IDS int tid = threadIdx.x; asm volatile("" : "+v"(tid)); const int lane = tid & 63, wave = __builtin_amdgcn_readfirstlane(tid >> 6); \
    int bx = blockIdx.x, G = gridDim.x; asm volatile("" : "+s"(bx), "+s"(G)); const int gw = bx * NWAVES + wave, NGW = G * NWAVES; (void)lane; (void)gw; (void)NGW;
#define ws (ARG_WS)
#define ctl ((unsigned*)(ws + WS_CTL))
#define PH_LO (*(const CAS int*)(karg() + 304))
#define PH_HI (*(const CAS int*)(karg() + 308))
#define IN(p) (PH_LO <= (p) && (p) < PH_HI)
#define T_START unsigned long long t0_ = 0; if (DELAYMASK) t0_ = __builtin_amdgcn_s_memrealtime();
#define T_DELAY(c) do { if (DELAYMASK && (c)) { const unsigned long long t1_ = __builtin_amdgcn_s_memrealtime(); while (__builtin_amdgcn_s_memrealtime() - t1_ < t1_ - t0_) __builtin_amdgcn_s_sleep(8); } } while (0)
#define BAR_AFTER(p) do { if (MK_SINGLE && (p) + 1 < PH_HI) { XcdBarrier bar_; bar_.bar = ctl + CW_BAR; bar_.x = xb_xcc_id(); bar_.st = (volatile LAS unsigned*)(lds + MISC_OFF) + 8; xcd_barrier(bar_); } } while (0)
#define in_x ((const float*)INP(0))
#define in_mem ((const float*)INP(1))
#define in_pos ((const int*)INP(2))
#define norm_g ((const float*)INP(3))
#define mem_g ((const float*)INP(4))
#define final_g ((const float*)INP(5))
#define X (ARG_OUT)
#define XB ((bf16*)(ws + WS_XB))
#define SSQ ((float*)(ws + WS_SSQ))
#define CS ((float*)(ws + WS_MISC + MISC_CS))
#define KMEAN ((float*)(ws + WS_MISC + MISC_KMEAN))
#define KCMP ((bf16*)(ws + WS_MISC + MISC_KCMP))
#define VCMP ((bf16*)(ws + WS_MISC + MISC_VCMP))
#define MEMB ((bf16*)(ws + WS_MEMB))
#define XK ((bf16*)(ws + WS_XK))
#define XV ((bf16*)(ws + WS_XV))
#define YB ((bf16*)(ws + WS_YB))
#define XQ ((bf16*)(ws + WS_XQ))
#define XO ((bf16*)(ws + WS_XO))
#define TOKE ((int*)(ws + WS_ROUTE + RT_TOKE))
#define TOKPOS ((int*)(ws + WS_ROUTE + RT_TOKPOS))
#define TOKW ((float*)(ws + WS_ROUTE + RT_TOKW))
#define TOKRSTD ((float*)(ws + WS_ROUTE + RT_TOKRSTD))
#define ROWTOK ((int*)(ws + WS_ROUTE + RT_ROWTOK))
#define ROWW ((float*)(ws + WS_ROUTE + RT_ROWW))
#define ROWRSTD ((float*)(ws + WS_ROUTE + RT_ROWRSTD))
#define TILEE ((int*)(ws + WS_ROUTE + RT_TILEE))
#define LCNT ((int*)(ws + WS_ROUTE + RT_LCNT))
#define RA ((unsigned char*)(ws + WS_REGA))
#define UPOOL ((float*)(RA + RA_UPOOL))
#define QB ((bf16*)(RA + RA_QB))
#define KB ((bf16*)(RA + RA_KB))
#define VB ((bf16*)(RA + RA_VB))
#define QRAW ((bf16*)(RA + RA_QRAW))
#define QROT ((bf16*)(RA + RA_QROT))
#define ACMPK ((bf16*)(RA + RA_ACMPK))
#define KSB ((bf16*)(RA + RA_KS))
#define VSB ((bf16*)(RA + RA_VS))
#define KWB ((bf16*)(RA + RA_KW))
#define VWB ((bf16*)(RA + RA_VW))
#define GATES ((float*)(RA + RA_GATES))
#define CPART ((float*)(RA + RA_CPART))
#define YMOE ((bf16*)(RA + RA_YMOE))
#define XPERM ((bf16*)(RA + RA_XPERM))
#define HB ((bf16*)(ws + WS_REGB))
template <int l> __device__ __forceinline__ void run_layer(LAS unsigned char* lds) {
        constexpr int pb = 2 + 13 * l, i2 = l >> 1;
        constexpr bool even = (l & 1) == 0;
        if (IN(pb + 0)) {
            PHASE_IDS T_START
            if (ON(2) && even) {
                pg8::Gemm g{XB, (const bf16*)(ws + WS_W_INAB) + (size_t)i2 * AB_IN * DM, DM, DM, DM}; pg8::StaticOrder S; S.init(MTOK, AB_IN, G, bx, DM, DM);
                pg8::EpiInAB E{SSQ, CS, RA, KMEAN};
                pg8::gemm_phase<pg8::EpiInAB, pg8::StaticOrder>(lds, g, S, E, tid);
                if (G == 256 && bx >= 128) { if (l == 0) MOE_CONV_SLICE(0, 0, MS0_A0, bx - 128, 128); else MOE_CONV_SLICE(1, 0, MS1_B0, bx - 128, 128); }
            } else if (ON(3) && !even) {
                pg8::Gemm g{XB, (const bf16*)(ws + WS_W_INC) + (size_t)i2 * C_IN_PAD * DM, DM, DM, DM}; pg8::StaticOrder S; S.init(MTOK, C_IN_PAD, G, bx, DM, DM);
                pg8::EpiInC E{SSQ, CS, RA, (const float*)INP(14) + (size_t)i2 * 32 * 64, (const float*)INP(15) + (size_t)i2 * 32 * 64};
                pg8::gemm_phase<pg8::EpiInC, pg8::StaticOrder>(lds, g, S, E, tid);
            }
            BAR_AFTER(pb + 0); T_DELAY((even ? DLY(2) : DLY(3)));
        }
        if (IN(pb + 1) && !even) {
            PHASE_IDS T_START
            if (ON(5)) {
                pg8::Gemm g{ACMPK, (const bf16*)(ws + WS_W_CW1) + (size_t)i2 * 2 * 256 * 2048, 2048, 2048, 2048 / CMP_SPLIT}; pg8::CmpOrder S{G, bx};
                pg8::EpiCmpPart E{CPART};
                pg8::gemm_phase<pg8::EpiCmpPart, pg8::CmpOrder>(lds, g, S, E, tid);
            }
            BAR_AFTER(pb + 1); T_DELAY((even ? DLY(4) : DLY(5)));
        }
        if (ON(6) && IN(pb + 2) && !even) {
            PHASE_IDS T_START
            LAS float* wl = (LAS float*)lds;
            LAS float* hl = (LAS float*)(lds + 65536);
            for (int u = bx; u < 256; u += G) {
                const int t = u >> 7, R0 = (u & 127) * 32;
                const float* w2 = (const float*)INP(t ? 19 : 17) + (size_t)i2 * 256 * 64;
#pragma unroll
                for (int q = 0; q < 8; ++q) *(LAS f32x4*)(wl + (tid + 512 * q) * 4) = *(const f32x4*)(w2 + (tid + 512 * q) * 4);
#pragma unroll
                for (int q = 0; q < 4; ++q) { const int idx4 = tid + 512 * q, rr = idx4 >> 6, c4 = (idx4 & 63) * 4; f32x4 sacc = {0.f, 0.f, 0.f, 0.f};
#pragma unroll
                    for (int sp = 0; sp < CMP_SPLIT; ++sp) sacc = sacc + *(const f32x4*)(CPART + ((size_t)(t * CMP_SPLIT + sp) * 4096 + R0 + rr) * 256 + c4);
#pragma unroll
                    for (int e = 0; e < 4; ++e) sacc[e] = gelu_tanh_f(sacc[e]);
                    *(LAS f32x4*)(hl + rr * 256 + c4) = sacc; }
                __syncthreads();
                const int rr = tid >> 4, d4 = (tid & 15) * 4; f32x4 a = {0.f, 0.f, 0.f, 0.f};
#pragma unroll 8
                for (int k = 0; k < 256; ++k) a = a + *(const LAS f32x4*)(wl + k * 64 + d4) * hl[rr * 256 + k];
                const int row = R0 + rr; if ((row & 127) == 127) a = (f32x4){0.f, 0.f, 0.f, 0.f};
                u32x2 o; o.x = pk2(a[0], a[1]); o.y = pk2(a[2], a[3]);
                *(u32x2*)((t ? VCMP : KCMP) + (size_t)row * 64 + d4) = o;
                __syncthreads();
            }
            BAR_AFTER(pb + 2); T_DELAY(DLY(6));
        }
        if (IN(pb + 3)) {
            PHASE_IDS T_START
            if (ON(7) && even) {
                for (int u0 = bx, rnd = 0; u0 < 768 + 512; u0 += G, ++rnd) {
                    const int u = ((rnd & 1) && (u0 - bx) + G <= 768) ? (u0 - bx) + (G - 1 - bx) : u0;
                    if (u < 768) {
                        const int qb = 7 - u / 96, bh = u % 96, b = bh / 12, h = bh % 12;
                        LAS float* km = (LAS float*)(lds + att::KV_BYTES);
                        LAS unsigned* uni = (LAS unsigned*)(lds + att::KV_BYTES + 2048);
                        if (tid < qb * 64) { const int j = tid >> 6, d = tid & 63; const float* kp = KMEAN + (size_t)((b * 8 + j) * 2) * MOBA_DIMC + h * 64 + d; km[tid] = (kp[0] + kp[MOBA_DIMC]) * (1.f / 256.f); }
                        if (tid == 0) *uni = 0u;
                        __syncthreads();
                        const int r = lane & 31, hh = lane >> 5, tq = 32 * wave + r;
                        const size_t tok = (size_t)b * SEQ + 256 * qb + tq;
                        bf16x8 qf[4]; att::load_q(qf, QB + tok * MOBA_DIMC + h * 64, hh);
                        float gt[7];
#pragma unroll
                        for (int j = 0; j < 7; ++j) { float p = -INFINITY;
                            if (j < qb) { p = 0.f;
#pragma unroll
                                for (int ks = 0; ks < 4; ++ks)
#pragma unroll
                                    for (int jj = 0; jj < 8; ++jj) p += bf2f((unsigned short)qf[ks][jj]) * km[j * 64 + ks * 16 + hh * 8 + jj];
                                p += __shfl_xor(p, 32); }
                            gt[j] = p; }
                        unsigned sel = 0u;
#pragma unroll
                        for (int j = 0; j < 7; ++j) { int c = 0;
#pragma unroll
                            for (int j2 = 0; j2 < 7; ++j2) c += (gt[j2] > gt[j] || (gt[j2] == gt[j] && j2 < j)) ? 1 : 0;
                            if (j < qb && c < 3) sel |= 1u << j; }
                        { unsigned o = sel;
#pragma unroll
                          for (int s = 1; s < 64; s <<= 1) o |= __shfl_xor(o, s);
                          if (lane == 0 && o) atomicOr((unsigned*)uni, o); }
                        __syncthreads();
                        att::MobaMask mk; mk.qb = qb; mk.wq0 = 32 * wave; mk.tq = tq; mk.sel = sel; mk.uni = __builtin_amdgcn_readfirstlane(*uni);
                        att::State st; att::reset(st);
                        att::flash_run<att::MobaMask, false>(lds, KB + (size_t)b * SEQ * MOBA_DIMC + h * 64, VB + (size_t)b * SEQ * MOBA_DIMC + h * 64, MOBA_DIMC, 0, 4 * (qb + 1), qf, st, mk, tid);
                        att::store_o(YB + tok * DM + 256 + h * 64, st.o0, st.o1, st.l > 0.f ? 1.f / st.l : 0.f, hh);
                        __syncthreads();
                    } else {
                        const int pu = u - 768, tok0 = pu * 32, t0 = tok0 & (SEQ - 1);
                        LAS float* ub = (LAS float*)lds;
                        LAS float* pl = (LAS float*)(lds + 47 * 1024);
                        for (int idx = tid; idx < 47 * 64; idx += 512) { const int rr = idx >> 6, c4 = (idx & 63) * 4; const int t = t0 - 15 + rr;
                            f32x4 v = {0.f, 0.f, 0.f, 0.f}; if (t >= 0) v = *(const f32x4*)(UPOOL + (size_t)(tok0 - 15 + rr) * 256 + c4);
                            *(LAS f32x4*)(ub + rr * 256 + c4) = v; }
                        __syncthreads();
                        for (int idx = tid; idx < 32 * 256; idx += 512) { const int tt = idx >> 8, c = idx & 255, w = 2 << (c >> 6), t = t0 + tt;
                            const int cnt = (t + 1 < w) ? t + 1 : w; float s = 0.f;
                            for (int q = 0; q < cnt; ++q) s += ub[(15 + tt - q) * 256 + c];
                            pl[idx] = s / (float)cnt - ub[(15 + tt) * 256 + c]; }
                        __syncthreads();
                        { const int c = tid & 255, hf = tid >> 8, gi = c >> 6, d = c & 63;
                          const float* pw = (const float*)INP(7) + ((size_t)(i2 * 4 + gi) * 64) * 64 + d; const float sc = ((const float*)INP(8))[i2 * 256 + c];
                          float a[16];
#pragma unroll
                          for (int q = 0; q < 16; ++q) a[q] = 0.f;
                          for (int k = 0; k < 64; ++k) { const float wv = pw[k * 64];
#pragma unroll
                              for (int q = 0; q < 16; ++q) a[q] += pl[(hf * 16 + q) * 256 + gi * 64 + k] * wv; }
#pragma unroll
                          for (int q = 0; q < 16; ++q) YB[(size_t)(tok0 + hf * 16 + q) * DM + c] = (bf16)f2bf(a[q] * sc); }
                        __syncthreads();
                    }
                }
            } else if (ON(8) && !even) {
                for (int u0 = bx, rnd = 0; u0 < 1024; u0 += G, ++rnd) {
                    const int u = ((rnd & 1) && (u0 - bx) + G <= 1024) ? (u0 - bx) + (G - 1 - bx) : u0;
                    const int tb = 31 - u / 32, bg = u % 32, b = bg >> 2, g = bg & 3;
                    LAS float* pslc = (LAS float*)(lds + att::KV_BYTES);
                    LAS float* sc = (LAS float*)(lds + att::KV_BYTES + 32768);
                    LAS unsigned* selm = (LAS unsigned*)(lds + att::KV_BYTES + 65536);
                    LAS float* yst = (LAS float*)(lds + att::KV_BYTES) + (size_t)wave * 32 * 64 + lane;
                    const int r = lane & 31, hh = lane >> 5, hd = wave & 3, th = wave >> 2, tq = 32 * th + r, t = 64 * tb + tq;
                    const size_t tok = (size_t)b * SEQ + t; const int head = g * 4 + hd;
                    f32x16 y0, y1;
                    bf16x8 qf[4];
                    att::State st;
                    {
                        att::load_q(qf, QRAW + tok * DM + head * 64, hh);
                        att::CmpMask mk; mk.nmax = (t >= 31) ? ((t - 31) >> 4) : -1;
                        const int tlo = 64 * tb + 32 * th, thi = tlo + 31; mk.nlo = (tlo >= 31) ? ((tlo - 31) >> 4) : -1; mk.nhi = (thi >= 31) ? ((thi - 31) >> 4) : -1;
                        att::reset(st);
                        att::flash_run<att::CmpMask, true>(lds, KCMP + (size_t)bg * 128 * 64, VCMP + (size_t)bg * 128 * 64, 64, 0, tb <= 15 ? 1 : 2, qf, st, mk, tid);
                        const float inv = st.l > 0.f ? 1.f / st.l : 0.f, sg = inv * GATES[tok * 48 + head * 3 + 0];
                        y0 = st.o0 * sg; y1 = st.o1 * sg;
#pragma unroll
                        for (int i = 0; i < 16; ++i) pslc[(hd * 64 + tq) * 32 + (i & 3) + 8 * (i >> 2) + 4 * hh] = st.o2[i] * inv;
                    }
                    __syncthreads();
#pragma nounroll
                    for (int p = 0; p < 4; ++p) { const int tt = p * 16 + (tid >> 5), j = tid & 31;
                        float v = -1.f;
                        if (j <= tb) v = (j == 0 || j == tb || j == tb - 1) ? 1e4f : ((pslc[(0 * 64 + tt) * 32 + j] + pslc[(1 * 64 + tt) * 32 + j]) + (pslc[(2 * 64 + tt) * 32 + j] + pslc[(3 * 64 + tt) * 32 + j]));
                        sc[tt * 32 + j] = v; }
                    __syncthreads();
#pragma nounroll
                    for (int p = 0; p < 4; ++p) { const int tt = p * 16 + (tid >> 5), j = tid & 31; const float my = sc[tt * 32 + j]; int c = 0;
#pragma unroll 8
                        for (int j2 = 0; j2 < 32; ++j2) { const float o = sc[tt * 32 + j2]; c += (o > my || (o == my && j2 < j)) ? 1 : 0; }
                        const unsigned long long bm = __ballot(c < 16 && j <= tb);
                        if ((lane & 31) == 0) selm[tt] = (unsigned)(bm >> (lane & 32)); }
                    __syncthreads();
                    unsigned uni;
                    { unsigned o = selm[lane];
#pragma unroll
                      for (int s = 1; s < 64; s <<= 1) o |= __shfl_xor(o, s);
                      uni = __builtin_amdgcn_readfirstlane(o); }
                    const unsigned sel = selm[tq];
                    __syncthreads();
#pragma unroll
                    for (int i = 0; i < 16; ++i) { yst[i * 64] = y0[i]; yst[(16 + i) * 64] = y1[i]; }
                    att::load_q(qf, QROT + tok * DM + head * 64, hh);
                    {
                        att::SelMask mk; mk.tb = tb; mk.tq = tq; mk.wq0 = 32 * th; mk.sel = sel; mk.uni = uni;
                        att::reset(st);
                        att::flash_run<att::SelMask, false>(lds, KSB + (size_t)b * SEQ * 256 + g * 64, VSB + (size_t)b * SEQ * 256 + g * 64, 256, 0, tb + 1, qf, st, mk, tid);
                        const float sg = (st.l > 0.f ? 1.f / st.l : 0.f) * GATES[tok * 48 + head * 3 + 1];
#pragma unroll
                        for (int i = 0; i < 16; ++i) { yst[i * 64] += st.o0[i] * sg; yst[(16 + i) * 64] += st.o1[i] * sg; }
                    }
                    {
                        att::WinMask mk; mk.tb = tb; mk.tq = tq;
                        att::reset(st);
                        att::flash_run<att::WinMask, false>(lds, KWB + (size_t)b * SEQ * 256 + g * 64, VWB + (size_t)b * SEQ * 256 + g * 64, 256, tb >= 8 ? tb - 8 : 0, tb + 1, qf, st, mk, tid);
                        const float sg = (st.l > 0.f ? 1.f / st.l : 0.f) * GATES[tok * 48 + head * 3 + 2];
#pragma unroll
                        for (int i = 0; i < 16; ++i) { y0[i] = yst[i * 64] + st.o0[i] * sg; y1[i] = yst[(16 + i) * 64] + st.o1[i] * sg; }
                    }
                    att::store_o(YB + tok * DM + head * 64, y0, y1, 1.f, hh);
                    __syncthreads();
                }
            }
            BAR_AFTER(pb + 3); T_DELAY((even ? DLY(7) : DLY(8)));
        }
        if (ON(9) && IN(pb + 4)) {
            PHASE_IDS T_START
            const bf16* W = even ? (const bf16*)(ws + WS_W_OUTAB) + (size_t)i2 * DM * DM : (const bf16*)(ws + WS_W_OUTC) + (size_t)i2 * DM * DM;
            pg8::Gemm g{YB, W, DM, DM, DM}; pg8::StaticOrder S; S.init(MTOK, DM, G, bx, DM, DM);
            pg8::EpiRes E{XB, SSQ};
            pg8::gemm_phase<pg8::EpiRes, pg8::StaticOrder>(lds, g, S, E, tid);
            BAR_AFTER(pb + 4); T_DELAY(DLY(9));
        }
        if (ON(10) && IN(pb + 5)) {
            PHASE_IDS T_START
            if (l == 0 && ON(1) && bx >= 64 && bx < 128) {
                pg8::Gemm g{MEMB, (const bf16*)(ws + WS_W_XKV), DM, DM, DM}; pg8::StaticOrder S; S.init(NB * MEML, 4 * 512, G, bx - 64, DM, DM);
                pg8::EpiXKV E{XK, XV};
                pg8::gemm_phase<pg8::EpiXKV, pg8::StaticOrder>(lds, g, S, E, tid);
            } else {
                pg8::Gemm g{XB, (const bf16*)(ws + WS_W_XQ) + (size_t)l * 256 * DM, DM, DM, DM}; pg8::StaticOrder S; S.init(MTOK, 256, G, bx, DM, DM);
                pg8::EpiXQ E{SSQ, XQ};
                pg8::gemm_phase<pg8::EpiXQ, pg8::StaticOrder>(lds, g, S, E, tid);
            }
            if (G == 256) {
                if (l == 0) { if (bx >= 128) MOE_CONV_SLICE(0, MS0_A0, MS0_A1, bx - 128, 128); }
                else if (l == 1) { if (bx >= 64) MOE_CONV_SLICE(0, MS0_A2, MS0_A3, bx - 64, 192); }
                else if (l == 2) { if (bx >= 64) MOE_CONV_SLICE(1, MS1_B0, MS1_B1, bx - 64, 192); }
                else { if (bx >= 64) MOE_CONV_SLICE(1, MS1_B2, MS1_B3, bx - 64, 192); }
            }
            BAR_AFTER(pb + 5); T_DELAY(DLY(10));
        }
        if (ON(11) && IN(pb + 6)) {
            PHASE_IDS T_START
            for (int u = bx; u < 256; u += G) {
                const int b = u >> 5, h = (u >> 3) & 3, qt = u & 7;
                const int r = lane & 31, hh = lane >> 5;
                const size_t tok = (size_t)b * SEQ + 256 * qt + 32 * wave + r;
                bf16x8 qf[4]; att::load_q(qf, XQ + tok * 256 + h * 64, hh);
                att::NoMask mk; att::State st; att::reset(st);
                att::flash_run<att::NoMask, false>(lds, XK + ((size_t)l * NB * MEML + (size_t)b * MEML) * 256 + h * 64, XV + ((size_t)l * NB * MEML + (size_t)b * MEML) * 256 + h * 64, 256, 0, 4, qf, st, mk, tid);
                att::store_o(XO + tok * 256 + h * 64, st.o0, st.o1, 1.f / st.l, hh);
            }
            BAR_AFTER(pb + 6); T_DELAY(DLY(11));
        }
        if (ON(12) && IN(pb + 7)) {
            PHASE_IDS T_START
            pg8::Gemm g{XO, (const bf16*)(ws + WS_W_XO) + (size_t)l * DM * 256, 256, 256, 256}; pg8::StaticOrder S; S.init(MTOK, DM, G, bx, 256, 256);
            pg8::EpiRes E{XB, SSQ};
            pg8::gemm_phase<pg8::EpiRes, pg8::StaticOrder>(lds, g, S, E, tid);
            BAR_AFTER(pb + 7); T_DELAY(DLY(12));
        }
        if (IN(pb + 8)) {
            PHASE_IDS T_START
            if (ON(13) && even) {
                pg8::Gemm g{XB, (const bf16*)(ws + WS_W_FFNGU) + (size_t)i2 * 2 * DFF * DM, DM, DM, DM}; pg8::StaticOrder S; S.init(MTOK, 2 * DFF, G, bx, DM, DM);
                pg8::EpiGateUp<false> E{SSQ, HB, DFF};
                pg8::gemm_phase<pg8::EpiGateUp<false>, pg8::StaticOrder>(lds, g, S, E, tid);
                if (G == 256 && bx >= 128) { if (l == 0) MOE_CONV_SLICE(0, MS0_A1, MS0_A2, bx - 128, 128); else MOE_CONV_SLICE(1, MS1_B1, MS1_B2, bx - 128, 128); }
            } else if (ON(14) && !even) {
                for (int idx = bx * 512 + tid; idx < MOE_MAX_ROWS; idx += G * 512) ROWTOK[idx] = -1;
                const float* gn = norm_g + (l * 3 + 2) * DM; const float* rw = (const float*)INP(21) + (size_t)i2 * DM * NEXP;
                LAS float* wg = (LAS float*)(lds + 4096);
                for (int idx = tid; idx < DM * NEXP / 4; idx += 512) { const int k = idx >> 1; *(LAS f32x4*)(wg + idx * 4) = *(const f32x4*)(rw + idx * 4) * gn[k]; }
                LAS int* lcnt = (LAS int*)lds;
                LAS int* lte = (LAS int*)(lds + 64);
                LAS int* ltp = (LAS int*)(lds + 64 + 512);
                LAS float* ltw = (LAS float*)(lds + 64 + 1024);
                LAS float* ltr = (LAS float*)(lds + 64 + 1536);
                for (int tb0 = bx * 64; tb0 < MTOK; tb0 += G * 64) {
                    if (tid < 16) lcnt[tid] = 0;
                    __syncthreads();
#pragma nounroll
                    for (int q = 0; q < 8; ++q) {
                        const int tl = wave * 8 + q, m = tb0 + tl;
                        f32x4 v[4]; const float s = load_row4_bf16(XB + (size_t)m * DM, lane, v); const float rstd = rsqrtf(s * (1.f / DM) + NORM_EPS);
                        float lg[NEXP];
#pragma unroll
                        for (int e = 0; e < NEXP; ++e) lg[e] = 0.f;
#pragma unroll
                        for (int j = 0; j < 4; ++j) {
#pragma unroll
                            for (int qq = 0; qq < 4; ++qq) { const float hv = v[j][qq]; const LAS float* wr_ = wg + (4 * lane + 256 * j + qq) * NEXP; const f32x4 w0 = *(const LAS f32x4*)wr_, w1 = *(const LAS f32x4*)(wr_ + 4);
                                lg[0] += hv * w0[0]; lg[1] += hv * w0[1]; lg[2] += hv * w0[2]; lg[3] += hv * w0[3]; lg[4] += hv * w1[0]; lg[5] += hv * w1[1]; lg[6] += hv * w1[2]; lg[7] += hv * w1[3]; } }
#pragma unroll
                        for (int e = 0; e < NEXP; ++e) lg[e] = wave_sum(lg[e]) * rstd;
                        int e0 = 0; float v0 = lg[0];
#pragma unroll
                        for (int e = 1; e < NEXP; ++e) if (lg[e] > v0) { v0 = lg[e]; e0 = e; }
                        int e1 = -1; float v1 = -INFINITY;
#pragma unroll
                        for (int e = 0; e < NEXP; ++e) if (e != e0 && lg[e] > v1) { v1 = lg[e]; e1 = e; }
                        if (lane == 0) {
                            const float w1 = 1.f / (1.f + expf(v0 - v1)), w0 = 1.f - w1;
                            lte[2 * tl] = e0; lte[2 * tl + 1] = e1; ltw[2 * tl] = w0; ltw[2 * tl + 1] = w1; ltr[tl] = rstd;
                            ltp[2 * tl] = atomicAdd((int*)(lcnt + e0), 1); ltp[2 * tl + 1] = atomicAdd((int*)(lcnt + e1), 1);
                        }
                    }
                    __syncthreads();
                    if (tid < NEXP) LCNT[(tb0 >> 6) * NEXP + tid] = lcnt[tid];
                    if (tid < 128) { const int tl = tid >> 1, m = tb0 + tl;
                        TOKE[2 * m + (tid & 1)] = lte[tid]; TOKPOS[2 * m + (tid & 1)] = ltp[tid]; TOKW[2 * m + (tid & 1)] = ltw[tid];
                        if ((tid & 1) == 0) TOKRSTD[m] = ltr[tl]; }
                    __syncthreads();
                }
            }
            BAR_AFTER(pb + 8); T_DELAY((even ? DLY(13) : DLY(14)));
        }
        if (IN(pb + 9)) {
            PHASE_IDS T_START
            if (ON(15) && even) {
                pg8::Gemm g{HB, (const bf16*)(ws + WS_W_FFND) + (size_t)i2 * DM * DFF, DFF, DFF, DFF}; pg8::StaticOrder S; S.init(MTOK, DM, G, bx, DFF, DFF);
                pg8::EpiRes E{XB, SSQ};
                pg8::gemm_phase<pg8::EpiRes, pg8::StaticOrder>(lds, g, S, E, tid);
            } else if (ON(16) && !even) {
                LAS int* pre = (LAS int*)lds;
                LAS int* ebase = (LAS int*)(lds + 256 * NEXP * 4);
                for (int idx = tid; idx < (MTOK / 64) * NEXP; idx += 512) pre[idx] = LCNT[idx];
                __syncthreads();
                if (tid < NEXP) { int run = 0; for (int tb = 0; tb < MTOK / 64; ++tb) { const int c = pre[tb * NEXP + tid]; pre[tb * NEXP + tid] = run; run += c; } ebase[tid] = run; }
                __syncthreads();
                if (tid == 0) { int acc_t = 0;
                    for (int e = 0; e < NEXP; ++e) { const int c = ebase[e]; ebase[e] = acc_t * 256; const int nt_ = (c + 255) >> 8;
                        if (bx == 0) for (int q = 0; q < nt_; ++q) TILEE[acc_t + q] = e;
                        acc_t += nt_; }
                    if (bx == 0) TILEE[MOE_MAX_TILES] = acc_t; }
                __syncthreads();
                for (int m = gw; m < MTOK; m += NGW) {
                    const int e0 = TOKE[2 * m], e1 = TOKE[2 * m + 1];
                    const int r0 = ebase[e0] + pre[(m >> 6) * NEXP + e0] + TOKPOS[2 * m], r1 = ebase[e1] + pre[(m >> 6) * NEXP + e1] + TOKPOS[2 * m + 1];
                    const float rq = TOKRSTD[m] * FP8_SX;
                    const u32x4 a = *(const u32x4*)(XB + (size_t)m * DM + 16 * lane), c = *(const u32x4*)(XB + (size_t)m * DM + 16 * lane + 8);
                    u32x4 o;
                    o.x = pk4_fp8(__builtin_bit_cast(float, a.x << 16) * rq, __builtin_bit_cast(float, a.x & 0xffff0000u) * rq, __builtin_bit_cast(float, a.y << 16) * rq, __builtin_bit_cast(float, a.y & 0xffff0000u) * rq);
                    o.y = pk4_fp8(__builtin_bit_cast(float, a.z << 16) * rq, __builtin_bit_cast(float, a.z & 0xffff0000u) * rq, __builtin_bit_cast(float, a.w << 16) * rq, __builtin_bit_cast(float, a.w & 0xffff0000u) * rq);
                    o.z = pk4_fp8(__builtin_bit_cast(float, c.x << 16) * rq, __builtin_bit_cast(float, c.x & 0xffff0000u) * rq, __builtin_bit_cast(float, c.y << 16) * rq, __builtin_bit_cast(float, c.y & 0xffff0000u) * rq);
                    o.w = pk4_fp8(__builtin_bit_cast(float, c.z << 16) * rq, __builtin_bit_cast(float, c.z & 0xffff0000u) * rq, __builtin_bit_cast(float, c.w << 16) * rq, __builtin_bit_cast(float, c.w & 0xffff0000u) * rq);
                    *(u32x4*)((unsigned char*)XPERM + (size_t)r0 * DM + 16 * lane) = o; *(u32x4*)((unsigned char*)XPERM + (size_t)r1 * DM + 16 * lane) = o;
                    if (lane == 0) { const float rs_ = TOKRSTD[m]; ROWTOK[r0] = 2 * m; ROWTOK[r1] = 2 * m + 1; ROWW[r0] = TOKW[2 * m]; ROWW[r1] = TOKW[2 * m + 1]; ROWRSTD[r0] = rs_; ROWRSTD[r1] = rs_; }
                }
            }
            BAR_AFTER(pb + 9); T_DELAY((even ? DLY(15) : DLY(16)));
        }
        if (ON(17) && IN(pb + 10) && !even) {
            PHASE_IDS T_START
            pg8::Gemm g{XPERM, (const bf16*)(ws + WS_W_MOEGU + i2 * MOEGU_SET), DM / 2, DM / 2, DM / 2}; pg8::MoeOrder S{TILEE, 2 * DFFE / 256, G, bx, DM / 2, DM / 2, 2 * DFFE};
            pg8::EpiGateUp<true> E{nullptr, HB, DFFE};
            pg8::gemm_phase<pg8::EpiGateUp<true>, pg8::MoeOrder, true, E8(6), E8(2)>(lds, g, S, E, tid);
            BAR_AFTER(pb + 10); T_DELAY(DLY(17));
        }
        if (ON(18) && IN(pb + 11) && !even) {
            PHASE_IDS T_START
            pg8::Gemm g{HB, (const bf16*)(ws + WS_W_MOED + i2 * MOED_SET), DFFE / 2, DFFE / 2, DFFE / 2}; pg8::MoeOrder S{TILEE, DM / 256, G, bx, DFFE / 2, DFFE / 2, DM};
            pg8::EpiMoeDown E{ROWTOK, ROWW, YMOE};
            pg8::gemm_phase<pg8::EpiMoeDown, pg8::MoeOrder, true, E8(7), E8(3)>(lds, g, S, E, tid);
            BAR_AFTER(pb + 11); T_DELAY(DLY(18));
        }
        if (ON(19) && IN(pb + 12) && !even) {
            PHASE_IDS T_START
            if (l == 1) {
                LAS ConvJob* jobsw = (LAS ConvJob*)(lds + CONV_JOBS_OFF);
                if (tid == 0) { int nj = 0, tot = 0; BUILD_MOE_JOBS(1); }
                __syncthreads();
                run_conv_jobs(lds, 24, G == 256 ? MS1_B3 : 0, MOE_ITEMS, gw, NGW, wave, lane);
            }
            for (int m = gw; m < MTOK; m += NGW) {
                f32x4 v[4]; float s = 0.f;
#pragma unroll
                for (int j = 0; j < 4; ++j) { const size_t o = (size_t)m * DM + 4 * lane + 256 * j;
                    const u32x2 y0 = *(const u32x2*)(YMOE + o), y1 = *(const u32x2*)(YMOE + (size_t)MTOK * DM + o);
                    const f32x4 a0 = {__builtin_bit_cast(float, y0.x << 16), __builtin_bit_cast(float, y0.x & 0xffff0000u), __builtin_bit_cast(float, y0.y << 16), __builtin_bit_cast(float, y0.y & 0xffff0000u)};
                    const f32x4 a1 = {__builtin_bit_cast(float, y1.x << 16), __builtin_bit_cast(float, y1.x & 0xffff0000u), __builtin_bit_cast(float, y1.y << 16), __builtin_bit_cast(float, y1.y & 0xffff0000u)};
                    const u32x2 xo = *(const u32x2*)(XB + o);
                    const f32x4 xv = {__builtin_bit_cast(float, xo.x << 16), __builtin_bit_cast(float, xo.x & 0xffff0000u), __builtin_bit_cast(float, xo.y << 16), __builtin_bit_cast(float, xo.y & 0xffff0000u)};
                    v[j] = (xv + a0) + a1;
                    s += (v[j][0] * v[j][0] + v[j][1] * v[j][1]) + (v[j][2] * v[j][2] + v[j][3] * v[j][3]); }
                s = wave_sum(s);
                if (l == 3) { const float r = rsqrtf(s * (1.f / DM) + NORM_EPS);
#pragma unroll
                    for (int j = 0; j < 4; ++j) *(f32x4*)(X + (size_t)m * DM + 4 * lane + 256 * j) = v[j] * r * *(const f32x4*)(final_g + 4 * lane + 256 * j);
                } else {
                    store_row_bf16(XB + (size_t)m * DM, lane, v); store_ssq_full(SSQ, m, s, lane);
                }
            }
            BAR_AFTER(pb + 12); T_DELAY(DLY(19));
        }
}
__global__ void __launch_bounds__(NWAVES * 64, 2) mk_fwd(Args args) {
    extern __shared__ __attribute__((aligned(16))) unsigned char lds_raw[];
    LAS unsigned char* lds = (LAS unsigned char*)lds_raw;
    volatile LAS unsigned* MISC = (volatile LAS unsigned*)(lds + MISC_OFF);
    for (int u = threadIdx.x; u < (LDS_BYTES - LDSCTL_OFF) / 4; u += NWAVES * 64) ((LAS unsigned*)(lds + LDSCTL_OFF))[u] = 0u;
    __syncthreads();
    if (MK_SINGLE) (void)xcd_barrier_post(ctl + CW_BAR, MISC + 8);


    if (ON(0) && IN(0)) {
            PHASE_IDS T_START
        LAS ConvJob* jobsw = (LAS ConvJob*)(lds + CONV_JOBS_OFF);
        LAS int* jmeta = (LAS int*)(lds + CONV_META_OFF);
        if (tid == 0) {
            int nj = 0, tot = 0;
#pragma nounroll
            for (int i = 0; i < 2; ++i) {
                ADD_JOB((const float*)INP(6) + (size_t)i * DM * AB_IN, (bf16*)(ws + WS_W_INAB) + (size_t)i * AB_IN * DM, norm_g + (2 * i * 3 + 0) * DM, DM, AB_IN, 0);
                ADD_JOB((const float*)INP(9) + (size_t)i * DM * DM, (bf16*)(ws + WS_W_OUTAB) + (size_t)i * DM * DM, (const float*)nullptr, DM, DM, 0);
                ADD_JOB((const float*)INP(10) + (size_t)i * DM * DFF, (bf16*)(ws + WS_W_FFNGU) + (size_t)i * 2 * DFF * DM, norm_g + (2 * i * 3 + 2) * DM, DM, DFF, 1);
                ADD_JOB((const float*)INP(11) + (size_t)i * DM * DFF, (bf16*)(ws + WS_W_FFNGU) + (size_t)i * 2 * DFF * DM, norm_g + (2 * i * 3 + 2) * DM, DM, DFF, 2);
                ADD_JOB((const float*)INP(12) + (size_t)i * DFF * DM, (bf16*)(ws + WS_W_FFND) + (size_t)i * DM * DFF, (const float*)nullptr, DFF, DM, 0);
                ADD_JOB((const float*)INP(13) + (size_t)i * DM * C_IN, (bf16*)(ws + WS_W_INC) + (size_t)i * C_IN_PAD * DM, norm_g + ((2 * i + 1) * 3 + 0) * DM, DM, C_IN, 0);
                ADD_JOB((const float*)INP(16) + (size_t)i * 2048 * 256, (bf16*)(ws + WS_W_CW1) + (size_t)(i * 2 + 0) * 256 * 2048, (const float*)nullptr, 2048, 256, 0);
                ADD_JOB((const float*)INP(18) + (size_t)i * 2048 * 256, (bf16*)(ws + WS_W_CW1) + (size_t)(i * 2 + 1) * 256 * 2048, (const float*)nullptr, 2048, 256, 0);
                ADD_JOB((const float*)INP(20) + (size_t)i * DM * DM, (bf16*)(ws + WS_W_OUTC) + (size_t)i * DM * DM, (const float*)nullptr, DM, DM, 0);
            }
#pragma nounroll
            for (int l = 0; l < 4; ++l) {
                ADD_JOB((const float*)INP(25) + (size_t)l * DM * 256, (bf16*)(ws + WS_W_XQ) + (size_t)l * 256 * DM, norm_g + (l * 3 + 1) * DM, DM, 256, 0);
                ADD_JOB((const float*)INP(26) + (size_t)l * DM * 512, (bf16*)(ws + WS_W_XKV) + (size_t)l * 512 * DM, (const float*)nullptr, DM, 512, 0);
                ADD_JOB((const float*)INP(27) + (size_t)l * 256 * DM, (bf16*)(ws + WS_W_XO) + (size_t)l * DM * 256, (const float*)nullptr, 256, DM, 0);
            }
            jmeta[0] = nj; jmeta[1] = tot;
        }
        __syncthreads();
        run_conv_jobs(lds, jmeta[0], 0, jmeta[1], gw, NGW, wave, lane);
        __syncthreads();
        if (tid == 0) { int nj = 0, tot = 0; BUILD_MOE_JOBS(0); }
        __syncthreads();
        run_conv_jobs(lds, 24, G == 256 ? MS0_A3 : 0, MOE_ITEMS, gw, NGW, wave, lane);
        for (int idx = bx * 512 + tid; idx < 2 * (C_IN_PAD - C_IN) * (DM / 8); idx += G * 512) {
            const int i = idx / ((C_IN_PAD - C_IN) * (DM / 8)), rem = idx % ((C_IN_PAD - C_IN) * (DM / 8));
            *(u32x4*)((bf16*)(ws + WS_W_INC) + ((size_t)i * C_IN_PAD + C_IN) * DM + (size_t)rem * 8) = (u32x4){0u, 0u, 0u, 0u};
        }
        for (int m = gw; m < MTOK; m += NGW) {
            f32x4 v[4]; const float s = load_row4(in_x + (size_t)m * DM, lane, v);
            store_row_bf16(XB + (size_t)m * DM, lane, v); store_ssq_full(SSQ, m, s, lane);
        }
        for (int m = gw; m < NB * MEML; m += NGW) {
            f32x4 v[4]; const float s = load_row4(in_mem + (size_t)m * DM, lane, v); const float r = rsqrtf(s * (1.f / DM) + NORM_EPS);
#pragma unroll
            for (int j = 0; j < 4; ++j) v[j] = v[j] * r * *(const f32x4*)(mem_g + 4 * lane + 256 * j);
            store_row_bf16(MEMB + (size_t)m * DM, lane, v);
        }
        for (int idx = bx * 512 + tid; idx < SEQ * 8; idx += G * 512) {
            const int t = idx >> 3, j = idx & 7; const double a = (double)in_pos[t] * ARG_INVF(j) * 0.15915494309189535;
            const float fr_ = (float)(a - __builtin_rint(a));
            CS[t * 16 + j] = __builtin_amdgcn_cosf(fr_); CS[t * 16 + 8 + j] = __builtin_amdgcn_sinf(fr_);
        }
        BAR_AFTER(0); T_DELAY(DLY(0));
    }


    run_layer<0>(lds); run_layer<1>(lds); run_layer<2>(lds); run_layer<3>(lds);
#undef IN
#undef BAR_AFTER
}
#undef ws
#undef ctl
#undef X

static bool phase_applies(int p) {
    if (p == 0) return true;
    if (p == 1) return false;
    const int l = (p - 2) / 13, k = (p - 2) % 13; const bool even = (l & 1) == 0;
    if (even) return k != 1 && k != 2 && k < 10;
    return true;
}
#ifndef DUP_EVEN
#define DUP_EVEN 0u
#endif
#ifndef DUP_ODD
#define DUP_ODD 0u
#endif
static bool probe_dup(int p) {
    if (p == 0) return (DUP_EVEN >> 13) & 1u;
    if (p == 1) return (DUP_EVEN >> 14) & 1u;
    const int l = (p - 2) / 13, k = (p - 2) % 13;
    return (((l & 1) ? DUP_ODD : DUP_EVEN) >> k) & 1u;
}
extern "C" void kernel_launch(void* const* d_in, const int* in_sizes, int n_in, void* d_out, int out_size, void* d_ws, size_t ws_size, hipStream_t stream) {
    static int grid = 0;
    if (grid == 0) {
        if (n_in != 28 || out_size != MTOK * DM || ws_size < WS_END) { fprintf(stderr, "kernel_launch: unexpected shapes (n_in %d out %d ws %zu need %zu)\n", n_in, out_size, ws_size, (size_t)WS_END); grid = -1; return; }
        int dev = 0, cus = 0;
        if (hipGetDevice(&dev) != hipSuccess || hipDeviceGetAttribute(&cus, hipDeviceAttributeMultiprocessorCount, dev) != hipSuccess) { grid = -1; return; }
        if (hipFuncSetAttribute((const void*)mk_fwd, hipFuncAttributeMaxDynamicSharedMemorySize, LDS_BYTES) != hipSuccess) { fprintf(stderr, "kernel_launch: hipFuncSetAttribute failed\n"); grid = -1; return; }
        int per_cu = 0;
        if (hipOccupancyMaxActiveBlocksPerMultiprocessor(&per_cu, (const void*)mk_fwd, NWAVES * 64, LDS_BYTES) != hipSuccess || per_cu < 1) fprintf(stderr, "kernel_launch: occupancy query reports %d\n", per_cu);
        (void)hipGetLastError();
        grid = cus;
    }
    if (grid < 0) return;
    (void)hipMemsetAsync((char*)d_ws + WS_CTL, 0, CTL_ZERO_BYTES, stream);
    Args a{};
    for (int i = 0; i < 28; ++i) a.in[i] = d_in[i];
    a.out = (float*)d_out; a.ws = (unsigned char*)d_ws;
    for (int j = 0; j < 8; ++j) a.invf[j] = pow(500000.0, -(double)(2 * j) / 16.0);
#if MK_SINGLE
    a.ph_lo = 0; a.ph_hi = NPH;
    hipLaunchKernelGGL(mk_fwd, dim3(grid), dim3(NWAVES * 64), LDS_BYTES, stream, a);
#else
    for (int p = 0; p < NPH; ++p) {
        if (!phase_applies(p)) continue;
        a.ph_lo = p; a.ph_hi = p + 1;
        const int nrep = probe_dup(p) ? 2 : 1;
        for (int r = 0; r < nrep; ++r) hipLaunchKernelGGL(mk_fwd, dim3(grid), dim3(NWAVES * 64), LDS_BYTES, stream, a);
    }
#endif
}
```

```cpp
#include <hip/hip_runtime.h>
#include <cstdio>
#include <cstdint>
#include <cmath>
#include <cstddef>

#ifndef MK_SINGLE
#define MK_SINGLE 1
#endif

#ifndef PHMASK
#define PHMASK 0xFFFFFFu
#endif
#define ON(n) (((PHMASK) >> (n)) & 1u)
#ifndef DELAYMASK
#define DELAYMASK 0u
#endif
#define DLY(n) (((DELAYMASK) >> (n)) & 1u)
#define GAS __attribute__((address_space(1)))
#define LAS __attribute__((address_space(3)))
typedef unsigned short bf16;
typedef short bf16x8 __attribute__((ext_vector_type(8)));
typedef short s16x4 __attribute__((ext_vector_type(4)));
typedef float f32x4 __attribute__((ext_vector_type(4)));
typedef float f32x2 __attribute__((ext_vector_type(2)));
typedef float f32x16 __attribute__((ext_vector_type(16)));
typedef unsigned u32x4 __attribute__((ext_vector_type(4)));
typedef unsigned u32x2 __attribute__((ext_vector_type(2)));
typedef __bf16 bf16x2_t __attribute__((ext_vector_type(2)));

constexpr int NB = 8, SEQ = 2048, DM = 1024, MTOK = NB * SEQ, MEML = 256;
constexpr int AB_IN = 2560, MOBA_DIMC = 768, C_IN = 2608, C_IN_PAD = 2816;
constexpr int DFF = 2816, DFFE = 3584, NEXP = 8;
constexpr int MOE_MAX_TILES = 136, MOE_MAX_ROWS = MOE_MAX_TILES * 256;
constexpr int CMP_SPLIT = 8;
constexpr float NORM_EPS = 1e-5f;
constexpr float C2 = 0.125f * 1.4426950408889634f;

constexpr size_t MiB = 1u << 20, KiB = 1024;
constexpr size_t WS_CTL = 0, CTL_ZERO_BYTES = 64 * KiB;
constexpr size_t WS_W_INAB = 1 * MiB, WS_W_OUTAB = 11 * MiB, WS_W_FFNGU = 15 * MiB, WS_W_FFND = 37 * MiB, WS_W_INC = 48 * MiB, WS_W_CW1 = 59 * MiB,
                 WS_W_OUTC = 63 * MiB, WS_W_XQ = 67 * MiB, WS_W_XKV = 69 * MiB, WS_W_XO = 73 * MiB, WS_W_MOEGU = 75 * MiB, WS_W_MOED = 187 * MiB;
constexpr size_t WS_XB = 243 * MiB, WS_SSQ = 275 * MiB, WS_MISC = 276 * MiB, WS_MEMB = 280 * MiB, WS_XK = 284 * MiB, WS_XV = 288 * MiB,
                 WS_YB = 292 * MiB, WS_XQ = 324 * MiB, WS_XO = 332 * MiB, WS_ROUTE = 340 * MiB, WS_REGA = 342 * MiB, WS_REGB = 538 * MiB, WS_END = 776 * MiB;
constexpr size_t MISC_CS = 0, MISC_KMEAN = 128 * KiB, MISC_KCMP = 512 * KiB, MISC_VCMP = 1024 * KiB;
constexpr size_t RT_TOKE = 0, RT_TOKPOS = 128 * KiB, RT_TOKW = 256 * KiB, RT_TOKRSTD = 384 * KiB, RT_ROWTOK = 512 * KiB, RT_ROWW = 704 * KiB, RT_ROWRSTD = 896 * KiB, RT_TILEE = 1088 * KiB, RT_LCNT = 1152 * KiB;
constexpr size_t RA_UPOOL = 0, RA_QB = 16 * MiB, RA_KB = 40 * MiB, RA_VB = 64 * MiB;
constexpr size_t RA_QRAW = 0, RA_QROT = 32 * MiB, RA_ACMPK = 64 * MiB, RA_ACMPV = 80 * MiB, RA_KS = 96 * MiB, RA_VS = 104 * MiB, RA_KW = 112 * MiB, RA_VW = 120 * MiB,
                 RA_GATES = 128 * MiB, RA_CPART = 132 * MiB;
constexpr size_t RA_YMOE = 0, RA_XPERM = 128 * MiB;
constexpr int CW_BAR = 4096, CW_CNT = 8192;

constexpr int RING_BYTES = 131072, LDS_BYTES = 147456, LDSCTL_OFF = LDS_BYTES - 512, MISC_OFF = LDSCTL_OFF + 320;
constexpr int CONV_JOBS_OFF = 8 * 64 * 65 * 4, CONV_META_OFF = CONV_JOBS_OFF + 64 * 48;
static_assert(CONV_META_OFF + 64 <= LDSCTL_OFF, "LDS map");
constexpr int NWAVES = 8;

__device__ __forceinline__ unsigned f2bf(float f) { unsigned u = __builtin_bit_cast(unsigned, f); return (u + 0x7fffu + ((u >> 16) & 1u)) >> 16; }
__device__ __forceinline__ unsigned pk2(float lo, float hi) { f32x2 v = {lo, hi}; bf16x2_t b = __builtin_convertvector(v, bf16x2_t); return __builtin_bit_cast(unsigned, b); }
__device__ __forceinline__ float bf2f(unsigned short b) { return __builtin_bit_cast(float, (unsigned)b << 16); }
__device__ __forceinline__ float wave_sum(float v) {
#pragma unroll
    for (int o = 1; o < 64; o <<= 1) v += __shfl_xor(v, o);
    return v;
}
__device__ __forceinline__ float fast_exp2(float x) { return __builtin_amdgcn_exp2f(x); }
__device__ __forceinline__ float fast_rcp(float x) { return __builtin_amdgcn_rcpf(x); }
__device__ __forceinline__ float silu_f(float x) { return x * fast_rcp(1.f + fast_exp2(-1.4426950408889634f * x)); }
__device__ __forceinline__ float sigmoid_f(float x) { return fast_rcp(1.f + fast_exp2(-1.4426950408889634f * x)); }
__device__ __forceinline__ float gelu_tanh_f(float x) {
    const float u = 0.7978845608028654f * (x + 0.044715f * x * x * x);
    const float t = 1.f - 2.f * fast_rcp(1.f + fast_exp2(2.f * 1.4426950408889634f * u));
    return 0.5f * x * (1.f + t);
}
#define LDS_WAIT() asm volatile("s_waitcnt lgkmcnt(0)" ::: "memory")
__device__ __forceinline__ unsigned pk4_fp8(float a, float b, float c, float d) {
    a = __builtin_amdgcn_fmed3f(a, -448.f, 448.f); b = __builtin_amdgcn_fmed3f(b, -448.f, 448.f); c = __builtin_amdgcn_fmed3f(c, -448.f, 448.f); d = __builtin_amdgcn_fmed3f(d, -448.f, 448.f);
    int r = 0; r = __builtin_amdgcn_cvt_pk_fp8_f32(a, b, r, false); r = __builtin_amdgcn_cvt_pk_fp8_f32(c, d, r, true); return (unsigned)r;
}
constexpr float FP8_SW_GU = 64.f, FP8_SW_D = 128.f, FP8_SX = 4.f, FP8_SH = 8.f;
constexpr int E8(int e) { return (127 - e) * 0x01010101; }

namespace pg8 {
#define PG8_LAS __attribute__((address_space(3)))
constexpr int BM = 256, BK = 64, HALF = 128, HTB = HALF * BK * 2, NXCD = 8, WGM = 8;
__host__ __device__ __forceinline__ int lds_byte(int r, int c) { const int st = (r >> 4) * 2 + (c >> 5), rr = r & 15, cc = c & 31, ob = rr * 64 + cc * 2; return st * 1024 + (ob ^ (((ob >> 9) & 1) << 5)); }
__host__ __device__ __forceinline__ void stage_rc(int b, int& R, int& C) { const int st = b / 1024, sb = b % 1024, swz = sb ^ (((sb >> 9) & 1) << 5); R = (st >> 1) * 16 + swz / 64; C = (st & 1) * 32 + (swz % 64) / 2; }
__host__ __device__ __forceinline__ int perm32(int rho) { const int n = rho >> 4, i = rho & 15; return 8 * (i >> 2) + 4 * n + (i & 3); }

typedef int v8i32 __attribute__((ext_vector_type(8)));
typedef int v4i32 __attribute__((ext_vector_type(4)));
__device__ __forceinline__ bf16x8 half8(const v8i32& v, int k) { return k ? __builtin_bit_cast(bf16x8, __builtin_shufflevector(v, v, 4, 5, 6, 7)) : __builtin_bit_cast(bf16x8, __builtin_shufflevector(v, v, 0, 1, 2, 3)); }
struct Unit { int pm, pn, aux; size_t oa, ob; };
struct Gemm { const bf16* A; const bf16* Bt; int lda, ldb, K; };

struct StaticOrder {
    int nM, nN, nwg, G, c, lda, ldb;
    __device__ void init(int M, int N, int G_, int c_, int lda_, int ldb_) { nM = M / BM; nN = N / BM; nwg = nM * nN; G = G_; c = c_; lda = lda_; ldb = ldb_; }
    __device__ bool next(int i, Unit& u) const {
        const long L = (long)i * G + c; if (L >= nwg) return false;
        int wgid = (int)L; { const int q = nwg / NXCD, r = nwg % NXCD, xcd = wgid % NXCD, off = wgid / NXCD; wgid = (xcd < r ? xcd * (q + 1) : r * (q + 1) + (xcd - r) * q) + off; }
        const int nig = WGM * nN, gid = wgid / nig, fm = gid * WGM, gsz = (nM - fm) < WGM ? (nM - fm) : WGM;
        u.pm = fm + ((wgid % nig) % gsz); u.pn = (wgid % nig) / gsz; u.aux = 0;
        u.oa = (size_t)u.pm * BM * lda * 2; u.ob = (size_t)u.pn * BM * ldb * 2; return true;
    }
};

template <class Epi, class Sched, bool FP8 = false, int SCA = 0x7F7F7F7F, int SCB = 0x7F7F7F7F>
__device__ __forceinline__ void gemm_phase(PG8_LAS unsigned char* lds, const Gemm g, const Sched& S, const Epi& E, const int tid) {
    const int wid = __builtin_amdgcn_readfirstlane(tid >> 6), lane = tid & 63, wr = wid >> 2, wc = wid & 3, fr = lane & 15, fq = lane >> 4;
    const int K = g.K, nt = K / BK;
    unsigned voffA[2], voffB[2];
#pragma unroll
    for (int i = 0; i < 2; ++i) { int R, C; stage_rc(tid * 16 + i * 8192, R, C); const int Rb = Epi::PERM ? ((R & ~31) + perm32(R & 31)) : R;
        voffA[i] = (unsigned)(R * g.lda + C) * 2u; voffB[i] = (unsigned)(Rb * g.ldb + C) * 2u; }
    const size_t kstep = (size_t)(BK * 2);
    const size_t hstepA = (size_t)HALF * g.lda * 2, hstepB = (size_t)HALF * g.ldb * 2;
    const unsigned ldsw = (unsigned)wid * 1024u;
    const int aoff = lds_byte(wr * 64 + fr, fq * 8), boff = lds_byte(wc * 32 + fr, fq * 8);
#define PG8_SA(b, h) (((b) * 2 + (h)) * HTB)
#define PG8_SB(b, h) ((4 + (b) * 2 + (h)) * HTB)
#define PG8_STAGE(bufoff, gbase, voff) do { _Pragma("unroll") for (int _i = 0; _i < 2; ++_i) \
        __builtin_amdgcn_global_load_lds((const unsigned*)((const char*)(gbase) + (voff)[_i]), (PG8_LAS unsigned*)(lds + (bufoff) + ldsw + _i * 8192), 16, 0, 0); } while (0)
#define PG8_LDA(dst, b, h) do { _Pragma("unroll") for (int m = 0; m < 4; ++m) { const v4i32 x_ = *(const PG8_LAS v4i32*)(lds + PG8_SA(b, h) + aoff + m * 2048), y_ = *(const PG8_LAS v4i32*)(lds + PG8_SA(b, h) + aoff + m * 2048 + 1024); dst[m] = __builtin_shufflevector(x_, y_, 0, 1, 2, 3, 4, 5, 6, 7); } } while (0)
#define PG8_LDB(dst, b, h) do { _Pragma("unroll") for (int n = 0; n < 2; ++n) { const v4i32 x_ = *(const PG8_LAS v4i32*)(lds + PG8_SB(b, h) + boff + n * 2048), y_ = *(const PG8_LAS v4i32*)(lds + PG8_SB(b, h) + boff + n * 2048 + 1024); dst[n] = __builtin_shufflevector(x_, y_, 0, 1, 2, 3, 4, 5, 6, 7); } } while (0)
#define PG8_MMA(ai, bj, At, Bt) do { __builtin_amdgcn_s_setprio(1); _Pragma("unroll") for (int m = 0; m < 4; ++m) _Pragma("unroll") for (int n = 0; n < 2; ++n) { \
        if constexpr (FP8) { asm volatile("v_mfma_scale_f32_16x16x128_f8f6f4 %0, %1, %2, %0, %3, %4 op_sel_hi:[0,0,0]" : "+v"(acc[ai][bj][m][n]) : "v"(Bt[n]), "v"(At[m]), "v"(sca_), "v"(scb_)); } \
        else { _Pragma("unroll") for (int k = 0; k < 2; ++k) acc[ai][bj][m][n] = __builtin_amdgcn_mfma_f32_16x16x32_bf16(half8(Bt[n], k), half8(At[m], k), acc[ai][bj][m][n], 0, 0, 0); } } \
        __builtin_amdgcn_s_setprio(0); } while (0)
#define PG8_WAIT_V(n) asm volatile("s_waitcnt vmcnt(" #n ")" ::: "memory")
#define PG8_WAIT_L(n) asm volatile("s_waitcnt lgkmcnt(" #n ")" ::: "memory")
#define PG8_BAR __builtin_amdgcn_s_barrier()
#define PG8_SCHED __builtin_amdgcn_sched_barrier(0)
    Unit cur, nxt; int ui = 0;
    if (!S.next(0, cur)) return;
    int sca_ = SCA, scb_ = SCB; if constexpr (FP8) asm volatile("" : "+v"(sca_), "+v"(scb_));
    f32x4 acc[2][2][4][2];
#pragma unroll
    for (int a = 0; a < 2; ++a)
#pragma unroll
        for (int b = 0; b < 2; ++b)
#pragma unroll
            for (int m = 0; m < 4; ++m)
#pragma unroll
                for (int n = 0; n < 2; ++n) acc[a][b][m][n] = (f32x4){0.f, 0.f, 0.f, 0.f};
    v8i32 At[4], B0[2], B1[2];
    const char* cA = (const char*)g.A + cur.oa; const char* cB = (const char*)g.Bt + cur.ob;
    PG8_STAGE(PG8_SB(0, 0), cB, voffB); PG8_STAGE(PG8_SB(0, 1), cB + hstepB, voffB); PG8_STAGE(PG8_SA(0, 0), cA, voffA); PG8_STAGE(PG8_SA(0, 1), cA + hstepA, voffA);
    if (wr == 1) PG8_BAR;
    PG8_WAIT_V(2); PG8_BAR;
    PG8_STAGE(PG8_SB(1, 0), cB + kstep, voffB); PG8_STAGE(PG8_SA(1, 0), cA + kstep, voffA); PG8_STAGE(PG8_SB(1, 1), cB + hstepB + kstep, voffB);
    PG8_WAIT_V(6); PG8_BAR;
    for (;;) {
        const bool has_next = S.next(ui + 1, nxt);
        const char* nA = has_next ? (const char*)g.A + nxt.oa : cA; const char* nB = has_next ? (const char*)g.Bt + nxt.ob : cB;
#pragma nounroll
        for (int t = 0; t < nt; t += 2) {
            const bool last = (t == nt - 2);
            const char* a1 = cA + (size_t)(t + 1) * kstep;
            const char* a2 = last ? nA : cA + (size_t)(t + 2) * kstep; const char* b2 = last ? nB : cB + (size_t)(t + 2) * kstep;
            const char* a3 = a2 + kstep; const char* b3 = b2 + kstep;
            PG8_LDB(B0, 0, 0); PG8_LDB(B1, 0, 1); PG8_SCHED; PG8_LDA(At, 0, 0); PG8_STAGE(PG8_SA(1, 1), a1 + hstepA, voffA);
            PG8_WAIT_V(8); PG8_WAIT_L(0); PG8_BAR; PG8_MMA(0, 0, At, B0); PG8_MMA(0, 1, At, B1); PG8_BAR; PG8_SCHED;
            PG8_LDA(At, 0, 1); PG8_STAGE(PG8_SB(0, 0), b2, voffB); PG8_STAGE(PG8_SB(0, 1), b2 + hstepB, voffB); PG8_STAGE(PG8_SA(0, 0), a2, voffA);
            PG8_WAIT_V(8); PG8_WAIT_L(0); PG8_BAR; PG8_MMA(1, 0, At, B0); PG8_MMA(1, 1, At, B1); PG8_BAR; PG8_SCHED;
            PG8_LDB(B0, 1, 0); PG8_LDB(B1, 1, 1); PG8_SCHED; PG8_LDA(At, 1, 0); PG8_STAGE(PG8_SA(0, 1), a2 + hstepA, voffA);
            PG8_WAIT_V(8); PG8_WAIT_L(0); PG8_BAR; PG8_MMA(0, 0, At, B0); PG8_MMA(0, 1, At, B1); PG8_BAR; PG8_SCHED;
            PG8_LDA(At, 1, 1); PG8_STAGE(PG8_SB(1, 0), b3, voffB); PG8_STAGE(PG8_SB(1, 1), b3 + hstepB, voffB); PG8_STAGE(PG8_SA(1, 0), a3, voffA);
            PG8_WAIT_V(8); PG8_WAIT_L(0); PG8_BAR; PG8_MMA(1, 0, At, B0); PG8_MMA(1, 1, At, B1); PG8_BAR; PG8_SCHED;
        }
        if (wr == 0) PG8_BAR;
        { int l_ = threadIdx.x; asm volatile("" : "+v"(l_)); const int fr_ = l_ & 15, fq_ = (l_ >> 4) & 3; E(acc, cur, wr, wc, fr_, fq_); }
        if (!has_next) break;
#pragma unroll
        for (int a = 0; a < 2; ++a)
#pragma unroll
            for (int b = 0; b < 2; ++b)
#pragma unroll
                for (int m = 0; m < 4; ++m)
#pragma unroll
                    for (int n = 0; n < 2; ++n) acc[a][b][m][n] = (f32x4){0.f, 0.f, 0.f, 0.f};
        cur = nxt; cA = nA; cB = nB; ++ui;
        if (wr == 1) PG8_BAR;
    }
    PG8_WAIT_V(0);
    PG8_BAR;
#undef PG8_SA
#undef PG8_SB
#undef PG8_STAGE
#undef PG8_LDA
#undef PG8_LDB
#undef PG8_MMA
#undef PG8_WAIT_V
#undef PG8_WAIT_L
#undef PG8_BAR
#undef PG8_SCHED
}

typedef f32x4 Acc[2][2][4][2];

__device__ __forceinline__ void load_rstd(const float* ssq, int row0, int fq, float (&rs)[2][4]) {
#pragma unroll
    for (int ai = 0; ai < 2; ++ai)
#pragma unroll
        for (int m = 0; m < 4; ++m) {
            const float* p = ssq + (size_t)(fq * 4) * MTOK + row0 + ai * HALF + m * 16;
            float s = (p[0] + p[MTOK]) + (p[2 * MTOK] + p[3 * MTOK]);
            s += __shfl_xor(s, 16); s += __shfl_xor(s, 32);
            rs[ai][m] = rsqrtf(s * (1.f / DM) + NORM_EPS);
        }
}
__device__ __forceinline__ float row_rstd(const float* ssq, int row, int fq) {
    const float* p = ssq + (size_t)(fq * 4) * MTOK + row;
    float s = (p[0] + p[MTOK]) + (p[2 * MTOK] + p[3 * MTOK]);
    s += __shfl_xor(s, 16); s += __shfl_xor(s, 32);
    return rsqrtf(s * (1.f / DM) + NORM_EPS);
}
__device__ __forceinline__ u32x4 pack8(const f32x4& a, const f32x4& b) { u32x4 w; w.x = pk2(a[0], a[1]); w.y = pk2(a[2], a[3]); w.z = pk2(b[0], b[1]); w.w = pk2(b[2], b[3]); return w; }
__device__ __forceinline__ void rope8(f32x4& v0, f32x4& v1, const float* cs, int fq) {
    const f32x4 c0 = *(const f32x4*)(cs), c1 = *(const f32x4*)(cs + 4), s0 = *(const f32x4*)(cs + 8), s1 = *(const f32x4*)(cs + 12);
    f32x4 p0, p1;
#pragma unroll
    for (int e = 0; e < 4; ++e) { p0[e] = __shfl_xor(v0[e], 16); p1[e] = __shfl_xor(v1[e], 16); }
    if (fq == 0) { v0 = v0 * c0 - p0 * s0; v1 = v1 * c1 - p1 * s1; }
    else if (fq == 1) { v0 = p0 * s0 + v0 * c0; v1 = p1 * s1 + v1 * c1; }
}

struct EpiInAB {
    static constexpr bool PERM = true;
    const float* ssq; const float* cs; unsigned char* ra; float* kpart;
    __device__ __forceinline__ void operator()(const Acc& acc, const Unit& u, int wr, int wc, int fr, int fq) const {
        const int row0 = u.pm * BM + wr * 64 + fr;
        float rs[2][4]; load_rstd(ssq, row0, fq, rs);
        if (u.pn == 0) {
#pragma unroll
            for (int ai = 0; ai < 2; ++ai)
#pragma unroll
                for (int m = 0; m < 4; ++m) { const int row = row0 + ai * HALF + m * 16; float* rp = (float*)(ra + RA_UPOOL) + (size_t)row * 256 + wc * 32 + fq * 8;
#pragma unroll
                    for (int bj = 0; bj < 2; ++bj) { *(f32x4*)(rp + bj * HALF) = acc[ai][bj][m][0] * rs[ai][m]; *(f32x4*)(rp + bj * HALF + 4) = acc[ai][bj][m][1] * rs[ai][m]; } }
        } else {
            const int t = (u.pn - 1) / 3, cb = ((u.pn - 1) % 3) * 256;
            bf16* dst = (bf16*)(ra + RA_QB + (size_t)t * (RA_KB - RA_QB));
            const bool rope = (t < 2) && ((wc & 1) == 0);
#pragma unroll
            for (int ai = 0; ai < 2; ++ai)
#pragma unroll
                for (int m = 0; m < 4; ++m) { const int row = row0 + ai * HALF + m * 16; bf16* rp = dst + (size_t)row * MOBA_DIMC + cb + wc * 32 + fq * 8;
                    const float* csr = cs + (size_t)(row & (SEQ - 1)) * 16;
#pragma unroll
                    for (int bj = 0; bj < 2; ++bj) { f32x4 v0 = acc[ai][bj][m][0] * rs[ai][m], v1 = acc[ai][bj][m][1] * rs[ai][m];
                        if (rope) rope8(v0, v1, csr, fq);
                        *(u32x4*)(rp + bj * HALF) = pack8(v0, v1); } }
            if (t == 1) {
                asm volatile("s_waitcnt vmcnt(0)" ::: "memory");
                const int lane_ = fq * 16 + fr, cl = cb + (lane_ >> 5) * HALF + wc * 32 + (lane_ & 31);
                const bf16* kp = dst + (size_t)(u.pm * BM + wr * 64) * MOBA_DIMC + cl; float sum = 0.f;
#pragma unroll 1
                for (int ai = 0; ai < 2; ++ai)
#pragma unroll 16
                    for (int rr = 0; rr < 64; ++rr) sum += bf2f(kp[(size_t)(ai * HALF + rr) * MOBA_DIMC]);
                kpart[(size_t)(u.pm * 2 + wr) * MOBA_DIMC + cl] = sum;
            }
        }
    }
};

struct EpiInC {
    static constexpr bool PERM = true;
    const float* ssq; const float* cs; unsigned char* ra; const float* pek; const float* pev;
    __device__ __forceinline__ void operator()(const Acc& acc, const Unit& u, int wr, int wc, int fr, int fq) const {
        const int row0 = u.pm * BM + wr * 64 + fr;
        const int pn = u.pn;
        const bool rope = ((wc & 1) == 0);
        if (pn < 4) {
#pragma unroll
            for (int ai = 0; ai < 2; ++ai)
#pragma unroll
                for (int m = 0; m < 4; ++m) { const int row = row0 + ai * HALF + m * 16; const float rsv = row_rstd(ssq, row, fq); const size_t off = (size_t)row * DM + pn * 256 + wc * 32 + fq * 8;
                    const float* csr = cs + (size_t)(row & (SEQ - 1)) * 16;
#pragma unroll
                    for (int bj = 0; bj < 2; ++bj) { f32x4 v0 = acc[ai][bj][m][0] * rsv, v1 = acc[ai][bj][m][1] * rsv;
                        *(u32x4*)((bf16*)(ra + RA_QRAW) + off + bj * HALF) = pack8(v0, v1);
                        if (rope) rope8(v0, v1, csr, fq);
                        *(u32x4*)((bf16*)(ra + RA_QROT) + off + bj * HALF) = pack8(v0, v1); } }
        } else if (pn < 6) {
            bf16* ac = (bf16*)(ra + RA_ACMPK + (size_t)(pn - 4) * (RA_ACMPV - RA_ACMPK)); const float* pe = pek + (ptrdiff_t)(pn - 4) * (pev - pek);
#pragma unroll
            for (int ai = 0; ai < 2; ++ai)
#pragma unroll
                for (int m = 0; m < 4; ++m) { const int row = row0 + ai * HALF + m * 16; const float rsv = row_rstd(ssq, row, fq); const int b = row >> 11, t = row & (SEQ - 1);
#pragma unroll
                    for (int bj = 0; bj < 2; ++bj) { const int c = bj * HALF + wc * 32 + fq * 8, gi = c >> 6, d = c & 63;
                        const f32x4 v0 = acc[ai][bj][m][0] * rsv, v1 = acc[ai][bj][m][1] * rsv;
                        const int n1 = t >> 4, l1 = t & 15;
                        if (n1 <= 126) { const float* pp = pe + l1 * 64 + d; const f32x4 a0 = v0 + *(const f32x4*)pp, a1 = v1 + *(const f32x4*)(pp + 4);
                            *(u32x4*)(ac + ((size_t)((b * 4 + gi) * 128 + n1)) * 2048 + l1 * 64 + d) = pack8(a0, a1); }
                        const int n2 = n1 - 1, l2 = l1 + 16;
                        if (n2 >= 0) { const float* pp = pe + l2 * 64 + d; const f32x4 a0 = v0 + *(const f32x4*)pp, a1 = v1 + *(const f32x4*)(pp + 4);
                            *(u32x4*)(ac + ((size_t)((b * 4 + gi) * 128 + n2)) * 2048 + l2 * 64 + d) = pack8(a0, a1); } } }
        } else if (pn < 10) {
            bf16* dst = (bf16*)(ra + RA_KS + (size_t)(pn - 6) * (RA_VS - RA_KS));
            const bool rp_ = rope && ((pn & 1) == 0);
#pragma unroll
            for (int ai = 0; ai < 2; ++ai)
#pragma unroll
                for (int m = 0; m < 4; ++m) { const int row = row0 + ai * HALF + m * 16; const float rsv = row_rstd(ssq, row, fq); bf16* rp = dst + (size_t)row * 256 + wc * 32 + fq * 8;
                    const float* csr = cs + (size_t)(row & (SEQ - 1)) * 16;
#pragma unroll
                    for (int bj = 0; bj < 2; ++bj) { f32x4 v0 = acc[ai][bj][m][0] * rsv, v1 = acc[ai][bj][m][1] * rsv;
                        if (rp_) rope8(v0, v1, csr, fq);
                        *(u32x4*)(rp + bj * HALF) = pack8(v0, v1); } }
        } else {
            const int c = wc * 32 + fq * 8;
#pragma unroll
            for (int ai = 0; ai < 2; ++ai)
#pragma unroll
                for (int m = 0; m < 4; ++m) { const int row = row0 + ai * HALF + m * 16; const float rsv = row_rstd(ssq, row, fq); float* gp = (float*)(ra + RA_GATES) + (size_t)row * 48 + c;
                    f32x4 v0 = acc[ai][0][m][0] * rsv, v1 = acc[ai][0][m][1] * rsv;
#pragma unroll
                    for (int e = 0; e < 4; ++e) { v0[e] = sigmoid_f(v0[e]); v1[e] = sigmoid_f(v1[e]); }
                    if (c < 48) { *(f32x4*)gp = v0; *(f32x4*)(gp + 4) = v1; } }
        }
    }
};

struct EpiRes {
    static constexpr bool PERM = true;
    bf16* xb; float* ssq;
    __device__ __forceinline__ void operator()(const Acc& acc, const Unit& u, int wr, int wc, int fr, int fq) const {
        const int row0 = u.pm * BM + wr * 64 + fr;
#pragma unroll
        for (int ai = 0; ai < 2; ++ai)
#pragma unroll
            for (int m = 0; m < 4; ++m) { const int row = row0 + ai * HALF + m * 16; const size_t off = (size_t)row * DM + u.pn * 256 + wc * 32 + fq * 8; float ss = 0.f;
#pragma unroll
                for (int bj = 0; bj < 2; ++bj) { bf16* xp = xb + off + bj * HALF; const u32x4 o = *(const u32x4*)xp;
                    const f32x4 x0 = {__builtin_bit_cast(float, o.x << 16), __builtin_bit_cast(float, o.x & 0xffff0000u), __builtin_bit_cast(float, o.y << 16), __builtin_bit_cast(float, o.y & 0xffff0000u)};
                    const f32x4 x1 = {__builtin_bit_cast(float, o.z << 16), __builtin_bit_cast(float, o.z & 0xffff0000u), __builtin_bit_cast(float, o.w << 16), __builtin_bit_cast(float, o.w & 0xffff0000u)};
                    const f32x4 v0 = x0 + acc[ai][bj][m][0], v1 = x1 + acc[ai][bj][m][1];
                    *(u32x4*)xp = pack8(v0, v1);
                    ss += (v0[0] * v0[0] + v0[1] * v0[1]) + (v0[2] * v0[2] + v0[3] * v0[3]) + (v1[0] * v1[0] + v1[1] * v1[1]) + (v1[2] * v1[2] + v1[3] * v1[3]); }
                ss += __shfl_xor(ss, 16); ss += __shfl_xor(ss, 32);
                if (fq == 0) ssq[(size_t)(u.pn * 4 + wc) * MTOK + row] = ss; }
    }
};

struct EpiXQ {
    static constexpr bool PERM = true;
    const float* ssq; bf16* o;
    __device__ __forceinline__ void operator()(const Acc& acc, const Unit& u, int wr, int wc, int fr, int fq) const {
        const int row0 = u.pm * BM + wr * 64 + fr;
        float rs[2][4]; load_rstd(ssq, row0, fq, rs);
#pragma unroll
        for (int ai = 0; ai < 2; ++ai)
#pragma unroll
            for (int m = 0; m < 4; ++m) { const int row = row0 + ai * HALF + m * 16; bf16* rp = o + (size_t)row * 256 + wc * 32 + fq * 8;
#pragma unroll
                for (int bj = 0; bj < 2; ++bj) *(u32x4*)(rp + bj * HALF) = pack8(acc[ai][bj][m][0] * rs[ai][m], acc[ai][bj][m][1] * rs[ai][m]); }
    }
};

struct EpiXKV {
    static constexpr bool PERM = true;
    bf16* xk; bf16* xv;
    __device__ __forceinline__ void operator()(const Acc& acc, const Unit& u, int wr, int wc, int fr, int fq) const {
        const int row0 = u.pm * BM + wr * 64 + fr;
        bf16* dst = xk + (size_t)(u.pn & 1) * (size_t)(xv - xk) + (size_t)(u.pn >> 1) * (NB * MEML * 256);
#pragma unroll
        for (int ai = 0; ai < 2; ++ai)
#pragma unroll
            for (int m = 0; m < 4; ++m) { const int row = row0 + ai * HALF + m * 16; bf16* rp = dst + (size_t)row * 256 + wc * 32 + fq * 8;
#pragma unroll
                for (int bj = 0; bj < 2; ++bj) *(u32x4*)(rp + bj * HALF) = pack8(acc[ai][bj][m][0], acc[ai][bj][m][1]); }
    }
};

template <bool MOE> struct EpiGateUp {
    static constexpr bool PERM = true;
    const float* ssq; bf16* h; int ldh;
    __device__ __forceinline__ void operator()(const Acc& acc, const Unit& u, int wr, int wc, int fr, int fq) const {
        const int row0 = u.pm * BM + wr * 64 + fr;
#pragma unroll
        for (int ai = 0; ai < 2; ++ai)
#pragma unroll
            for (int m = 0; m < 4; ++m) { const int row = row0 + ai * HALF + m * 16; float r = 1.f; if constexpr (!MOE) r = row_rstd(ssq, row, fq);
                f32x4 o0, o1;
#pragma unroll
                for (int e = 0; e < 4; ++e) { o0[e] = silu_f(acc[ai][0][m][0][e] * r) * (acc[ai][1][m][0][e] * r); o1[e] = silu_f(acc[ai][0][m][1][e] * r) * (acc[ai][1][m][1][e] * r); }
                if constexpr (MOE) { u32x2 w; w.x = pk4_fp8(o0[0] * FP8_SH, o0[1] * FP8_SH, o0[2] * FP8_SH, o0[3] * FP8_SH); w.y = pk4_fp8(o1[0] * FP8_SH, o1[1] * FP8_SH, o1[2] * FP8_SH, o1[3] * FP8_SH);
                    *(u32x2*)((unsigned char*)h + (size_t)row * ldh + u.pn * 128 + wc * 32 + fq * 8) = w; }
                else *(u32x4*)(h + (size_t)row * ldh + u.pn * 128 + wc * 32 + fq * 8) = pack8(o0, o1); }
    }
};

struct EpiMoeDown {
    static constexpr bool PERM = true;
    const int* rowtok; const float* roww; bf16* ymoe;
    __device__ __forceinline__ void operator()(const Acc& acc, const Unit& u, int wr, int wc, int fr, int fq) const {
        const int row0 = u.pm * BM + wr * 64 + fr;
#pragma unroll
        for (int ai = 0; ai < 2; ++ai)
#pragma unroll
            for (int m = 0; m < 4; ++m) { const int row = row0 + ai * HALF + m * 16; const int tk = rowtok[row];
                if (tk >= 0) { const float w = roww[row]; bf16* yp = ymoe + ((size_t)(tk & 1) * MTOK + (tk >> 1)) * DM + u.pn * 256 + wc * 32 + fq * 8;
#pragma unroll
                    for (int bj = 0; bj < 2; ++bj) *(u32x4*)(yp + bj * HALF) = pack8(acc[ai][bj][m][0] * w, acc[ai][bj][m][1] * w); } }
    }
};

struct EpiCmpPart {
    static constexpr bool PERM = true;
    float* cpart;
    __device__ __forceinline__ void operator()(const Acc& acc, const Unit& u, int wr, int wc, int fr, int fq) const {
        const int row0 = u.pm * BM + wr * 64 + fr;
        float* base = cpart + (size_t)u.aux * 4096 * 128;
#pragma unroll
        for (int ai = 0; ai < 2; ++ai)
#pragma unroll
            for (int m = 0; m < 4; ++m) { const int row = row0 + ai * HALF + m * 16; unsigned short* rp = (unsigned short*)base + (size_t)row * 256 + wc * 32 + fq * 8;
#pragma unroll
                for (int bj = 0; bj < 2; ++bj) *(u32x4*)(rp + bj * HALF) = pack8(acc[ai][bj][m][0], acc[ai][bj][m][1]); }
    }
};

struct CmpOrder {
    int G, c;
    __device__ bool next(int i, Unit& u) const {
        const long L = (long)i * G + c; if (L >= 2 * CMP_SPLIT * 16) return false;
        const int t = (int)L / (CMP_SPLIT * 16), s = ((int)L / 16) % CMP_SPLIT, pm = (int)L % 16;
        u.pm = pm; u.pn = 0; u.aux = t * CMP_SPLIT + s;
        u.oa = ((size_t)(t * 4096 + pm * 256) * 2048 + s * 256) * 2; u.ob = ((size_t)(t * 256) * 2048 + s * 256) * 2; return true;
    }
};
struct MoeOrder {
    const int* tile_e; int nN, G, c, lda, ldb, nper;
    __device__ bool next(int i, Unit& u) const {
        const int nt = __builtin_amdgcn_readfirstlane(tile_e[MOE_MAX_TILES]);
        const long L = (long)i * G + c; if (L >= (long)nt * nN) return false;
        const int pm = (int)(L / nN), pn = (int)(L % nN), e = __builtin_amdgcn_readfirstlane(tile_e[pm]);
        u.pm = pm; u.pn = pn; u.aux = e; u.oa = (size_t)pm * BM * lda * 2; u.ob = ((size_t)e * nper + (size_t)pn * BM) * ldb * 2; return true;
    }
};
}

namespace att {
constexpr int KP = 128, TILE_B = 64 * KP;
constexpr int NSLOT = 4;
constexpr int KV_BYTES = 2 * NSLOT * TILE_B;
#define MFMA32(a, b, c) __builtin_amdgcn_mfma_f32_32x32x16_bf16((a), (b), (c), 0, 0, 0)
typedef short v4i16_t __attribute__((ext_vector_type(4)));
__device__ __forceinline__ void glds16(const void* gsrc, unsigned lds_dst) { unsigned keep;
    asm volatile("s_mov_b32 %0, m0\n\ts_mov_b32 m0, %2\n\ts_nop 0\n\tglobal_load_lds_dwordx4 %1, off\n\ts_mov_b32 m0, %0" : "=&s"(keep) : "v"(gsrc), "s"(lds_dst) : "memory"); }
__device__ __forceinline__ s16x4 vtr(const LAS unsigned char* p) { return __builtin_bit_cast(s16x4, __builtin_amdgcn_ds_read_tr16_b64_v4i16((LAS v4i16_t*)p)); }
__device__ __forceinline__ bf16x8 packp(const f32x16& x, int s) {
    u32x4 p; p.x = pk2(x[8 * s], x[8 * s + 1]); p.y = pk2(x[8 * s + 2], x[8 * s + 3]); p.z = pk2(x[8 * s + 4], x[8 * s + 5]); p.w = pk2(x[8 * s + 6], x[8 * s + 7]);
    return __builtin_bit_cast(bf16x8, p);
}
__device__ __forceinline__ short ov_bits(int n, int j) {
    const int jn = n >> 2, q = n & 3;
    if (q < 3) return (jn == j) ? (short)0x3F80 : (short)0;
    return (jn == j || jn + 1 == j) ? (short)0x3F00 : (short)0;
}

__device__ __forceinline__ float max3f(float a, float b, float c) { float r; asm("v_max3_f32 %0, %1, %2, %3" : "=v"(r) : "v"(a), "v"(b), "v"(c)); return r; }
__device__ __forceinline__ float max2f(float a, float b) { float r; asm("v_max_f32_e32 %0, %1, %2" : "=v"(r) : "v"(a), "v"(b)); return r; }
__device__ __forceinline__ float max2f_after_mfma(float a, float b) { float r; asm volatile("s_nop 15\n\ts_nop 7\n\tv_max_f32_e32 %0, %1, %2" : "=v"(r) : "v"(a), "v"(b)); return r; }
struct State { f32x16 o0, o1, o2; float m, l; };
__device__ __forceinline__ void reset(State& s) {
#pragma unroll
    for (int i = 0; i < 16; ++i) { s.o0[i] = 0.f; s.o1[i] = 0.f; s.o2[i] = 0.f; }
    s.m = -1e30f; s.l = 0.f;
}

template <class MK, bool OV>
__device__ __forceinline__ void flash_run(LAS unsigned char* kv, const bf16* Kg, const bf16* Vg, int ld, int jlo, int jhi, const bf16x8 (&qf)[4], State& st, const MK& mk, const int tid) {
    const int lane = tid & 63, r = lane & 31, h = lane >> 5, blk16 = (lane >> 4) & 1, q4 = (lane & 15) >> 2, p4 = lane & 3;
    const int wv = __builtin_amdgcn_readfirstlane(tid >> 6);
    const int skey = tid >> 3, sch = (tid & 7) ^ (skey & 7);
    const size_t goff = ((size_t)skey * ld + sch * 8) * 2;
    const unsigned kvb = (unsigned)(__UINTPTR_TYPE__)kv + (unsigned)wv * 1024u;
#define FL_DMA(jt, slot) do { const size_t tb_ = (size_t)(64 * (jt)) * ld * 2 + goff; \
        glds16((const char*)Kg + tb_, (unsigned)__builtin_amdgcn_readfirstlane(kvb + (unsigned)(slot) * TILE_B)); \
        glds16((const char*)Vg + tb_, (unsigned)__builtin_amdgcn_readfirstlane(kvb + (unsigned)(NSLOT + (slot)) * TILE_B)); } while (0)
#define FL_NEXT(x) do { ++(x); while ((x) < jhi && !mk.active(x)) ++(x); } while (0)
    int j = jlo; while (j < jhi && !mk.active(j)) ++j;
    if (j >= jhi) return;
    int jp = j, np = 0, nc = 0;
#pragma unroll
    for (int k = 0; k < NSLOT - 1; ++k) if (jp < jhi) { FL_DMA(jp, np & (NSLOT - 1)); ++np; FL_NEXT(jp); }
    bf16x8 q0 = qf[0], q1 = qf[1], q2 = qf[2], q3 = qf[3]; asm volatile("" : "+v"(q0), "+v"(q1), "+v"(q2), "+v"(q3));
    const int sw = r & 7;
    unsigned kro[4];
#pragma unroll
    for (int ks = 0; ks < 4; ++ks) kro[ks] = (unsigned)(r * KP + (((2 * ks + h) ^ sw) << 4));
    const int vsw = 4 * h + q4;
    const unsigned vro0 = (unsigned)(vsw * KP + (((2 * blk16 + (p4 >> 1)) ^ vsw) << 4) + 8 * (p4 & 1));
    const unsigned vro1 = (unsigned)(vsw * KP + (((4 + 2 * blk16 + (p4 >> 1)) ^ vsw) << 4) + 8 * (p4 & 1));
#pragma nounroll
    for (;;) {
        { const int younger = np - nc - 1;
          if (younger >= 2) asm volatile("s_waitcnt vmcnt(4)" ::: "memory"); else if (younger == 1) asm volatile("s_waitcnt vmcnt(2)" ::: "memory"); else asm volatile("s_waitcnt vmcnt(0)" ::: "memory"); }
        __syncthreads();
        if (jp < jhi) { FL_DMA(jp, np & (NSLOT - 1)); ++np; FL_NEXT(jp); }
        const int cur = nc & (NSLOT - 1);
        const int kind = mk.kind(j);
        if (kind != 0) {
            const LAS unsigned char* Kb = kv + cur * TILE_B; const LAS unsigned char* Vb = kv + (NSLOT + cur) * TILE_B;
            f32x16 s0, s1;
#pragma unroll
            for (int i = 0; i < 16; ++i) { s0[i] = 0.f; s1[i] = 0.f; }
#pragma unroll
            for (int ks = 0; ks < 4; ++ks) {
                const bf16x8 k0 = *(const LAS bf16x8*)(Kb + kro[ks]), k1 = *(const LAS bf16x8*)(Kb + kro[ks] + 32 * KP);
                const bf16x8 qk = ks == 0 ? q0 : (ks == 1 ? q1 : (ks == 2 ? q2 : q3));
                s0 = MFMA32(k0, qk, s0); s1 = MFMA32(k1, qk, s1);
            }
            if (kind == 2) {
#pragma unroll
                for (int i = 0; i < 16; ++i) { const int kk = (i & 3) + 8 * (i >> 2) + 4 * h; if (!mk.ok(j, kk)) s0[i] = -INFINITY; if (!mk.ok(j, kk + 32)) s1[i] = -INFINITY; }
            }
            float mx = max2f_after_mfma(s0[0], s1[0]);
#pragma unroll
            for (int i = 1; i < 16; ++i) mx = max3f(mx, s0[i], s1[i]);
            const bool lok = (kind != 3) || mk.lane_ok(j);
            if (!lok) mx = -INFINITY;
            mx = fmaxf(mx, __shfl_xor(mx, 32));
            const float mn = fmaxf(st.m, mx * C2);
            if (!__all(mn - st.m <= 8.f)) {
                const float alpha = fast_exp2(st.m - mn); st.m = mn;
                st.l = st.l * alpha; st.o0 = st.o0 * alpha; st.o1 = st.o1 * alpha; if (OV) st.o2 = st.o2 * alpha;
            }
            const float nm = lok ? -st.m : -INFINITY;
            float ps = 0.f;
#pragma unroll
            for (int i = 0; i < 16; ++i) { s0[i] = fast_exp2(__builtin_fmaf(s0[i], C2, nm)); s1[i] = fast_exp2(__builtin_fmaf(s1[i], C2, nm)); ps += s0[i] + s1[i]; }
            ps += __shfl_xor(ps, 32);
            st.l += ps;
#pragma unroll
            for (int hf = 0; hf < 2; ++hf)
#pragma unroll
                for (int s = 0; s < 2; ++s) {
                    const bf16x8 pf = packp(hf ? s1 : s0, s);
                    const LAS unsigned char* vb = Vb + (32 * hf + 16 * s) * KP;
                    const s16x4 l0 = vtr(vb + vro0), h0 = vtr(vb + vro0 + 8 * KP), l1 = vtr(vb + vro1), h1 = vtr(vb + vro1 + 8 * KP);
                    st.o0 = MFMA32(__builtin_shufflevector(l0, h0, 0, 1, 2, 3, 4, 5, 6, 7), pf, st.o0);
                    st.o1 = MFMA32(__builtin_shufflevector(l1, h1, 0, 1, 2, 3, 4, 5, 6, 7), pf, st.o1);
                    if (OV) {
                        int r_ = r; asm volatile("" : "+v"(r_));
                        const int jnA = 16 * j + 8 * hf + 4 * s + h - r_, jnB = jnA + 2;
                        u32x4 a;
                        a.x = (jnA == 0) ? 0x3F803F80u : 0u; a.y = ((jnA == 0) ? 0x00003F80u : 0u) | ((jnA == 0 || jnA == -1) ? 0x3F000000u : 0u);
                        a.z = (jnB == 0) ? 0x3F803F80u : 0u; a.w = ((jnB == 0) ? 0x00003F80u : 0u) | ((jnB == 0 || jnB == -1) ? 0x3F000000u : 0u);
                        st.o2 = MFMA32(__builtin_bit_cast(bf16x8, a), pf, st.o2); }
                }
        }
        ++nc; FL_NEXT(j);
        if (j >= jhi) break;
    }
    __syncthreads();
#undef FL_NEXT
#undef FL_DMA
}

__device__ __forceinline__ void load_q(bf16x8 (&qf)[4], const bf16* qrow, int h) {
#pragma unroll
    for (int ks = 0; ks < 4; ++ks) qf[ks] = *(const bf16x8*)(qrow + ks * 16 + h * 8);
}
__device__ __forceinline__ void store_o(bf16* orow, const f32x16& o0, const f32x16& o1, float sc, int h) {
#pragma unroll
    for (int g = 0; g < 4; ++g) {
        u32x2 a, b; a.x = pk2(o0[4 * g] * sc, o0[4 * g + 1] * sc); a.y = pk2(o0[4 * g + 2] * sc, o0[4 * g + 3] * sc);
        b.x = pk2(o1[4 * g] * sc, o1[4 * g + 1] * sc); b.y = pk2(o1[4 * g + 2] * sc, o1[4 * g + 3] * sc);
        *(u32x2*)(orow + 8 * g + 4 * h) = a; *(u32x2*)(orow + 32 + 8 * g + 4 * h) = b;
    }
}

struct NoMask { __device__ __forceinline__ bool active(int) const { return true; } __device__ __forceinline__ int kind(int) const { return 1; } __device__ __forceinline__ bool ok(int, int) const { return true; } __device__ __forceinline__ bool lane_ok(int) const { return true; } };
struct MobaMask {
    int qb, wq0, tq; unsigned sel, uni;
    __device__ __forceinline__ bool active(int jt) const { const int jb = jt >> 2; return jb >= qb || ((uni >> jb) & 1u); }
    __device__ __forceinline__ int kind(int jt) const { const int jb = jt >> 2; if (jb < qb) { const bool s_ = (sel >> jb) & 1u; return __all(s_) ? 1 : (__any(s_) ? 3 : 0); } const int k0 = (jt & 3) * 64; if (k0 > wq0 + 31) return 0; if (k0 + 63 <= wq0) return 1; return 2; }
    __device__ __forceinline__ bool ok(int jt, int kk) const { return (jt & 3) * 64 + kk <= tq; }
    __device__ __forceinline__ bool lane_ok(int jt) const { return (sel >> (jt >> 2)) & 1u; }
};
struct CmpMask {
    int nmax, nlo, nhi;
    __device__ __forceinline__ bool active(int) const { return true; }
    __device__ __forceinline__ int kind(int j) const { if (64 * j > nhi) return 0; if (64 * j + 63 <= nlo) return 1; return 2; }
    __device__ __forceinline__ bool ok(int j, int kk) const { return 64 * j + kk <= nmax; }
    __device__ __forceinline__ bool lane_ok(int) const { return true; }
};
struct SelMask {
    int tb, tq, wq0; unsigned sel, uni;
    __device__ __forceinline__ bool active(int j) const { return (uni >> j) & 1u; }
    __device__ __forceinline__ int kind(int j) const { if (j == tb) return 2; const bool s_ = (sel >> j) & 1u; return __all(s_) ? 1 : (__any(s_) ? 3 : 0); }
    __device__ __forceinline__ bool ok(int j, int kk) const { return kk <= tq; }
    __device__ __forceinline__ bool lane_ok(int j) const { return (sel >> j) & 1u; }
};
struct WinMask {
    int tb, tq;
    __device__ __forceinline__ bool active(int) const { return true; }
    __device__ __forceinline__ int kind(int j) const { return (j == tb || j == tb - 8) ? 2 : 1; }
    __device__ __forceinline__ bool ok(int j, int kk) const { const int d = 64 * (tb - j) + tq - kk; return d >= 0 && d < 512; }
    __device__ __forceinline__ bool lane_ok(int) const { return true; }
};
}

#define XB_TMO      128
#define XB_XCNT(j)  (256  + 64 * (j))
#define XB_XSUB(j)  (1280 + 64 * (j))
#define XB_XGEN(j)  (2304 + 64 * (j))
#define XB_TOP      3328
#define XB_TOPGEN   3392
#define XCD_BAR_WORDS 3456
#define XB_SPIN_CAP (1u << 18)
__device__ __forceinline__ unsigned xb_ld(unsigned* p)              { return __hip_atomic_load(p, __ATOMIC_RELAXED, __HIP_MEMORY_SCOPE_AGENT); }
__device__ __forceinline__ unsigned xb_add(unsigned* p, unsigned v) { return __hip_atomic_fetch_add(p, v, __ATOMIC_RELAXED, __HIP_MEMORY_SCOPE_AGENT); }
__device__ __forceinline__ unsigned xb_xcc_id() { return (unsigned)__builtin_amdgcn_s_getreg((3 << 11) | 20) & 0xFu; }
#define XB_SPIN(cond, bar) do { unsigned _sp = 0; while (cond) { __builtin_amdgcn_s_sleep(1); \
    if ((++_sp & 255u) == 0u) { if (xb_ld(&(bar)[XB_TMO])) break; if (_sp > XB_SPIN_CAP) { atomicAdd(&(bar)[XB_TMO], 1u); break; } } } } while (0)
struct XcdBarrier { unsigned* bar; unsigned x; volatile LAS unsigned* st; };
__device__ __forceinline__ XcdBarrier xcd_barrier_post(unsigned* bar, volatile LAS unsigned* st) {
    XcdBarrier b; b.bar = bar; b.x = xb_xcc_id(); b.st = st;
    if (threadIdx.x == 0) (void)xb_add(&bar[XB_XCNT(b.x)], 1u);
    return b;
}
__device__ __forceinline__ void xcd_barrier_complete(unsigned* bar, unsigned x, unsigned& nloc, unsigned& nx) {
    const unsigned G = gridDim.x * gridDim.y * gridDim.z;
    unsigned sum, cnt, mine, sp = 0u;
    for (;;) {
        sum = 0u; cnt = 0u; mine = 0u;
#pragma unroll
        for (unsigned j = 0; j < 16; ++j) { const unsigned c = xb_ld(&bar[XB_XCNT(j)]); sum += c; cnt += (c > 0u) ? 1u : 0u; mine = (j == x) ? c : mine; }
        if (sum == G) break;
        __builtin_amdgcn_s_sleep(1);
        if ((++sp & 255u) == 0u) { if (xb_ld(&bar[XB_TMO])) break; if (sp > XB_SPIN_CAP) { atomicAdd(&bar[XB_TMO], 1u); break; } }
    }
    nloc = mine > 0u ? mine : 1u; nx = cnt > 0u ? cnt : 1u;
}
__device__ __forceinline__ void xcd_barrier(const XcdBarrier& b) {
    asm volatile("s_waitcnt vmcnt(0)" ::: "memory");
    __syncthreads();
    if (threadIdx.x == 0) {
        unsigned* bar = b.bar;
        __builtin_amdgcn_s_waitcnt(0);
        unsigned nloc = b.st[0], nx = b.st[1];
        if (nloc == 0u) { xcd_barrier_complete(bar, b.x, nloc, nx); b.st[0] = nloc; b.st[1] = nx; }
        const unsigned old = xb_add(&bar[XB_XSUB(b.x)], 1u);
        const unsigned gen = old / nloc;
        if (old + 1u == (gen + 1u) * nloc) {
            __builtin_amdgcn_fence(__ATOMIC_RELEASE, "agent");
            asm volatile("s_waitcnt vmcnt(0)" ::: "memory");
            const unsigned og = xb_add(&bar[XB_TOP], 1u);
            const unsigned tg = og / nx;
            if (og + 1u == (tg + 1u) * nx) xb_add(&bar[XB_TOPGEN], 1u);
            else XB_SPIN(xb_ld(&bar[XB_TOPGEN]) == tg, bar);
            __builtin_amdgcn_fence(__ATOMIC_ACQUIRE, "agent");
            xb_add(&bar[XB_XGEN(b.x)], 1u);
            asm volatile("s_waitcnt vmcnt(0)" ::: "memory");
        } else {
            XB_SPIN(xb_ld(&bar[XB_XGEN(b.x)]) == gen, bar);
            __builtin_amdgcn_fence(__ATOMIC_ACQUIRE, "agent");
            asm volatile("s_waitcnt vmcnt(0)" ::: "memory");
        }
    }
    __syncthreads();
}

struct ConvJob { const float* src; bf16* dst; const float* g; int K, N, nblk, mode, start; float scale; };

__device__ __forceinline__ void conv_load(const float* src, int N, int nblk, int item, int lane, float (&v)[64]) {
    const int kb = item / nblk, nb = item - kb * nblk, k0 = 64 * kb, n = 64 * nb + lane;
    const float* p = src + (size_t)k0 * N + n;
    if (n < N) {
#pragma unroll
        for (int i = 0; i < 64; ++i) v[i] = p[(size_t)i * N];
    } else {
#pragma unroll
        for (int i = 0; i < 64; ++i) v[i] = 0.f;
    }
}
__device__ __forceinline__ void conv_store(bf16* dst, const float* g, int K, int N, int nblk, int mode, float scale, LAS float* scr, int item, int lane, const float (&v)[64]) {
    const int kb = item / nblk, nb = item - kb * nblk, k0 = 64 * kb, n0 = 64 * nb;
    if (g) {
#pragma unroll
        for (int i = 0; i < 64; ++i) scr[i * 65 + lane] = v[i] * g[k0 + i];
    } else {
#pragma unroll
        for (int i = 0; i < 64; ++i) scr[i * 65 + lane] = v[i];
    }
    LDS_WAIT(); asm volatile("" ::: "memory");
    const int rm = mode & 3;
    if (mode & 4) {
        const int c = lane & 3;
#pragma unroll
        for (int j = 0; j < 4; ++j) { const int nn = (lane >> 2) + 16 * j, nc = n0 + nn; const LAS float* s = scr + (16 * c) * 65 + nn;
            u32x4 o; o.x = pk4_fp8(s[0 * 65] * scale, s[1 * 65] * scale, s[2 * 65] * scale, s[3 * 65] * scale); o.y = pk4_fp8(s[4 * 65] * scale, s[5 * 65] * scale, s[6 * 65] * scale, s[7 * 65] * scale);
            o.z = pk4_fp8(s[8 * 65] * scale, s[9 * 65] * scale, s[10 * 65] * scale, s[11 * 65] * scale); o.w = pk4_fp8(s[12 * 65] * scale, s[13 * 65] * scale, s[14 * 65] * scale, s[15 * 65] * scale);
            if (nc < N) { const int orow = rm == 0 ? nc : (256 * (nc >> 7) + (nc & 127) + (rm == 2 ? 128 : 0)); *(u32x4*)((unsigned char*)dst + (size_t)orow * K + k0 + 16 * c) = o; } }
    } else {
    const int c = lane & 7;
#pragma unroll
    for (int j = 0; j < 8; ++j) { const int nn = (lane >> 3) + 8 * j, nc = n0 + nn; const LAS float* s = scr + (8 * c) * 65 + nn;
        u32x4 o; o.x = pk2(s[0 * 65], s[1 * 65]); o.y = pk2(s[2 * 65], s[3 * 65]); o.z = pk2(s[4 * 65], s[5 * 65]); o.w = pk2(s[6 * 65], s[7 * 65]);
        if (nc < N) { const int orow = rm == 0 ? nc : (256 * (nc >> 7) + (nc & 127) + (rm == 2 ? 128 : 0)); *(u32x4*)(dst + (size_t)orow * K + k0 + 8 * c) = o; } }
    }
    LDS_WAIT(); asm volatile("" ::: "memory");
}
struct ConvCur { const float* src; bf16* dst; const float* g; int K, N, nblk, mode, item; float scale; };
__device__ __forceinline__ void conv_lookup(const LAS ConvJob* jobs, int njobs, int it, ConvCur& c) {
    int ji = 0; while (ji + 1 < njobs && jobs[ji + 1].start <= it) ++ji;
    c.src = jobs[ji].src; c.dst = jobs[ji].dst; c.g = jobs[ji].g; c.K = jobs[ji].K; c.N = jobs[ji].N; c.nblk = jobs[ji].nblk; c.mode = jobs[ji].mode; c.item = it - jobs[ji].start; c.scale = jobs[ji].scale;
}
__device__ __forceinline__ void run_conv_jobs(LAS unsigned char* lds, int njobs, int item_lo, int item_hi, int w0, int nw, int wave, int lane) {
    const LAS ConvJob* jobs = (const LAS ConvJob*)(lds + CONV_JOBS_OFF);
    LAS float* scr = (LAS float*)(lds + wave * (64 * 65 * 4));
    int it = item_lo + w0; if (it >= item_hi) return;
    ConvCur cur, nxt; float v[64], w[64];
    conv_lookup(jobs, njobs, it, cur); conv_load(cur.src, cur.N, cur.nblk, cur.item, lane, v);
#pragma nounroll
    for (;;) {
        const int itn = it + nw; const bool has = itn < item_hi;
        if (has) { conv_lookup(jobs, njobs, itn, nxt); conv_load(nxt.src, nxt.N, nxt.nblk, nxt.item, lane, w); }
        conv_store(cur.dst, cur.g, cur.K, cur.N, cur.nblk, cur.mode, cur.scale, scr, cur.item, lane, v);
        if (!has) break;
#pragma unroll
        for (int i = 0; i < 64; ++i) v[i] = w[i];
        cur = nxt; it = itn;
    }
}
#define ADD_JOB(SRC, DST, GP, KK, NN, MODE) do { LAS ConvJob* _j = jobsw + nj; int kk_ = (KK), nn_ = (NN), md_ = (MODE); asm volatile("" : "+s"(kk_), "+s"(nn_), "+s"(md_));     \
    _j->src = (SRC); _j->dst = (DST); _j->g = (GP); _j->K = kk_; _j->N = nn_; _j->nblk = (nn_ + 63) / 64; \
    _j->mode = md_; _j->start = tot; _j->scale = (md_ & 4) ? ((md_ & 3) ? FP8_SW_GU : FP8_SW_D) : 1.f; tot += (kk_ / 64) * ((nn_ + 63) / 64); ++nj; } while (0)

constexpr int MOE_ITEMS = 24 * 896;
constexpr size_t MOEGU_SET = (size_t)NEXP * 2 * DFFE * DM, MOED_SET = (size_t)NEXP * DM * DFFE;
#define BUILD_MOE_JOBS(I) do { _Pragma("nounroll") for (int e = 0; e < NEXP; ++e) { \
        ADD_JOB((const float*)INP(22) + (size_t)((I) * NEXP + e) * DM * DFFE, (bf16*)(ws + WS_W_MOEGU + (I) * MOEGU_SET + (size_t)e * 2 * DFFE * DM), norm_g + ((2 * (I) + 1) * 3 + 2) * DM, DM, DFFE, 5); \
        ADD_JOB((const float*)INP(23) + (size_t)((I) * NEXP + e) * DM * DFFE, (bf16*)(ws + WS_W_MOEGU + (I) * MOEGU_SET + (size_t)e * 2 * DFFE * DM), norm_g + ((2 * (I) + 1) * 3 + 2) * DM, DM, DFFE, 6); \
        ADD_JOB((const float*)INP(24) + (size_t)((I) * NEXP + e) * DFFE * DM, (bf16*)(ws + WS_W_MOED + (I) * MOED_SET + (size_t)e * DM * DFFE), (const float*)nullptr, DFFE, DM, 4); } } while (0)
#define MOE_CONV_SLICE(I, LO, HI, RANK, NRANK) do { LAS ConvJob* jobsw = (LAS ConvJob*)(lds + CONV_JOBS_OFF); \
        __syncthreads(); if (tid == 0) { int nj = 0, tot = 0; BUILD_MOE_JOBS(I); } __syncthreads(); \
        run_conv_jobs(lds, 24, (LO), (HI), (RANK) * NWAVES + wave, (NRANK) * NWAVES, wave, lane); __syncthreads(); } while (0)
constexpr int MS_E1 = 2048, MS_XQA = 3072, MS_F1 = 2048, MS_XQB = 4608;
constexpr int MS0_A0 = MS_E1, MS0_A1 = MS0_A0 + MS_XQA, MS0_A2 = MS0_A1 + MS_F1, MS0_A3 = MS0_A2 + MS_XQB;
constexpr int MS1_B0 = MS_E1, MS1_B1 = MS1_B0 + MS_XQB, MS1_B2 = MS1_B1 + MS_F1, MS1_B3 = MS1_B2 + MS_XQB;

__device__ __forceinline__ float load_row4(const float* row, int lane, f32x4 (&v)[4]) {
    float s = 0.f;
#pragma unroll
    for (int j = 0; j < 4; ++j) { v[j] = *(const f32x4*)(row + 4 * lane + 256 * j); s += (v[j][0] * v[j][0] + v[j][1] * v[j][1]) + (v[j][2] * v[j][2] + v[j][3] * v[j][3]); }
    return wave_sum(s);
}
__device__ __forceinline__ float load_row4_bf16(const bf16* row, int lane, f32x4 (&v)[4]) {
    float s = 0.f;
#pragma unroll
    for (int j = 0; j < 4; ++j) { const u32x2 o = *(const u32x2*)(row + 4 * lane + 256 * j);
        v[j] = (f32x4){__builtin_bit_cast(float, o.x << 16), __builtin_bit_cast(float, o.x & 0xffff0000u), __builtin_bit_cast(float, o.y << 16), __builtin_bit_cast(float, o.y & 0xffff0000u)};
        s += (v[j][0] * v[j][0] + v[j][1] * v[j][1]) + (v[j][2] * v[j][2] + v[j][3] * v[j][3]); }
    return wave_sum(s);
}
__device__ __forceinline__ void store_ssq_full(float* ssq, int row, float s, int lane) { if (lane < 16) ssq[(size_t)lane * MTOK + row] = (lane == 0) ? s : 0.f; }
__device__ __forceinline__ void store_row_bf16(bf16* orow, int lane, const f32x4 (&v)[4]) {
#pragma unroll
    for (int j = 0; j < 4; ++j) { u32x2 o; o.x = pk2(v[j][0], v[j][1]); o.y = pk2(v[j][2], v[j][3]); *(u32x2*)(orow + 4 * lane + 256 * j) = o; }
}

struct Args { const void* in[28]; float* out; unsigned char* ws; double invf[8]; int ph_lo, ph_hi; };
constexpr int NPH = 2 + 4 * 13;

#define CAS __attribute__((address_space(4)))
__device__ __forceinline__ const CAS char* karg() { const CAS char* kp = (const CAS char*)__builtin_amdgcn_kernarg_segment_ptr(); asm volatile("" : "+s"(kp)); return kp; }
#define INP(k) ((const void*)(*(const GAS void* const CAS*)(karg() + 8 * (k))))
#define ARG_OUT ((float*)(*(GAS float* const CAS*)(karg() + 224)))
#define ARG_WS (*(GAS unsigned char* const CAS*)(karg() + 232))
#define ARG_INVF(j) (*(const CAS double*)(karg() + 240 + 8 * (j)))
static_assert(offsetof(Args, out) == 224 && offsetof(Args, ws) == 232 && offsetof(Args, invf) == 240 && offsetof(Args, ph_lo) == 304 && sizeof(Args) == 312, "kernarg layout");
#define PHASE_IDS int tid = threadIdx.x; asm volatile("" : "+v"(tid)); const int lane = tid & 63, wave = __builtin_amdgcn_readfirstlane(tid >> 6); \
    int bx = blockIdx.x, G = gridDim.x; asm volatile("" : "+s"(bx), "+s"(G)); const int gw = bx * NWAVES + wave, NGW = G * NWAVES; (void)lane; (void)gw; (void)NGW;
#define ws (ARG_WS)
#define ctl ((unsigned*)(ws + WS_CTL))
#define PH_LO (*(const CAS int*)(karg() + 304))
#define PH_HI (*(const CAS int*)(karg() + 308))
#define IN(p) (PH_LO <= (p) && (p) < PH_HI)
#define T_START unsigned long long t0_ = 0; if (DELAYMASK) t0_ = __builtin_amdgcn_s_memrealtime();
#define T_DELAY(c) do { if (DELAYMASK && (c)) { const unsigned long long t1_ = __builtin_amdgcn_s_memrealtime(); while (__builtin_amdgcn_s_memrealtime() - t1_ < t1_ - t0_) __builtin_amdgcn_s_sleep(8); } } while (0)
#define BAR_AFTER(p) do { if (MK_SINGLE && (p) + 1 < PH_HI) { XcdBarrier bar_; bar_.bar = ctl + CW_BAR; bar_.x = xb_xcc_id(); bar_.st = (volatile LAS unsigned*)(lds + MISC_OFF) + 8; xcd_barrier(bar_); } } while (0)
#define in_x ((const float*)INP(0))
#define in_mem ((const float*)INP(1))
#define in_pos ((const int*)INP(2))
#define norm_g ((const float*)INP(3))
#define mem_g ((const float*)INP(4))
#define final_g ((const float*)INP(5))
#define X (ARG_OUT)
#define XB ((bf16*)(ws + WS_XB))
#define SSQ ((float*)(ws + WS_SSQ))
#define CS ((float*)(ws + WS_MISC + MISC_CS))
#define KMEAN ((float*)(ws + WS_MISC + MISC_KMEAN))
#define KCMP ((bf16*)(ws + WS_MISC + MISC_KCMP))
#define VCMP ((bf16*)(ws + WS_MISC + MISC_VCMP))
#define MEMB ((bf16*)(ws + WS_MEMB))
#define XK ((bf16*)(ws + WS_XK))
#define XV ((bf16*)(ws + WS_XV))
#define YB ((bf16*)(ws + WS_YB))
#define XQ ((bf16*)(ws + WS_XQ))
#define XO ((bf16*)(ws + WS_XO))
#define TOKE ((int*)(ws + WS_ROUTE + RT_TOKE))
#define TOKPOS ((int*)(ws + WS_ROUTE + RT_TOKPOS))
#define TOKW ((float*)(ws + WS_ROUTE + RT_TOKW))
#define TOKRSTD ((float*)(ws + WS_ROUTE + RT_TOKRSTD))
#define ROWTOK ((int*)(ws + WS_ROUTE + RT_ROWTOK))
#define ROWW ((float*)(ws + WS_ROUTE + RT_ROWW))
#define ROWRSTD ((float*)(ws + WS_ROUTE + RT_ROWRSTD))
#define TILEE ((int*)(ws + WS_ROUTE + RT_TILEE))
#define LCNT ((int*)(ws + WS_ROUTE + RT_LCNT))
#define RA ((unsigned char*)(ws + WS_REGA))
#define UPOOL ((float*)(RA + RA_UPOOL))
#define QB ((bf16*)(RA + RA_QB))
#define KB ((bf16*)(RA + RA_KB))
#define VB ((bf16*)(RA + RA_VB))
#define QRAW ((bf16*)(RA + RA_QRAW))
#define QROT ((bf16*)(RA + RA_QROT))
#define ACMPK ((bf16*)(RA + RA_ACMPK))
#define KSB ((bf16*)(RA + RA_KS))
#define VSB ((bf16*)(RA + RA_VS))
#define KWB ((bf16*)(RA + RA_KW))
#define VWB ((bf16*)(RA + RA_VW))
#define GATES ((float*)(RA + RA_GATES))
#define CPART ((float*)(RA + RA_CPART))
#define YMOE ((bf16*)(RA + RA_YMOE))
#define XPERM ((bf16*)(RA + RA_XPERM))
#define HB ((bf16*)(ws + WS_REGB))
template <int l> __device__ __forceinline__ void run_layer(LAS unsigned char* lds) {
        constexpr int pb = 2 + 13 * l, i2 = l >> 1;
        constexpr bool even = (l & 1) == 0;
        if (IN(pb + 0)) {
            PHASE_IDS T_START
            if (ON(2) && even) {
                pg8::Gemm g{XB, (const bf16*)(ws + WS_W_INAB) + (size_t)i2 * AB_IN * DM, DM, DM, DM}; pg8::StaticOrder S; S.init(MTOK, AB_IN, G, bx, DM, DM);
                pg8::EpiInAB E{SSQ, CS, RA, KMEAN};
                pg8::gemm_phase<pg8::EpiInAB, pg8::StaticOrder>(lds, g, S, E, tid);
                if (G == 256 && bx >= 128) { if (l == 0) MOE_CONV_SLICE(0, 0, MS0_A0, bx - 128, 128); else MOE_CONV_SLICE(1, 0, MS1_B0, bx - 128, 128); }
            } else if (ON(3) && !even) {
                pg8::Gemm g{XB, (const bf16*)(ws + WS_W_INC) + (size_t)i2 * C_IN_PAD * DM, DM, DM, DM}; pg8::StaticOrder S; S.init(MTOK, C_IN_PAD, G, bx, DM, DM);
                pg8::EpiInC E{SSQ, CS, RA, (const float*)INP(14) + (size_t)i2 * 32 * 64, (const float*)INP(15) + (size_t)i2 * 32 * 64};
                pg8::gemm_phase<pg8::EpiInC, pg8::StaticOrder>(lds, g, S, E, tid);
            }
            BAR_AFTER(pb + 0); T_DELAY((even ? DLY(2) : DLY(3)));
        }
        if (IN(pb + 1) && !even) {
            PHASE_IDS T_START
            if (ON(5)) {
                pg8::Gemm g{ACMPK, (const bf16*)(ws + WS_W_CW1) + (size_t)i2 * 2 * 256 * 2048, 2048, 2048, 2048 / CMP_SPLIT}; pg8::CmpOrder S{G, bx};
                pg8::EpiCmpPart E{CPART};
                pg8::gemm_phase<pg8::EpiCmpPart, pg8::CmpOrder>(lds, g, S, E, tid);
            }
            BAR_AFTER(pb + 1); T_DELAY((even ? DLY(4) : DLY(5)));
        }
        if (ON(6) && IN(pb + 2) && !even) {
            PHASE_IDS T_START
            LAS float* wl = (LAS float*)lds;
            LAS float* hl = (LAS float*)(lds + 65536);
            for (int u = bx; u < 256; u += G) {
                const int t = u >> 7, R0 = (u & 127) * 32;
                const float* w2 = (const float*)INP(t ? 19 : 17) + (size_t)i2 * 256 * 64;
#pragma unroll
                for (int q = 0; q < 8; ++q) *(LAS f32x4*)(wl + (tid + 512 * q) * 4) = *(const f32x4*)(w2 + (tid + 512 * q) * 4);
#pragma unroll
                for (int q = 0; q < 4; ++q) { const int idx4 = tid + 512 * q, rr = idx4 >> 6, c4 = (idx4 & 63) * 4; f32x4 sacc = {0.f, 0.f, 0.f, 0.f};
#pragma unroll
                    for (int sp = 0; sp < CMP_SPLIT; ++sp) { const u32x2 pw = *(const u32x2*)((const unsigned short*)CPART + ((size_t)(t * CMP_SPLIT + sp) * 4096 + R0 + rr) * 256 + c4);
                        sacc[0] += __builtin_bit_cast(float, pw.x << 16); sacc[1] += __builtin_bit_cast(float, pw.x & 0xffff0000u); sacc[2] += __builtin_bit_cast(float, pw.y << 16); sacc[3] += __builtin_bit_cast(float, pw.y & 0xffff0000u); }
#pragma unroll
                    for (int e = 0; e < 4; ++e) sacc[e] = gelu_tanh_f(sacc[e]);
                    *(LAS f32x4*)(hl + rr * 256 + c4) = sacc; }
                __syncthreads();
                const int rr = tid >> 4, d4 = (tid & 15) * 4; f32x4 a = {0.f, 0.f, 0.f, 0.f};
#pragma unroll 8
                for (int k = 0; k < 256; ++k) a = a + *(const LAS f32x4*)(wl + k * 64 + d4) * hl[rr * 256 + k];
                const int row = R0 + rr; if ((row & 127) == 127) a = (f32x4){0.f, 0.f, 0.f, 0.f};
                u32x2 o; o.x = pk2(a[0], a[1]); o.y = pk2(a[2], a[3]);
                *(u32x2*)((t ? VCMP : KCMP) + (size_t)row * 64 + d4) = o;
                __syncthreads();
            }
            BAR_AFTER(pb + 2); T_DELAY(DLY(6));
        }
        if (IN(pb + 3)) {
            PHASE_IDS T_START
            if (ON(7) && even) {
                for (int u0 = bx, rnd = 0; u0 < 768 + 512; u0 += G, ++rnd) {
                    const int u = ((rnd & 1) && (u0 - bx) + G <= 768) ? (u0 - bx) + (G - 1 - bx) : u0;
                    if (u < 768) {
                        const int qb = 7 - u / 96, bh = u % 96, b = bh / 12, h = bh % 12;
                        LAS float* km = (LAS float*)(lds + att::KV_BYTES);
                        LAS unsigned* uni = (LAS unsigned*)(lds + att::KV_BYTES + 2048);
                        if (tid < qb * 64) { const int j = tid >> 6, d = tid & 63; const float* kp = KMEAN + (size_t)((b * 8 + j) * 2) * MOBA_DIMC + h * 64 + d; km[tid] = (kp[0] + kp[MOBA_DIMC]) * (1.f / 256.f); }
                        if (tid == 0) *uni = 0u;
                        __syncthreads();
                        const int r = lane & 31, hh = lane >> 5, tq = 32 * wave + r;
                        const size_t tok = (size_t)b * SEQ + 256 * qb + tq;
                        bf16x8 qf[4]; att::load_q(qf, QB + tok * MOBA_DIMC + h * 64, hh);
                        float gt[7];
#pragma unroll
                        for (int j = 0; j < 7; ++j) { float p = -INFINITY;
                            if (j < qb) { p = 0.f;
#pragma unroll
                                for (int ks = 0; ks < 4; ++ks)
#pragma unroll
                                    for (int jj = 0; jj < 8; ++jj) p += bf2f((unsigned short)qf[ks][jj]) * km[j * 64 + ks * 16 + hh * 8 + jj];
                                p += __shfl_xor(p, 32); }
                            gt[j] = p; }
                        unsigned sel = 0u;
#pragma unroll
                        for (int j = 0; j < 7; ++j) { int c = 0;
#pragma unroll
                            for (int j2 = 0; j2 < 7; ++j2) c += (gt[j2] > gt[j] || (gt[j2] == gt[j] && j2 < j)) ? 1 : 0;
                            if (j < qb && c < 3) sel |= 1u << j; }
                        { unsigned o = sel;
#pragma unroll
                          for (int s = 1; s < 64; s <<= 1) o |= __shfl_xor(o, s);
                          if (lane == 0 && o) atomicOr((unsigned*)uni, o); }
                        __syncthreads();
                        att::MobaMask mk; mk.qb = qb; mk.wq0 = 32 * wave; mk.tq = tq; mk.sel = sel; mk.uni = __builtin_amdgcn_readfirstlane(*uni);
                        att::State st; att::reset(st);
                        att::flash_run<att::MobaMask, false>(lds, KB + (size_t)b * SEQ * MOBA_DIMC + h * 64, VB + (size_t)b * SEQ * MOBA_DIMC + h * 64, MOBA_DIMC, 0, 4 * (qb + 1), qf, st, mk, tid);
                        att::store_o(YB + tok * DM + 256 + h * 64, st.o0, st.o1, st.l > 0.f ? 1.f / st.l : 0.f, hh);
                        __syncthreads();
                    } else {
                        const int pu = u - 768, tok0 = pu * 32, t0 = tok0 & (SEQ - 1);
                        LAS float* ub = (LAS float*)lds;
                        LAS float* pl = (LAS float*)(lds + 47 * 1024);
                        for (int idx = tid; idx < 47 * 64; idx += 512) { const int rr = idx >> 6, c4 = (idx & 63) * 4; const int t = t0 - 15 + rr;
                            f32x4 v = {0.f, 0.f, 0.f, 0.f}; if (t >= 0) v = *(const f32x4*)(UPOOL + (size_t)(tok0 - 15 + rr) * 256 + c4);
                            *(LAS f32x4*)(ub + rr * 256 + c4) = v; }
                        __syncthreads();
                        for (int idx = tid; idx < 32 * 256; idx += 512) { const int tt = idx >> 8, c = idx & 255, w = 2 << (c >> 6), t = t0 + tt;
                            const int cnt = (t + 1 < w) ? t + 1 : w; float s = 0.f;
                            for (int q = 0; q < cnt; ++q) s += ub[(15 + tt - q) * 256 + c];
                            pl[idx] = s / (float)cnt - ub[(15 + tt) * 256 + c]; }
                        __syncthreads();
                        { const int c = tid & 255, hf = tid >> 8, gi = c >> 6, d = c & 63;
                          const float* pw = (const float*)INP(7) + ((size_t)(i2 * 4 + gi) * 64) * 64 + d; const float sc = ((const float*)INP(8))[i2 * 256 + c];
                          float a[16];
#pragma unroll
                          for (int q = 0; q < 16; ++q) a[q] = 0.f;
                          for (int k = 0; k < 64; ++k) { const float wv = pw[k * 64];
#pragma unroll
                              for (int q = 0; q < 16; ++q) a[q] += pl[(hf * 16 + q) * 256 + gi * 64 + k] * wv; }
#pragma unroll
                          for (int q = 0; q < 16; ++q) YB[(size_t)(tok0 + hf * 16 + q) * DM + c] = (bf16)f2bf(a[q] * sc); }
                        __syncthreads();
                    }
                }
            } else if (ON(8) && !even) {
                for (int u0 = bx, rnd = 0; u0 < 1024; u0 += G, ++rnd) {
                    const int u = ((rnd & 1) && (u0 - bx) + G <= 1024) ? (u0 - bx) + (G - 1 - bx) : u0;
                    const int tb = 31 - u / 32, bg = u % 32, b = bg >> 2, g = bg & 3;
                    LAS float* pslc = (LAS float*)(lds + att::KV_BYTES);
                    LAS float* sc = (LAS float*)(lds + att::KV_BYTES + 32768);
                    LAS unsigned* selm = (LAS unsigned*)(lds + att::KV_BYTES + 65536);
                    LAS float* yst = (LAS float*)(lds + att::KV_BYTES) + (size_t)wave * 32 * 64 + lane;
                    const int r = lane & 31, hh = lane >> 5, hd = wave & 3, th = wave >> 2, tq = 32 * th + r, t = 64 * tb + tq;
                    const size_t tok = (size_t)b * SEQ + t; const int head = g * 4 + hd;
                    f32x16 y0, y1;
                    bf16x8 qf[4];
                    att::State st;
                    {
                        att::load_q(qf, QRAW + tok * DM + head * 64, hh);
                        att::CmpMask mk; mk.nmax = (t >= 31) ? ((t - 31) >> 4) : -1;
                        const int tlo = 64 * tb + 32 * th, thi = tlo + 31; mk.nlo = (tlo >= 31) ? ((tlo - 31) >> 4) : -1; mk.nhi = (thi >= 31) ? ((thi - 31) >> 4) : -1;
                        att::reset(st);
                        att::flash_run<att::CmpMask, true>(lds, KCMP + (size_t)bg * 128 * 64, VCMP + (size_t)bg * 128 * 64, 64, 0, tb <= 15 ? 1 : 2, qf, st, mk, tid);
                        const float inv = st.l > 0.f ? 1.f / st.l : 0.f, sg = inv * GATES[tok * 48 + head * 3 + 0];
                        y0 = st.o0 * sg; y1 = st.o1 * sg;
#pragma unroll
                        for (int i = 0; i < 16; ++i) pslc[(hd * 64 + tq) * 32 + (i & 3) + 8 * (i >> 2) + 4 * hh] = st.o2[i] * inv;
                    }
                    __syncthreads();
#pragma nounroll
                    for (int p = 0; p < 4; ++p) { const int tt = p * 16 + (tid >> 5), j = tid & 31;
                        float v = -1.f;
                        if (j <= tb) v = (j == 0 || j == tb || j == tb - 1) ? 1e4f : ((pslc[(0 * 64 + tt) * 32 + j] + pslc[(1 * 64 + tt) * 32 + j]) + (pslc[(2 * 64 + tt) * 32 + j] + pslc[(3 * 64 + tt) * 32 + j]));
                        sc[tt * 32 + j] = v; }
                    __syncthreads();
#pragma nounroll
                    for (int p = 0; p < 4; ++p) { const int tt = p * 16 + (tid >> 5), j = tid & 31; const float my = sc[tt * 32 + j]; int c = 0;
#pragma unroll 8
                        for (int j2 = 0; j2 < 32; ++j2) { const float o = sc[tt * 32 + j2]; c += (o > my || (o == my && j2 < j)) ? 1 : 0; }
                        const unsigned long long bm = __ballot(c < 16 && j <= tb);
                        if ((lane & 31) == 0) selm[tt] = (unsigned)(bm >> (lane & 32)); }
                    __syncthreads();
                    unsigned uni;
                    { unsigned o = selm[lane];
#pragma unroll
                      for (int s = 1; s < 64; s <<= 1) o |= __shfl_xor(o, s);
                      uni = __builtin_amdgcn_readfirstlane(o); }
                    const unsigned sel = selm[tq];
                    __syncthreads();
#pragma unroll
                    for (int i = 0; i < 16; ++i) { yst[i * 64] = y0[i]; yst[(16 + i) * 64] = y1[i]; }
                    att::load_q(qf, QROT + tok * DM + head * 64, hh);
                    {
                        att::SelMask mk; mk.tb = tb; mk.tq = tq; mk.wq0 = 32 * th; mk.sel = sel; mk.uni = uni;
                        att::reset(st);
                        att::flash_run<att::SelMask, false>(lds, KSB + (size_t)b * SEQ * 256 + g * 64, VSB + (size_t)b * SEQ * 256 + g * 64, 256, 0, tb + 1, qf, st, mk, tid);
                        const float sg = (st.l > 0.f ? 1.f / st.l : 0.f) * GATES[tok * 48 + head * 3 + 1];
#pragma unroll
                        for (int i = 0; i < 16; ++i) { yst[i * 64] += st.o0[i] * sg; yst[(16 + i) * 64] += st.o1[i] * sg; }
                    }
                    {
                        att::WinMask mk; mk.tb = tb; mk.tq = tq;
                        att::reset(st);
                        att::flash_run<att::WinMask, false>(lds, KWB + (size_t)b * SEQ * 256 + g * 64, VWB + (size_t)b * SEQ * 256 + g * 64, 256, tb >= 8 ? tb - 8 : 0, tb + 1, qf, st, mk, tid);
                        const float sg = (st.l > 0.f ? 1.f / st.l : 0.f) * GATES[tok * 48 + head * 3 + 2];
#pragma unroll
                        for (int i = 0; i < 16; ++i) { y0[i] = yst[i * 64] + st.o0[i] * sg; y1[i] = yst[(16 + i) * 64] + st.o1[i] * sg; }
                    }
                    att::store_o(YB + tok * DM + head * 64, y0, y1, 1.f, hh);
                    __syncthreads();
                }
            }
            BAR_AFTER(pb + 3); T_DELAY((even ? DLY(7) : DLY(8)));
        }
        if (ON(9) && IN(pb + 4)) {
            PHASE_IDS T_START
            const bf16* W = even ? (const bf16*)(ws + WS_W_OUTAB) + (size_t)i2 * DM * DM : (const bf16*)(ws + WS_W_OUTC) + (size_t)i2 * DM * DM;
            pg8::Gemm g{YB, W, DM, DM, DM}; pg8::StaticOrder S; S.init(MTOK, DM, G, bx, DM, DM);
            pg8::EpiRes E{XB, SSQ};
            pg8::gemm_phase<pg8::EpiRes, pg8::StaticOrder>(lds, g, S, E, tid);
            BAR_AFTER(pb + 4); T_DELAY(DLY(9));
        }
        if (ON(10) && IN(pb + 5)) {
            PHASE_IDS T_START
            if (l == 0 && ON(1) && bx >= 64 && bx < 128) {
                pg8::Gemm g{MEMB, (const bf16*)(ws + WS_W_XKV), DM, DM, DM}; pg8::StaticOrder S; S.init(NB * MEML, 4 * 512, G, bx - 64, DM, DM);
                pg8::EpiXKV E{XK, XV};
                pg8::gemm_phase<pg8::EpiXKV, pg8::StaticOrder>(lds, g, S, E, tid);
            } else {
                pg8::Gemm g{XB, (const bf16*)(ws + WS_W_XQ) + (size_t)l * 256 * DM, DM, DM, DM}; pg8::StaticOrder S; S.init(MTOK, 256, G, bx, DM, DM);
                pg8::EpiXQ E{SSQ, XQ};
                pg8::gemm_phase<pg8::EpiXQ, pg8::StaticOrder>(lds, g, S, E, tid);
            }
            if (G == 256) {
                if (l == 0) { if (bx >= 128) MOE_CONV_SLICE(0, MS0_A0, MS0_A1, bx - 128, 128); }
                else if (l == 1) { if (bx >= 64) MOE_CONV_SLICE(0, MS0_A2, MS0_A3, bx - 64, 192); }
                else if (l == 2) { if (bx >= 64) MOE_CONV_SLICE(1, MS1_B0, MS1_B1, bx - 64, 192); }
                else { if (bx >= 64) MOE_CONV_SLICE(1, MS1_B2, MS1_B3, bx - 64, 192); }
            }
            BAR_AFTER(pb + 5); T_DELAY(DLY(10));
        }
        if (ON(11) && IN(pb + 6)) {
            PHASE_IDS T_START
            for (int u = bx; u < 256; u += G) {
                const int b = u >> 5, h = (u >> 3) & 3, qt = u & 7;
                const int r = lane & 31, hh = lane >> 5;
                const size_t tok = (size_t)b * SEQ + 256 * qt + 32 * wave + r;
                bf16x8 qf[4]; att::load_q(qf, XQ + tok * 256 + h * 64, hh);
                att::NoMask mk; att::State st; att::reset(st);
                att::flash_run<att::NoMask, false>(lds, XK + ((size_t)l * NB * MEML + (size_t)b * MEML) * 256 + h * 64, XV + ((size_t)l * NB * MEML + (size_t)b * MEML) * 256 + h * 64, 256, 0, 4, qf, st, mk, tid);
                att::store_o(XO + tok * 256 + h * 64, st.o0, st.o1, 1.f / st.l, hh);
            }
            BAR_AFTER(pb + 6); T_DELAY(DLY(11));
        }
        if (ON(12) && IN(pb + 7)) {
            PHASE_IDS T_START
            pg8::Gemm g{XO, (const bf16*)(ws + WS_W_XO) + (size_t)l * DM * 256, 256, 256, 256}; pg8::StaticOrder S; S.init(MTOK, DM, G, bx, 256, 256);
            pg8::EpiRes E{XB, SSQ};
            pg8::gemm_phase<pg8::EpiRes, pg8::StaticOrder>(lds, g, S, E, tid);
            BAR_AFTER(pb + 7); T_DELAY(DLY(12));
        }
        if (IN(pb + 8)) {
            PHASE_IDS T_START
            if (ON(13) && even) {
                pg8::Gemm g{XB, (const bf16*)(ws + WS_W_FFNGU) + (size_t)i2 * 2 * DFF * DM, DM, DM, DM}; pg8::StaticOrder S; S.init(MTOK, 2 * DFF, G, bx, DM, DM);
                pg8::EpiGateUp<false> E{SSQ, HB, DFF};
                pg8::gemm_phase<pg8::EpiGateUp<false>, pg8::StaticOrder>(lds, g, S, E, tid);
                if (G == 256 && bx >= 128) { if (l == 0) MOE_CONV_SLICE(0, MS0_A1, MS0_A2, bx - 128, 128); else MOE_CONV_SLICE(1, MS1_B1, MS1_B2, bx - 128, 128); }
            } else if (ON(14) && !even) {
                for (int idx = bx * 512 + tid; idx < MOE_MAX_ROWS; idx += G * 512) ROWTOK[idx] = -1;
                const float* gn = norm_g + (l * 3 + 2) * DM; const float* rw = (const float*)INP(21) + (size_t)i2 * DM * NEXP;
                LAS float* wg = (LAS float*)(lds + 4096);
                for (int idx = tid; idx < DM * NEXP / 4; idx += 512) { const int k = idx >> 1; *(LAS f32x4*)(wg + idx * 4) = *(const f32x4*)(rw + idx * 4) * gn[k]; }
                LAS int* lcnt = (LAS int*)lds;
                LAS int* lte = (LAS int*)(lds + 64);
                LAS int* ltp = (LAS int*)(lds + 64 + 512);
                LAS float* ltw = (LAS float*)(lds + 64 + 1024);
                LAS float* ltr = (LAS float*)(lds + 64 + 1536);
                for (int tb0 = bx * 64; tb0 < MTOK; tb0 += G * 64) {
                    if (tid < 16) lcnt[tid] = 0;
                    __syncthreads();
#pragma nounroll
                    for (int q = 0; q < 8; ++q) {
                        const int tl = wave * 8 + q, m = tb0 + tl;
                        f32x4 v[4]; const float s = load_row4_bf16(XB + (size_t)m * DM, lane, v); const float rstd = rsqrtf(s * (1.f / DM) + NORM_EPS);
                        float lg[NEXP];
#pragma unroll
                        for (int e = 0; e < NEXP; ++e) lg[e] = 0.f;
#pragma unroll
                        for (int j = 0; j < 4; ++j) {
#pragma unroll
                            for (int qq = 0; qq < 4; ++qq) { const float hv = v[j][qq]; const LAS float* wr_ = wg + (4 * lane + 256 * j + qq) * NEXP; const f32x4 w0 = *(const LAS f32x4*)wr_, w1 = *(const LAS f32x4*)(wr_ + 4);
                                lg[0] += hv * w0[0]; lg[1] += hv * w0[1]; lg[2] += hv * w0[2]; lg[3] += hv * w0[3]; lg[4] += hv * w1[0]; lg[5] += hv * w1[1]; lg[6] += hv * w1[2]; lg[7] += hv * w1[3]; } }
#pragma unroll
                        for (int e = 0; e < NEXP; ++e) lg[e] = wave_sum(lg[e]) * rstd;
                        int e0 = 0; float v0 = lg[0];
#pragma unroll
                        for (int e = 1; e < NEXP; ++e) if (lg[e] > v0) { v0 = lg[e]; e0 = e; }
                        int e1 = -1; float v1 = -INFINITY;
#pragma unroll
                        for (int e = 0; e < NEXP; ++e) if (e != e0 && lg[e] > v1) { v1 = lg[e]; e1 = e; }
                        if (lane == 0) {
                            const float w1 = 1.f / (1.f + expf(v0 - v1)), w0 = 1.f - w1;
                            lte[2 * tl] = e0; lte[2 * tl + 1] = e1; ltw[2 * tl] = w0; ltw[2 * tl + 1] = w1; ltr[tl] = rstd;
                            ltp[2 * tl] = atomicAdd((int*)(lcnt + e0), 1); ltp[2 * tl + 1] = atomicAdd((int*)(lcnt + e1), 1);
                        }
                    }
                    __syncthreads();
                    if (tid < NEXP) LCNT[(tb0 >> 6) * NEXP + tid] = lcnt[tid];
                    if (tid < 128) { const int tl = tid >> 1, m = tb0 + tl;
                        TOKE[2 * m + (tid & 1)] = lte[tid]; TOKPOS[2 * m + (tid & 1)] = ltp[tid]; TOKW[2 * m + (tid & 1)] = ltw[tid];
                        if ((tid & 1) == 0) TOKRSTD[m] = ltr[tl]; }
                    __syncthreads();
                }
            }
            BAR_AFTER(pb + 8); T_DELAY((even ? DLY(13) : DLY(14)));
        }
        if (IN(pb + 9)) {
            PHASE_IDS T_START
            if (ON(15) && even) {
                pg8::Gemm g{HB, (const bf16*)(ws + WS_W_FFND) + (size_t)i2 * DM * DFF, DFF, DFF, DFF}; pg8::StaticOrder S; S.init(MTOK, DM, G, bx, DFF, DFF);
                pg8::EpiRes E{XB, SSQ};
                pg8::gemm_phase<pg8::EpiRes, pg8::StaticOrder>(lds, g, S, E, tid);
            } else if (ON(16) && !even) {
                LAS int* pre = (LAS int*)lds;
                LAS int* ebase = (LAS int*)(lds + 256 * NEXP * 4);
                for (int idx = tid; idx < (MTOK / 64) * NEXP; idx += 512) pre[idx] = LCNT[idx];
                __syncthreads();
                if (tid < NEXP) { int run = 0; for (int tb = 0; tb < MTOK / 64; ++tb) { const int c = pre[tb * NEXP + tid]; pre[tb * NEXP + tid] = run; run += c; } ebase[tid] = run; }
                __syncthreads();
                if (tid == 0) { int acc_t = 0;
                    for (int e = 0; e < NEXP; ++e) { const int c = ebase[e]; ebase[e] = acc_t * 256; const int nt_ = (c + 255) >> 8;
                        if (bx == 0) for (int q = 0; q < nt_; ++q) TILEE[acc_t + q] = e;
                        acc_t += nt_; }
                    if (bx == 0) TILEE[MOE_MAX_TILES] = acc_t; }
                __syncthreads();
                for (int m = gw; m < MTOK; m += NGW) {
                    const int e0 = TOKE[2 * m], e1 = TOKE[2 * m + 1];
                    const int r0 = ebase[e0] + pre[(m >> 6) * NEXP + e0] + TOKPOS[2 * m], r1 = ebase[e1] + pre[(m >> 6) * NEXP + e1] + TOKPOS[2 * m + 1];
                    const float rq = TOKRSTD[m] * FP8_SX;
                    const u32x4 a = *(const u32x4*)(XB + (size_t)m * DM + 16 * lane), c = *(const u32x4*)(XB + (size_t)m * DM + 16 * lane + 8);
                    u32x4 o;
                    o.x = pk4_fp8(__builtin_bit_cast(float, a.x << 16) * rq, __builtin_bit_cast(float, a.x & 0xffff0000u) * rq, __builtin_bit_cast(float, a.y << 16) * rq, __builtin_bit_cast(float, a.y & 0xffff0000u) * rq);
                    o.y = pk4_fp8(__builtin_bit_cast(float, a.z << 16) * rq, __builtin_bit_cast(float, a.z & 0xffff0000u) * rq, __builtin_bit_cast(float, a.w << 16) * rq, __builtin_bit_cast(float, a.w & 0xffff0000u) * rq);
                    o.z = pk4_fp8(__builtin_bit_cast(float, c.x << 16) * rq, __builtin_bit_cast(float, c.x & 0xffff0000u) * rq, __builtin_bit_cast(float, c.y << 16) * rq, __builtin_bit_cast(float, c.y & 0xffff0000u) * rq);
                    o.w = pk4_fp8(__builtin_bit_cast(float, c.z << 16) * rq, __builtin_bit_cast(float, c.z & 0xffff0000u) * rq, __builtin_bit_cast(float, c.w << 16) * rq, __builtin_bit_cast(float, c.w & 0xffff0000u) * rq);
                    *(u32x4*)((unsigned char*)XPERM + (size_t)r0 * DM + 16 * lane) = o; *(u32x4*)((unsigned char*)XPERM + (size_t)r1 * DM + 16 * lane) = o;
                    if (lane == 0) { const float rs_ = TOKRSTD[m]; ROWTOK[r0] = 2 * m; ROWTOK[r1] = 2 * m + 1; ROWW[r0] = TOKW[2 * m]; ROWW[r1] = TOKW[2 * m + 1]; ROWRSTD[r0] = rs_; ROWRSTD[r1] = rs_; }
                }
            }
            BAR_AFTER(pb + 9); T_DELAY((even ? DLY(15) : DLY(16)));
        }
        if (ON(17) && IN(pb + 10) && !even) {
            PHASE_IDS T_START
            pg8::Gemm g{XPERM, (const bf16*)(ws + WS_W_MOEGU + i2 * MOEGU_SET), DM / 2, DM / 2, DM / 2}; pg8::MoeOrder S{TILEE, 2 * DFFE / 256, G, bx, DM / 2, DM / 2, 2 * DFFE};
            pg8::EpiGateUp<true> E{nullptr, HB, DFFE};
            pg8::gemm_phase<pg8::EpiGateUp<true>, pg8::MoeOrder, true, E8(6), E8(2)>(lds, g, S, E, tid);
            BAR_AFTER(pb + 10); T_DELAY(DLY(17));
        }
        if (ON(18) && IN(pb + 11) && !even) {
            PHASE_IDS T_START
            pg8::Gemm g{HB, (const bf16*)(ws + WS_W_MOED + i2 * MOED_SET), DFFE / 2, DFFE / 2, DFFE / 2}; pg8::MoeOrder S{TILEE, DM / 256, G, bx, DFFE / 2, DFFE / 2, DM};
            pg8::EpiMoeDown E{ROWTOK, ROWW, YMOE};
            pg8::gemm_phase<pg8::EpiMoeDown, pg8::MoeOrder, true, E8(7), E8(3)>(lds, g, S, E, tid);
            BAR_AFTER(pb + 11); T_DELAY(DLY(18));
        }
        if (ON(19) && IN(pb + 12) && !even) {
            PHASE_IDS T_START
            if (l == 1) {
                LAS ConvJob* jobsw = (LAS ConvJob*)(lds + CONV_JOBS_OFF);
                if (tid == 0) { int nj = 0, tot = 0; BUILD_MOE_JOBS(1); }
                __syncthreads();
                run_conv_jobs(lds, 24, G == 256 ? MS1_B3 : 0, MOE_ITEMS, gw, NGW, wave, lane);
            }
            for (int m = gw; m < MTOK; m += NGW) {
                f32x4 v[4]; float s = 0.f;
#pragma unroll
                for (int j = 0; j < 4; ++j) { const size_t o = (size_t)m * DM + 4 * lane + 256 * j;
                    const u32x2 y0 = *(const u32x2*)(YMOE + o), y1 = *(const u32x2*)(YMOE + (size_t)MTOK * DM + o);
                    const f32x4 a0 = {__builtin_bit_cast(float, y0.x << 16), __builtin_bit_cast(float, y0.x & 0xffff0000u), __builtin_bit_cast(float, y0.y << 16), __builtin_bit_cast(float, y0.y & 0xffff0000u)};
                    const f32x4 a1 = {__builtin_bit_cast(float, y1.x << 16), __builtin_bit_cast(float, y1.x & 0xffff0000u), __builtin_bit_cast(float, y1.y << 16), __builtin_bit_cast(float, y1.y & 0xffff0000u)};
                    const u32x2 xo = *(const u32x2*)(XB + o);
                    const f32x4 xv = {__builtin_bit_cast(float, xo.x << 16), __builtin_bit_cast(float, xo.x & 0xffff0000u), __builtin_bit_cast(float, xo.y << 16), __builtin_bit_cast(float, xo.y & 0xffff0000u)};
                    v[j] = (xv + a0) + a1;
                    s += (v[j][0] * v[j][0] + v[j][1] * v[j][1]) + (v[j][2] * v[j][2] + v[j][3] * v[j][3]); }
                s = wave_sum(s);
                if (l == 3) { const float r = rsqrtf(s * (1.f / DM) + NORM_EPS);
#pragma unroll
                    for (int j = 0; j < 4; ++j) *(f32x4*)(X + (size_t)m * DM + 4 * lane + 256 * j) = v[j] * r * *(const f32x4*)(final_g + 4 * lane + 256 * j);
                } else {
                    store_row_bf16(XB + (size_t)m * DM, lane, v); store_ssq_full(SSQ, m, s, lane);
                }
            }
            BAR_AFTER(pb + 12); T_DELAY(DLY(19));
        }
}
__global__ void __launch_bounds__(NWAVES * 64, 2) mk_fwd(Args args) {
    extern __shared__ __attribute__((aligned(16))) unsigned char lds_raw[];
    LAS unsigned char* lds = (LAS unsigned char*)lds_raw;
    volatile LAS unsigned* MISC = (volatile LAS unsigned*)(lds + MISC_OFF);
    for (int u = threadIdx.x; u < (LDS_BYTES - LDSCTL_OFF) / 4; u += NWAVES * 64) ((LAS unsigned*)(lds + LDSCTL_OFF))[u] = 0u;
    __syncthreads();
    if (MK_SINGLE) (void)xcd_barrier_post(ctl + CW_BAR, MISC + 8);


    if (ON(0) && IN(0)) {
            PHASE_IDS T_START
        LAS ConvJob* jobsw = (LAS ConvJob*)(lds + CONV_JOBS_OFF);
        LAS int* jmeta = (LAS int*)(lds + CONV_META_OFF);
        if (tid == 0) {
            int nj = 0, tot = 0;
#pragma nounroll
            for (int i = 0; i < 2; ++i) {
                ADD_JOB((const float*)INP(6) + (size_t)i * DM * AB_IN, (bf16*)(ws + WS_W_INAB) + (size_t)i * AB_IN * DM, norm_g + (2 * i * 3 + 0) * DM, DM, AB_IN, 0);
                ADD_JOB((const float*)INP(9) + (size_t)i * DM * DM, (bf16*)(ws + WS_W_OUTAB) + (size_t)i * DM * DM, (const float*)nullptr, DM, DM, 0);
                ADD_JOB((const float*)INP(10) + (size_t)i * DM * DFF, (bf16*)(ws + WS_W_FFNGU) + (size_t)i * 2 * DFF * DM, norm_g + (2 * i * 3 + 2) * DM, DM, DFF, 1);
                ADD_JOB((const float*)INP(11) + (size_t)i * DM * DFF, (bf16*)(ws + WS_W_FFNGU) + (size_t)i * 2 * DFF * DM, norm_g + (2 * i * 3 + 2) * DM, DM, DFF, 2);
                ADD_JOB((const float*)INP(12) + (size_t)i * DFF * DM, (bf16*)(ws + WS_W_FFND) + (size_t)i * DM * DFF, (const float*)nullptr, DFF, DM, 0);
                ADD_JOB((const float*)INP(13) + (size_t)i * DM * C_IN, (bf16*)(ws + WS_W_INC) + (size_t)i * C_IN_PAD * DM, norm_g + ((2 * i + 1) * 3 + 0) * DM, DM, C_IN, 0);
                ADD_JOB((const float*)INP(16) + (size_t)i * 2048 * 256, (bf16*)(ws + WS_W_CW1) + (size_t)(i * 2 + 0) * 256 * 2048, (const float*)nullptr, 2048, 256, 0);
                ADD_JOB((const float*)INP(18) + (size_t)i * 2048 * 256, (bf16*)(ws + WS_W_CW1) + (size_t)(i * 2 + 1) * 256 * 2048, (const float*)nullptr, 2048, 256, 0);
                ADD_JOB((const float*)INP(20) + (size_t)i * DM * DM, (bf16*)(ws + WS_W_OUTC) + (size_t)i * DM * DM, (const float*)nullptr, DM, DM, 0);
            }
#pragma nounroll
            for (int l = 0; l < 4; ++l) {
                ADD_JOB((const float*)INP(25) + (size_t)l * DM * 256, (bf16*)(ws + WS_W_XQ) + (size_t)l * 256 * DM, norm_g + (l * 3 + 1) * DM, DM, 256, 0);
                ADD_JOB((const float*)INP(26) + (size_t)l * DM * 512, (bf16*)(ws + WS_W_XKV) + (size_t)l * 512 * DM, (const float*)nullptr, DM, 512, 0);
                ADD_JOB((const float*)INP(27) + (size_t)l * 256 * DM, (bf16*)(ws + WS_W_XO) + (size_t)l * DM * 256, (const float*)nullptr, 256, DM, 0);
            }
            jmeta[0] = nj; jmeta[1] = tot;
        }
        __syncthreads();
        run_conv_jobs(lds, jmeta[0], 0, jmeta[1], gw, NGW, wave, lane);
        __syncthreads();
        if (tid == 0) { int nj = 0, tot = 0; BUILD_MOE_JOBS(0); }
        __syncthreads();
        run_conv_jobs(lds, 24, G == 256 ? MS0_A3 : 0, MOE_ITEMS, gw, NGW, wave, lane);
        for (int idx = bx * 512 + tid; idx < 2 * (C_IN_PAD - C_IN) * (DM / 8); idx += G * 512) {
            const int i = idx / ((C_IN_PAD - C_IN) * (DM / 8)), rem = idx % ((C_IN_PAD - C_IN) * (DM / 8));
            *(u32x4*)((bf16*)(ws + WS_W_INC) + ((size_t)i * C_IN_PAD + C_IN) * DM + (size_t)rem * 8) = (u32x4){0u, 0u, 0u, 0u};
        }
        for (int m = gw; m < MTOK; m += NGW) {
            f32x4 v[4]; const float s = load_row4(in_x + (size_t)m * DM, lane, v);
            store_row_bf16(XB + (size_t)m * DM, lane, v); store_ssq_full(SSQ, m, s, lane);
        }
        for (int m = gw; m < NB * MEML; m += NGW) {
            f32x4 v[4]; const float s = load_row4(in_mem + (size_t)m * DM, lane, v); const float r = rsqrtf(s * (1.f / DM) + NORM_EPS);
#pragma unroll
            for (int j = 0; j < 4; ++j) v[j] = v[j] * r * *(const f32x4*)(mem_g + 4 * lane + 256 * j);
            store_row_bf16(MEMB + (size_t)m * DM, lane, v);
        }
        for (int idx = bx * 512 + tid; idx < SEQ * 8; idx += G * 512) {
            const int t = idx >> 3, j = idx & 7; const double a = (double)in_pos[t] * ARG_INVF(j) * 0.15915494309189535;
            const float fr_ = (float)(a - __builtin_rint(a));
            CS[t * 16 + j] = __builtin_amdgcn_cosf(fr_); CS[t * 16 + 8 + j] = __builtin_amdgcn_sinf(fr_);
        }
        BAR_AFTER(0); T_DELAY(DLY(0));
    }


    run_layer<0>(lds); run_layer<1>(lds); run_layer<2>(lds); run_layer<3>(lds);
#undef IN
#undef BAR_AFTER
}
#undef ws
#undef ctl
#undef X

static bool phase_applies(int p) {
    if (p == 0) return true;
    if (p == 1) return false;
    const int l = (p - 2) / 13, k = (p - 2) % 13; const bool even = (l & 1) == 0;
    if (even) return k != 1 && k != 2 && k < 10;
    return true;
}
#ifndef DUP_EVEN
#define DUP_EVEN 0u
#endif
#ifndef DUP_ODD
#define DUP_ODD 0u
#endif
static bool probe_dup(int p) {
    if (p == 0) return (DUP_EVEN >> 13) & 1u;
    if (p == 1) return (DUP_EVEN >> 14) & 1u;
    const int l = (p - 2) / 13, k = (p - 2) % 13;
    return (((l & 1) ? DUP_ODD : DUP_EVEN) >> k) & 1u;
}
extern "C" void kernel_launch(void* const* d_in, const int* in_sizes, int n_in, void* d_out, int out_size, void* d_ws, size_t ws_size, hipStream_t stream) {
    static int grid = 0;
    if (grid == 0) {
        if (n_in != 28 || out_size != MTOK * DM || ws_size < WS_END) { fprintf(stderr, "kernel_launch: unexpected shapes (n_in %d out %d ws %zu need %zu)\n", n_in, out_size, ws_size, (size_t)WS_END); grid = -1; return; }
        int dev = 0, cus = 0;
        if (hipGetDevice(&dev) != hipSuccess || hipDeviceGetAttribute(&cus, hipDeviceAttributeMultiprocessorCount, dev) != hipSuccess) { grid = -1; return; }
        if (hipFuncSetAttribute((const void*)mk_fwd, hipFuncAttributeMaxDynamicSharedMemorySize, LDS_BYTES) != hipSuccess) { fprintf(stderr, "kernel_launch: hipFuncSetAttribute failed\n"); grid = -1; return; }
        int per_cu = 0;
        if (hipOccupancyMaxActiveBlocksPerMultiprocessor(&per_cu, (const void*)mk_fwd, NWAVES * 64, LDS_BYTES) != hipSuccess || per_cu < 1) fprintf(stderr, "kernel_launch: occupancy query reports %d\n", per_cu);
        (void)hipGetLastError();
        grid = cus;
    }
    if (grid < 0) return;
    (void)hipMemsetAsync((char*)d_ws + WS_CTL, 0, CTL_ZERO_BYTES, stream);
    Args a{};
    for (int i = 0; i < 28; ++i) a.in[i] = d_in[i];
    a.out = (float*)d_out; a.ws = (unsigned char*)d_ws;
    for (int j = 0; j < 8; ++j) a.invf[j] = pow(500000.0, -(double)(2 * j) / 16.0);
#if MK_SINGLE
    a.ph_lo = 0; a.ph_hi = NPH;
    hipLaunchKernelGGL(mk_fwd, dim3(grid), dim3(NWAVES * 64), LDS_BYTES, stream, a);
#else
    for (int p = 0; p < NPH; ++p) {
        if (!phase_applies(p)) continue;
        a.ph_lo = p; a.ph_hi = p + 1;
        const int nrep = probe_dup(p) ? 2 : 1;
        for (int r = 0; r < nrep; ++r) hipLaunchKernelGGL(mk_fwd, dim3(grid), dim3(NWAVES * 64), LDS_BYTES, stream, a);
    }
#endif
}
```
